# Optimizing an MI355X kernel written in HIP

```python
import math
import jax, jax.numpy as jnp
from jax import lax
import numpy as np

D_MODEL = 1024
BATCH = 8
SEQ = 2048
DEPTH = 2

RWKV_HEADS = 8
RWKV_HD = 64
RWKV_W = RWKV_HEADS * RWKV_HD
DECAY_LORA = 64
ICLR_LORA = 64
VRES_LORA = 32
GATE_LORA = 128
LNX_EPS = 64e-5
SB_HEADS = 8
SB_HD = 64
SB_W = SB_HEADS * SB_HD
SB_BLOCK = 128
MEM_LEN = 256
MEM_HEADS = 4
MEM_HD = 128
MEM_W = MEM_HEADS * MEM_HD
N_BRANCH = 3
BRANCH_W = 512
D_FF = 2816
CONV_W = 3
NORM_EPS = 1e-6

RWKV_SPLITS = (RWKV_W, RWKV_W, RWKV_W, DECAY_LORA, ICLR_LORA, GATE_LORA)
RWKV_COLS = sum(RWKV_SPLITS)
IN_COLS = RWKV_COLS + 3 * SB_W + MEM_W + N_BRANCH * D_MODEL

kernel_name = "hybrid_rwkv7_stickbreak_memxattn_convffn"


def rms_norm(x, g, eps=NORM_EPS):
    xf = x.astype(jnp.float32)
    y = xf * lax.rsqrt(jnp.mean(xf * xf, axis=-1, keepdims=True) + eps)
    return (y * g.astype(jnp.float32)).astype(x.dtype)


def split_heads(t, h, d):
    return t.reshape(t.shape[:-1] + (h, d))


def token_shift(p, mu):
    prev = jnp.pad(p, ((0, 0), (1, 0), (0, 0)))[:, :-1]
    return p + (prev - p) * mu


def rwkv7_recurrence(r, decay, k, v, kk, a):
    b, t, h, n = r.shape
    xs = tuple(jnp.moveaxis(z, 1, 0) for z in (r, decay, k, v, kk, a))

    def step(S, inp):
        r_t, w_t, k_t, v_t, kk_t, a_t = inp
        sa = jnp.einsum('bhij,bhj->bhi', S, -kk_t)
        S = (S * w_t[:, :, None, :]
             + sa[..., None] * (kk_t * a_t)[:, :, None, :]
             + v_t[..., None] * k_t[:, :, None, :])
        y_t = jnp.einsum('bhij,bhj->bhi', S, r_t)
        return S, y_t

    S0 = jnp.zeros((b, h, n, n), jnp.float32)
    _, ys = lax.scan(step, S0, xs)
    return jnp.moveaxis(ys, 0, 1)


def rwkv7_branch(p, mu, w0, w2, a0, a2, g2, k_k, k_a, r_k, lnx_g, lnx_b, v_first, vres):
    dt = p.dtype
    p = token_shift(p, mu)
    idx = list(np.cumsum(RWKV_SPLITS)[:-1])
    r, k, v, wl, al, gl = jnp.split(p, idx, axis=-1)
    f32 = jnp.float32
    w = -jax.nn.softplus(-(w0 + jnp.tanh(wl) @ w2).astype(f32)) - 0.5
    decay = jnp.exp(-jnp.exp(w))
    a = jax.nn.sigmoid((a0 + al @ a2).astype(f32))
    g = jax.nn.sigmoid(gl) @ g2
    if vres is None:
        v_first = v
    else:
        v0, v1, v2 = vres
        v = v + (v_first - v) * jax.nn.sigmoid(v0 + (v @ v1) @ v2)
    kk = split_heads((k * k_k).astype(f32), RWKV_HEADS, RWKV_HD)
    kk = kk / jnp.maximum(jnp.sqrt(jnp.sum(kk * kk, axis=-1, keepdims=True)), 1e-12)
    k = k.astype(f32) * (1.0 + (a - 1.0) * k_a.astype(f32))
    rh = split_heads(r.astype(f32), RWKV_HEADS, RWKV_HD)
    kh = split_heads(k, RWKV_HEADS, RWKV_HD)
    vh = split_heads(v.astype(f32), RWKV_HEADS, RWKV_HD)
    ah = split_heads(a, RWKV_HEADS, RWKV_HD)
    dh = split_heads(decay, RWKV_HEADS, RWKV_HD)
    y = rwkv7_recurrence(rh, dh, kh, vh, kk, ah)
    mean = jnp.mean(y, axis=-1, keepdims=True)
    var = jnp.mean(jnp.square(y - mean), axis=-1, keepdims=True)
    y = (y - mean) * lax.rsqrt(var + LNX_EPS)
    y = y.reshape(y.shape[:2] + (RWKV_W,)) * lnx_g.astype(f32) + lnx_b.astype(f32)
    bonus = jnp.sum(rh * kh * r_k.astype(f32), axis=-1, keepdims=True) * vh
    y = (y + bonus.reshape(y.shape)) * g.astype(f32)
    return y.astype(dt), v_first


def stick_breaking_attention(q, k, v):
    t_len = q.shape[2]
    scale = SB_HD ** -0.5
    outs = []
    for blk in range(t_len // SB_BLOCK):
        start = blk * SB_BLOCK
        end = start + SB_BLOCK
        qb = q[:, :, start:end]
        kb = k[:, :, :end]
        vb = v[:, :, :end]
        z = jnp.einsum('bhqd,bhkd->bhqk', qb, kb).astype(jnp.float32) * scale
        t_idx = start + jnp.arange(SB_BLOCK)
        s_idx = jnp.arange(end)
        mask = s_idx[None, :] < t_idx[:, None]
        log_1mb = jnp.where(mask, jax.nn.log_sigmoid(-z), 0.0)
        log_between = lax.cumsum(log_1mb, axis=3, reverse=True) - log_1mb
        attn = jnp.where(mask, jnp.exp(jax.nn.log_sigmoid(z) + log_between), 0.0)
        outs.append(jnp.einsum('bhqk,bhkd->bhqd', attn.astype(v.dtype), vb))
    return jnp.concatenate(outs, axis=2)


def stick_breaking_branch(p, q_g, k_g):
    b, t, _ = p.shape
    q, k, v = jnp.split(p, 3, axis=-1)
    q = rms_norm(split_heads(q, SB_HEADS, SB_HD), q_g).transpose(0, 2, 1, 3)
    k = rms_norm(split_heads(k, SB_HEADS, SB_HD), k_g).transpose(0, 2, 1, 3)
    v = split_heads(v, SB_HEADS, SB_HD).transpose(0, 2, 1, 3)
    o = stick_breaking_attention(q, k, v)
    return o.transpose(0, 2, 1, 3).reshape(b, t, SB_W)


def memory_branch(q, mem, mem_g, w_kv, q_g, k_g):
    b, t, _ = q.shape
    kv = rms_norm(mem, mem_g) @ w_kv
    mk, mv = jnp.split(kv, 2, axis=-1)
    qh = rms_norm(split_heads(q, MEM_HEADS, MEM_HD), q_g)
    kh = rms_norm(split_heads(mk, MEM_HEADS, MEM_HD), k_g)
    vh = split_heads(mv, MEM_HEADS, MEM_HD)
    s = jnp.einsum('bthd,bmhd->bhtm', qh, kh).astype(jnp.float32) * (MEM_HD ** -0.5)
    pr = jax.nn.softmax(s, axis=-1).astype(vh.dtype)
    o = jnp.einsum('bhtm,bmhd->bthd', pr, vh)
    return o.reshape(b, t, MEM_W)


def conv_ffn(x, g, w_up, conv_w, conv_b, w_down):
    h = rms_norm(x, g) @ w_up
    t = h.shape[1]
    hp = jnp.pad(h, ((0, 0), (CONV_W - 1, 0), (0, 0)))
    acc = conv_b + hp[:, 0:t] * conv_w[0]
    for i in range(1, CONV_W):
        acc = acc + hp[:, i:i + t] * conv_w[i]
    gate, val = jnp.split(acc, 2, axis=-1)
    return (jax.nn.silu(gate) * val) @ w_down


def setup_inputs(seed: int = 0) -> dict:
    key = jax.random.key(seed)
    ks = jax.random.split(key, 40)
    f32 = jnp.float32
    nrm = lambda k, s, sc: jax.random.normal(k, s, f32) * sc
    gain = lambda k, s: 1.0 + 0.05 * jax.random.normal(k, s, f32)
    L = DEPTH
    return {
        "x": nrm(ks[0], (BATCH, SEQ, D_MODEL), 1.0),
        "mem": nrm(ks[1], (BATCH, MEM_LEN, D_MODEL), 1.0),
        "norm1_g": gain(ks[2], (L, D_MODEL)),
        "w_in": nrm(ks[3], (L, D_MODEL, IN_COLS), D_MODEL ** -0.5),
        "shift_mu": jax.random.uniform(ks[4], (L, RWKV_COLS), f32, 0.0, 1.0),
        "decay_w0": jax.random.uniform(ks[5], (L, RWKV_W), f32, -6.0, 1.0),
        "decay_w2": nrm(ks[6], (L, DECAY_LORA, RWKV_W), 0.5 * DECAY_LORA ** -0.5),
        "iclr_a0": nrm(ks[7], (L, RWKV_W), 0.1),
        "iclr_a2": nrm(ks[8], (L, ICLR_LORA, RWKV_W), ICLR_LORA ** -0.5),
        "gate_g2": nrm(ks[9], (L, GATE_LORA, RWKV_W), GATE_LORA ** -0.5),
        "k_k": 0.85 + 0.05 * jax.random.normal(ks[10], (L, RWKV_W), f32),
        "k_a": gain(ks[11], (L, RWKV_W)),
        "r_k": nrm(ks[12], (L, RWKV_HEADS, RWKV_HD), 0.1),
        "lnx_g": gain(ks[13], (L, RWKV_W)),
        "lnx_b": nrm(ks[14], (L, RWKV_W), 0.02),
        "vres_v0": 1.0 + 0.1 * jax.random.normal(ks[15], (L - 1, RWKV_W), f32),
        "vres_v1": nrm(ks[16], (L - 1, RWKV_W, VRES_LORA), RWKV_W ** -0.5),
        "vres_v2": nrm(ks[17], (L - 1, VRES_LORA, RWKV_W), VRES_LORA ** -0.5),
        "sb_q_norm_g": gain(ks[18], (L, SB_HD)),
        "sb_k_norm_g": gain(ks[19], (L, SB_HD)),
        "mem_norm_g": gain(ks[20], (L, D_MODEL)),
        "w_mem_kv": nrm(ks[21], (L, D_MODEL, 2 * MEM_W), D_MODEL ** -0.5),
        "mem_q_norm_g": gain(ks[22], (L, MEM_HD)),
        "mem_k_norm_g": gain(ks[23], (L, MEM_HD)),
        "w_branch": nrm(ks[24], (L, N_BRANCH, BRANCH_W, D_MODEL), BRANCH_W ** -0.5),
        "w_out": nrm(ks[25], (L, D_MODEL, D_MODEL), D_MODEL ** -0.5),
        "norm2_g": gain(ks[26], (L, D_MODEL)),
        "w_up": nrm(ks[27], (L, D_MODEL, 2 * D_FF), D_MODEL ** -0.5),
        "conv_w": nrm(ks[28], (L, CONV_W, 2 * D_FF), CONV_W ** -0.5),
        "conv_b": nrm(ks[29], (L, 2 * D_FF), 0.02),
        "w_down": nrm(ks[30], (L, D_FF, D_MODEL), D_FF ** -0.5),
    }


def reference(x, mem, norm1_g, w_in, shift_mu, decay_w0, decay_w2, iclr_a0, iclr_a2, gate_g2,
              k_k, k_a, r_k, lnx_g, lnx_b, vres_v0, vres_v1, vres_v2, sb_q_norm_g, sb_k_norm_g,
              mem_norm_g, w_mem_kv, mem_q_norm_g, mem_k_norm_g, w_branch, w_out, norm2_g,
              w_up, conv_w, conv_b, w_down):
    b, t, _ = x.shape
    cut = [RWKV_COLS, RWKV_COLS + 3 * SB_W, RWKV_COLS + 3 * SB_W + MEM_W]
    v_first = None
    for l in range(DEPTH):
        h = rms_norm(x, norm1_g[l])
        proj = h @ w_in[l]
        p_rwkv, p_sb, q_mem, gate_logits = jnp.split(proj, cut, axis=-1)
        vres = None if l == 0 else (vres_v0[l - 1], vres_v1[l - 1], vres_v2[l - 1])
        y_a, v_first = rwkv7_branch(p_rwkv, shift_mu[l], decay_w0[l], decay_w2[l], iclr_a0[l],
                                    iclr_a2[l], gate_g2[l], k_k[l], k_a[l], r_k[l], lnx_g[l],
                                    lnx_b[l], v_first, vres)
        y_b = stick_breaking_branch(p_sb, sb_q_norm_g[l], sb_k_norm_g[l])
        y_m = memory_branch(q_mem, mem, mem_norm_g[l], w_mem_kv[l], mem_q_norm_g[l], mem_k_norm_g[l])
        ys = jnp.stack([y_a, y_b.astype(y_a.dtype), y_m.astype(y_a.dtype)], axis=2)
        branch_out = jnp.einsum('btnc,ncd->btnd', ys, w_branch[l])
        gates = jax.nn.sigmoid(gate_logits.reshape(b, t, N_BRANCH, D_MODEL))
        merged = jnp.sum(gates * branch_out, axis=2)
        x = x + merged @ w_out[l]
        x = x + conv_ffn(x, norm2_g[l], w_up[l], conv_w[l], conv_b[l], w_down[l])
    return x
```

```cpp
#include <hip/hip_runtime.h>
#include <cstdint>
#include <cstdio>

typedef unsigned short bf16;
typedef _Float16 f16;

constexpr int BATCH = 8, SEQ = 2048, D = 1024, M = BATCH * SEQ;
constexpr int RW = 512, NH = 8, HD = 64;
constexpr int RWKV_COLS = 1792, IN_COLS = 6912;
constexpr int MEM_LEN = 256, MEM_ROWS = BATCH * MEM_LEN;
constexpr int DFF = 2816, DFF2 = 5632;
constexpr float NORM_EPS = 1e-6f, LNX_EPS = 64e-5f;

constexpr size_t MiB = 1u << 20;
constexpr size_t WS_CTL = 0;
constexpr size_t WS_WINT = 1 * MiB;
constexpr size_t WS_WUPT = WS_WINT + 13 * MiB + MiB / 2;
constexpr size_t WS_WDNT = WS_WUPT + 11 * MiB;
constexpr size_t WS_WBRT = WS_WDNT + 5 * MiB + MiB / 2;
constexpr size_t WS_WOUTT = WS_WBRT + 3 * MiB;
constexpr size_t WS_WLORA = WS_WOUTT + 2 * MiB;
constexpr size_t WS_V1T = WS_WLORA + 3 * MiB / 4;
constexpr size_t WS_V2T = WS_V1T + MiB / 4;
constexpr size_t WS_VFIRST = 38 * MiB;
constexpr size_t WS_XBA = 54 * MiB;
constexpr size_t WS_KVMEM = 86 * MiB;
constexpr size_t WS_SSQ = 94 * MiB;
constexpr size_t WS_NRM = WS_SSQ + MiB / 4;
constexpr size_t WS_SSQM = WS_NRM + MiB / 2;
constexpr size_t WS_R = 95 * MiB;
constexpr size_t SLOT = 16 * MiB;
#define RS(i) (WS_R + (size_t)(i) * SLOT)
static_assert(WS_V2T + MiB / 4 <= WS_VFIRST, "weights region");
static_assert(RS(10) <= 256 * MiB, "ws");

__device__ __forceinline__ float bf2f(bf16 v) { return __uint_as_float((unsigned)v << 16); }
__device__ __forceinline__ bf16 f2bf(float f) { unsigned u = __float_as_uint(f); return (bf16)((u + 0x7fffu + ((u >> 16) & 1u)) >> 16); }
__device__ __forceinline__ float sigmoidf_(float x) { return 1.f / (1.f + __expf(-x)); }
__device__ __forceinline__ float softplusf_(float x) { return fmaxf(x, 0.f) + log1pf(__expf(-fabsf(x))); }
__device__ __forceinline__ float wave_sum(float v) {
#pragma unroll
    for (int o = 1; o < 64; o <<= 1) v += __shfl_xor(v, o);
    return v;
}
__device__ __forceinline__ float wave_max(float v) {
#pragma unroll
    for (int o = 1; o < 64; o <<= 1) v = fmaxf(v, __shfl_xor(v, o));
    return v;
}
__device__ __forceinline__ float rstd_of(const float* ssq, int r) {
    const float4 q = *(const float4*)(ssq + 4 * (size_t)r);
    return rsqrtf(((q.x + q.y) + (q.z + q.w)) * (1.f / 1024.f) + NORM_EPS);
}

__global__ void k_wt(const float* __restrict__ src, const float* __restrict__ scale, bf16* __restrict__ dst, int ldsrc, int lddst, int koff, int N, int K, int mode) {
    const size_t idx = (size_t)blockIdx.x * blockDim.x + threadIdx.x;
    if (idx >= (size_t)N * K) return;
    const int n = (int)(idx / K), k = (int)(idx % K);
    int sc = n;
    if (mode == 1) { const int pn = n >> 8, j = n & 255; sc = (j < 128) ? (128 * pn + j) : (DFF + 128 * pn + (j - 128)); }
    float v = src[(size_t)k * ldsrc + sc];
    if (scale) v *= scale[k];
    dst[(size_t)n * lddst + koff + k] = f2bf(v);
}

__global__ void k_x_to_xb(const float* __restrict__ x, bf16* __restrict__ xb, float* __restrict__ ssq, int rows, int pad) {
    const int row = blockIdx.x * 4 + (threadIdx.x >> 6), lane = threadIdx.x & 63;
    if (row >= rows) return;
    const float* xr = x + (size_t)row * D;
#pragma unroll
    for (int q = 0; q < 4; ++q) {
        const float4 v = *(const float4*)(xr + q * 256 + lane * 4);
        float s = (v.x * v.x + v.y * v.y) + (v.z * v.z + v.w * v.w);
        s = wave_sum(s);
        if (lane == 0) ssq[(size_t)row * 4 + q] = s;
        ushort4 o; o.x = f2bf(v.x); o.y = f2bf(v.y); o.z = f2bf(v.z); o.w = f2bf(v.w);
        *(ushort4*)(xb + (size_t)row * D + q * 256 + lane * 4) = o;
    }
}

struct EpiRowScaleBf16 { bf16* out; const float* ssq; int ldo; int act;
    __device__ __forceinline__ void operator()(int r, int c, float acc) const { float v = acc * rstd_of(ssq, r); if (act == 1) v = sigmoidf_(v); out[(size_t)r * ldo + c] = f2bf(v); } };
struct EpiPlainBf16 { bf16* out; int ldo; int pad;
    __device__ __forceinline__ void operator()(int r, int c, float acc) const { out[(size_t)r * ldo + c] = f2bf(acc); } };
struct EpiLora { f16* ld; bf16* a; bf16* g; const float* w0; const float* a0;
    __device__ __forceinline__ void operator()(int r, int c, float acc) const {
        if (c < 512) { const float wr = w0[c] + acc; const float w = -softplusf_(-wr) - 0.5f; ld[(size_t)r * 512 + c] = (f16)(-__expf(w)); }
        else if (c < 1024) { a[(size_t)r * 512 + c - 512] = f2bf(sigmoidf_(a0[c - 512] + acc)); }
        else { g[(size_t)r * 512 + c - 1024] = f2bf(acc); } } };
struct EpiVres { const bf16* v; const bf16* vf; const float* v0; bf16* out;
    __device__ __forceinline__ void operator()(int r, int c, float acc) const {
        const size_t i = (size_t)r * 512 + c; const float vv = bf2f(v[i]), f = bf2f(vf[i]);
        out[i] = f2bf(vv + (f - vv) * sigmoidf_(v0[c] + acc)); } };
struct EpiResidual { const float* xin; float* xout;
    __device__ __forceinline__ void operator()(int r, int c, float acc) const { const size_t i = (size_t)r * D + c; xout[i] = xin[i] + acc; } };

template <class Epi>
__global__ void __launch_bounds__(256) gemm_ref(const bf16* __restrict__ A, const bf16* __restrict__ Bt, int lda, int ldb, int K, int pad, Epi epi) {
    __shared__ float As[16][65], Bs[16][65];
    const int tx = threadIdx.x & 15, ty = threadIdx.x >> 4;
    const int r0 = blockIdx.y * 64, c0 = blockIdx.x * 64;
    const int lr = threadIdx.x >> 2, lk = (threadIdx.x & 3) * 4;
    float acc[4][4];
#pragma unroll
    for (int i = 0; i < 4; ++i)
#pragma unroll
        for (int j = 0; j < 4; ++j) acc[i][j] = 0.f;
    for (int k0 = 0; k0 < K; k0 += 16) {
        const ushort4 av = *(const ushort4*)(A + (size_t)(r0 + lr) * lda + k0 + lk);
        const ushort4 bv = *(const ushort4*)(Bt + (size_t)(c0 + lr) * ldb + k0 + lk);
        As[lk + 0][lr] = bf2f(av.x); As[lk + 1][lr] = bf2f(av.y); As[lk + 2][lr] = bf2f(av.z); As[lk + 3][lr] = bf2f(av.w);
        Bs[lk + 0][lr] = bf2f(bv.x); Bs[lk + 1][lr] = bf2f(bv.y); Bs[lk + 2][lr] = bf2f(bv.z); Bs[lk + 3][lr] = bf2f(bv.w);
        __syncthreads();
#pragma unroll
        for (int kk = 0; kk < 16; ++kk) {
            float a[4], b[4];
#pragma unroll
            for (int i = 0; i < 4; ++i) { a[i] = As[kk][ty * 4 + i]; b[i] = Bs[kk][tx * 4 + i]; }
#pragma unroll
            for (int i = 0; i < 4; ++i)
#pragma unroll
                for (int j = 0; j < 4; ++j) acc[i][j] += a[i] * b[j];
        }
        __syncthreads();
    }
#pragma unroll
    for (int i = 0; i < 4; ++i)
#pragma unroll
        for (int j = 0; j < 4; ++j) epi(r0 + ty * 4 + i, c0 + tx * 4 + j, acc[i][j]);
}

__global__ void __launch_bounds__(256) gemm_gated_ref(const bf16* __restrict__ ya, const bf16* __restrict__ yb, const bf16* __restrict__ ym, const bf16* __restrict__ WbrT,
                                                      const bf16* __restrict__ gates, bf16* __restrict__ merged) {
    __shared__ float As[16][65], Bs[16][65];
    const int tx = threadIdx.x & 15, ty = threadIdx.x >> 4;
    const int r0 = blockIdx.y * 64, c0 = blockIdx.x * 64;
    const int lr = threadIdx.x >> 2, lk = (threadIdx.x & 3) * 4;
    float tot[4][4];
#pragma unroll
    for (int i = 0; i < 4; ++i)
#pragma unroll
        for (int j = 0; j < 4; ++j) tot[i][j] = 0.f;
    for (int b = 0; b < 3; ++b) {
        const bf16* A = b == 0 ? ya : (b == 1 ? yb : ym);
        float acc[4][4];
#pragma unroll
        for (int i = 0; i < 4; ++i)
#pragma unroll
            for (int j = 0; j < 4; ++j) acc[i][j] = 0.f;
        for (int k0 = 0; k0 < 512; k0 += 16) {
            const ushort4 av = *(const ushort4*)(A + (size_t)(r0 + lr) * 512 + k0 + lk);
            const ushort4 bv = *(const ushort4*)(WbrT + (size_t)(c0 + lr) * 1536 + b * 512 + k0 + lk);
            As[lk + 0][lr] = bf2f(av.x); As[lk + 1][lr] = bf2f(av.y); As[lk + 2][lr] = bf2f(av.z); As[lk + 3][lr] = bf2f(av.w);
            Bs[lk + 0][lr] = bf2f(bv.x); Bs[lk + 1][lr] = bf2f(bv.y); Bs[lk + 2][lr] = bf2f(bv.z); Bs[lk + 3][lr] = bf2f(bv.w);
            __syncthreads();
#pragma unroll
            for (int kk = 0; kk < 16; ++kk) {
                float a[4], bb[4];
#pragma unroll
                for (int i = 0; i < 4; ++i) { a[i] = As[kk][ty * 4 + i]; bb[i] = Bs[kk][tx * 4 + i]; }
#pragma unroll
                for (int i = 0; i < 4; ++i)
#pragma unroll
                    for (int j = 0; j < 4; ++j) acc[i][j] += a[i] * bb[j];
            }
            __syncthreads();
        }
#pragma unroll
        for (int i = 0; i < 4; ++i)
#pragma unroll
            for (int j = 0; j < 4; ++j) { const int r = r0 + ty * 4 + i, c = c0 + tx * 4 + j; tot[i][j] += bf2f(gates[(size_t)r * 3072 + b * 1024 + c]) * acc[i][j]; }
    }
#pragma unroll
    for (int i = 0; i < 4; ++i)
#pragma unroll
        for (int j = 0; j < 4; ++j) merged[(size_t)(r0 + ty * 4 + i) * D + c0 + tx * 4 + j] = f2bf(tot[i][j]);
}

__global__ void k_memk_norm(bf16* __restrict__ kv, const float* __restrict__ kg) {
    const int row = blockIdx.x, h = threadIdx.x >> 6, lane = threadIdx.x & 63;
    bf16* p = kv + (size_t)row * 1024 + h * 128 + lane * 2;
    const float a = bf2f(p[0]), b = bf2f(p[1]);
    const float ss = wave_sum(a * a + b * b);
    const float rs = rsqrtf(ss * (1.f / 128.f) + NORM_EPS);
    p[0] = f2bf(a * rs * kg[lane * 2]); p[1] = f2bf(b * rs * kg[lane * 2 + 1]);
}

__global__ void __launch_bounds__(256) k_shift(const bf16* __restrict__ proj_r, const float* __restrict__ mu, const float* __restrict__ k_k,
                                              bf16* __restrict__ r_s, bf16* __restrict__ k_s, bf16* __restrict__ v_s, bf16* __restrict__ lora_in, float* __restrict__ nrm) {
    __shared__ float sq[512];
    const int row = blockIdx.x, t = row % SEQ;
    const bf16* cur = proj_r + (size_t)row * RWKV_COLS;
    for (int c = threadIdx.x; c < RWKV_COLS; c += 256) {
        const float pc = bf2f(cur[c]);
        const float pp = (t > 0) ? bf2f(cur[c - RWKV_COLS]) : 0.f;
        const float p = pc + (pp - pc) * mu[c];
        if (c < 512) r_s[(size_t)row * 512 + c] = f2bf(p);
        else if (c < 1024) { k_s[(size_t)row * 512 + c - 512] = f2bf(p); const float q = p * k_k[c - 512]; sq[c - 512] = q * q; }
        else if (c < 1536) v_s[(size_t)row * 512 + c - 1024] = f2bf(p);
        else if (c < 1600) lora_in[(size_t)row * 256 + (c - 1536)] = f2bf(tanhf(p));
        else if (c < 1664) lora_in[(size_t)row * 256 + 64 + (c - 1600)] = f2bf(p);
        else lora_in[(size_t)row * 256 + 128 + (c - 1664)] = f2bf(sigmoidf_(p));
    }
    __syncthreads();
    if (threadIdx.x < 8) {
        float s = 0.f;
        for (int j = 0; j < 64; ++j) s += sq[threadIdx.x * 64 + j];
        nrm[(size_t)row * 8 + threadIdx.x] = 1.f / fmaxf(sqrtf(s), 1e-12f);
    }
}

__global__ void __launch_bounds__(64) scan_ref(const bf16* __restrict__ r_s, const bf16* __restrict__ k_s, const bf16* __restrict__ v, const bf16* __restrict__ a,
                                              const f16* __restrict__ ld, const float* __restrict__ nrm, const float* __restrict__ k_k, const float* __restrict__ k_a,
                                              bf16* __restrict__ y_raw) {
    __shared__ float sr[64], sdec[64], sk[64], skk[64], skka[64];
    const int bh = blockIdx.x, b = bh >> 3, h = bh & 7, i = threadIdx.x;
    float S[64];
#pragma unroll
    for (int j = 0; j < 64; ++j) S[j] = 0.f;
    const float kkj = k_k[h * 64 + i], kaj = k_a[h * 64 + i];
    for (int t = 0; t < SEQ; ++t) {
        const size_t row = (size_t)b * SEQ + t, idx = row * 512 + h * 64 + i;
        const float r = bf2f(r_s[idx]), k = bf2f(k_s[idx]), aa = bf2f(a[idx]), l = (float)ld[idx], vv = bf2f(v[idx]);
        const float n = nrm[row * 8 + h];
        const float kk = k * kkj * n;
        sr[i] = r; sdec[i] = __expf(l); sk[i] = k * (1.f + (aa - 1.f) * kaj); skk[i] = kk; skka[i] = kk * aa;
        __syncthreads();
        float sa = 0.f;
#pragma unroll
        for (int j = 0; j < 64; ++j) sa += S[j] * skk[j];
        sa = -sa;
        float y = 0.f;
#pragma unroll
        for (int j = 0; j < 64; ++j) { S[j] = S[j] * sdec[j] + sa * skka[j] + vv * sk[j]; y += S[j] * sr[j]; }
        y_raw[idx] = f2bf(y);
        __syncthreads();
    }
}

__global__ void __launch_bounds__(512) k_post(const bf16* __restrict__ y_raw, const bf16* __restrict__ r_s, const bf16* __restrict__ k_s, const bf16* __restrict__ a,
                                             const bf16* __restrict__ v, const bf16* __restrict__ g, const float* __restrict__ k_a, const float* __restrict__ r_k,
                                             const float* __restrict__ lnx_g, const float* __restrict__ lnx_b, bf16* __restrict__ y_a) {
    const int row = blockIdx.x, col = threadIdx.x;
    const size_t idx = (size_t)row * 512 + col;
    const float y = bf2f(y_raw[idx]);
    const float mean = wave_sum(y) * (1.f / 64.f);
    const float d = y - mean;
    const float var = wave_sum(d * d) * (1.f / 64.f);
    const float yn = d * rsqrtf(var + LNX_EPS) * lnx_g[col] + lnx_b[col];
    const float r = bf2f(r_s[idx]), k = bf2f(k_s[idx]), aa = bf2f(a[idx]);
    const float kt = k * (1.f + (aa - 1.f) * k_a[col]);
    const float bonus = wave_sum(r * kt * r_k[col]);
    y_a[idx] = f2bf((yn + bonus * bf2f(v[idx])) * bf2f(g[idx]));
}

__global__ void __launch_bounds__(64) sb_attn_ref(const bf16* __restrict__ proj_sm, const float* __restrict__ qg, const float* __restrict__ kg, bf16* __restrict__ y_b) {
    __shared__ float ks[64][65], vs[64][65];
    const int bh = blockIdx.y, b = bh >> 3, h = bh & 7, qt = blockIdx.x, tid = threadIdx.x;
    const int t = qt * 64 + tid;
    const size_t rowq = (size_t)b * SEQ + t;
    float q[64], o[64];
    {
        float ss = 0.f;
#pragma unroll
        for (int d = 0; d < 64; ++d) { q[d] = bf2f(proj_sm[rowq * 2048 + h * 64 + d]); ss += q[d] * q[d]; }
        const float rs = rsqrtf(ss * (1.f / 64.f) + NORM_EPS) * 0.125f;
#pragma unroll
        for (int d = 0; d < 64; ++d) { q[d] = q[d] * rs * qg[d]; o[d] = 0.f; }
    }
    float R = 0.f;
    for (int kt = qt; kt >= 0; --kt) {
        {
            const size_t rowk = (size_t)b * SEQ + kt * 64 + tid;
            float kr[64]; float ss = 0.f;
#pragma unroll
            for (int d = 0; d < 64; ++d) { kr[d] = bf2f(proj_sm[rowk * 2048 + 512 + h * 64 + d]); ss += kr[d] * kr[d]; }
            const float rs = rsqrtf(ss * (1.f / 64.f) + NORM_EPS);
#pragma unroll
            for (int d = 0; d < 64; ++d) { ks[tid][d] = kr[d] * rs * kg[d]; vs[tid][d] = bf2f(proj_sm[rowk * 2048 + 1024 + h * 64 + d]); }
        }
        __syncthreads();
        for (int jj = 63; jj >= 0; --jj) {
            const int s = kt * 64 + jj;
            if (s < t) {
                float z = 0.f;
#pragma unroll
                for (int d = 0; d < 64; ++d) z += q[d] * ks[jj][d];
                R += softplusf_(z);
                const float A = __expf(z - R);
#pragma unroll
                for (int d = 0; d < 64; ++d) o[d] += A * vs[jj][d];
            }
        }
        __syncthreads();
    }
#pragma unroll
    for (int d = 0; d < 64; ++d) y_b[rowq * 512 + h * 64 + d] = f2bf(o[d]);
}

__global__ void __launch_bounds__(256) mem_attn_ref(const bf16* __restrict__ proj_sm, const bf16* __restrict__ kv, const float* __restrict__ qg, bf16* __restrict__ y_m) {
    __shared__ float qn[128], p[256], red[4];
    const int row = blockIdx.x >> 2, h = blockIdx.x & 3, b = row / SEQ, tid = threadIdx.x, wid = tid >> 6, lane = tid & 63;
    float qv = 0.f;
    if (tid < 128) qv = bf2f(proj_sm[(size_t)row * 2048 + 1536 + h * 128 + tid]);
    float s = wave_sum(qv * qv);
    if (lane == 0) red[wid] = s;
    __syncthreads();
    const float ss = red[0] + red[1];
    if (tid < 128) qn[tid] = qv * rsqrtf(ss * (1.f / 128.f) + NORM_EPS) * qg[tid];
    __syncthreads();
    const bf16* kr = kv + (size_t)(b * MEM_LEN + tid) * 1024 + h * 128;
    float sc = 0.f;
    for (int d = 0; d < 128; ++d) sc += qn[d] * bf2f(kr[d]);
    sc *= 0.08838834764831845f;
    float mx = wave_max(sc);
    __syncthreads();
    if (lane == 0) red[wid] = mx;
    __syncthreads();
    mx = fmaxf(fmaxf(red[0], red[1]), fmaxf(red[2], red[3]));
    const float e = __expf(sc - mx);
    float es = wave_sum(e);
    __syncthreads();
    if (lane == 0) red[wid] = es;
    p[tid] = e;
    __syncthreads();
    const float inv = 1.f / ((red[0] + red[1]) + (red[2] + red[3]));
    if (tid < 128) {
        float o = 0.f;
        const bf16* vr = kv + (size_t)(b * MEM_LEN) * 1024 + 512 + h * 128 + tid;
        for (int m = 0; m < 256; ++m) o += p[m] * bf2f(vr[(size_t)m * 1024]);
        y_m[(size_t)row * 512 + h * 128 + tid] = f2bf(o * inv);
    }
}

__global__ void __launch_bounds__(256) k_conv(const bf16* __restrict__ h, const float* __restrict__ cw, const float* __restrict__ cb, bf16* __restrict__ u, int row0, int pad) {
    const int lr = blockIdx.x, row = row0 + lr, t = row % SEQ;
    for (int ch = threadIdx.x; ch < DFF; ch += 256) {
        const int pn = ch >> 7, j = ch & 127, cg = 256 * pn + j, cv = cg + 128;
        float ga = cb[ch], va = cb[DFF + ch];
#pragma unroll
        for (int i = 0; i < 3; ++i) {
            const int dt = 2 - i;
            if (t - dt >= 0) {
                ga += bf2f(h[(size_t)(lr - dt) * DFF2 + cg]) * cw[i * DFF2 + ch];
                va += bf2f(h[(size_t)(lr - dt) * DFF2 + cv]) * cw[i * DFF2 + DFF + ch];
            }
        }
        u[(size_t)row * DFF + ch] = f2bf(ga * sigmoidf_(ga) * va);
    }
}

#define LAUNCH(k, g, b, ...) hipLaunchKernelGGL(k, g, b, 0, stream, __VA_ARGS__)
static void convert_w(hipStream_t stream, const float* src, int ldsrc, const float* scale, bf16* dst, int lddst, int koff, int N, int K, int mode) {
    const size_t n = (size_t)N * K;
    LAUNCH(k_wt, dim3((unsigned)((n + 255) / 256)), dim3(256), src, scale, dst, ldsrc, lddst, koff, N, K, mode);
}

extern "C" void kernel_launch(void* const* d_in, const int* in_sizes, int n_in, void* d_out, int out_size, void* d_ws, size_t ws_size, hipStream_t stream) {
    if (n_in != 31 || ws_size < 256 * MiB) { fprintf(stderr, "kernel_launch: unexpected n_in %d / ws %zu\n", n_in, ws_size); return; }
    const float* const* in = (const float* const*)d_in;
    const float* x0 = in[0]; const float* mem = in[1];
    unsigned char* ws = (unsigned char*)d_ws;
    float* xout = (float*)d_out;
    bf16* WinT = (bf16*)(ws + WS_WINT); bf16* WupT = (bf16*)(ws + WS_WUPT); bf16* WdnT = (bf16*)(ws + WS_WDNT); bf16* WbrT = (bf16*)(ws + WS_WBRT);
    bf16* WoutT = (bf16*)(ws + WS_WOUTT); bf16* Wlora = (bf16*)(ws + WS_WLORA); bf16* V1T = (bf16*)(ws + WS_V1T); bf16* V2T = (bf16*)(ws + WS_V2T);
    bf16* vfirst = (bf16*)(ws + WS_VFIRST); bf16* xbA = (bf16*)(ws + WS_XBA); bf16* kvmem = (bf16*)(ws + WS_KVMEM);
    float* ssq = (float*)(ws + WS_SSQ); float* nrm = (float*)(ws + WS_NRM); float* ssqm = (float*)(ws + WS_SSQM);

    {
        bf16* memb = (bf16*)(ws + RS(0)); bf16* WkvT = (bf16*)(ws + RS(1));
        LAUNCH(k_x_to_xb, dim3(MEM_ROWS / 4), dim3(256), mem, memb, ssqm, MEM_ROWS, 0);
        for (int l = 0; l < 2; ++l) {
            convert_w(stream, in[21] + (size_t)l * D * 1024, 1024, in[20] + l * D, WkvT, D, 0, 1024, D, 0);
            bf16* kv = kvmem + (size_t)l * MEM_ROWS * 1024;
            LAUNCH(gemm_ref<EpiRowScaleBf16>, dim3(1024 / 64, MEM_ROWS / 64), dim3(256), memb, WkvT, D, D, D, 0, EpiRowScaleBf16{kv, ssqm, 1024, 0});
            LAUNCH(k_memk_norm, dim3(MEM_ROWS), dim3(256), kv, in[23] + l * 128);
        }
        LAUNCH(k_x_to_xb, dim3(M / 4), dim3(256), x0, xbA, ssq, M, 0);
    }

    for (int l = 0; l < 2; ++l) {
        convert_w(stream, in[3] + (size_t)l * D * IN_COLS, IN_COLS, in[2] + l * D, WinT, D, 0, IN_COLS, D, 0);
        convert_w(stream, in[27] + (size_t)l * D * DFF2, DFF2, in[26] + l * D, WupT, D, 0, DFF2, D, 1);
        convert_w(stream, in[30] + (size_t)l * DFF * D, D, nullptr, WdnT, DFF, 0, D, DFF, 0);
        for (int b = 0; b < 3; ++b) convert_w(stream, in[24] + ((size_t)l * 3 + b) * 512 * D, D, nullptr, WbrT, 1536, b * 512, D, 512, 0);
        convert_w(stream, in[25] + (size_t)l * D * D, D, nullptr, WoutT, D, 0, D, D, 0);
        (void)hipMemsetAsync(Wlora, 0, 1536 * 256 * 2, stream);
        convert_w(stream, in[6] + (size_t)l * 64 * 512, 512, nullptr, Wlora, 256, 0, 512, 64, 0);
        convert_w(stream, in[8] + (size_t)l * 64 * 512, 512, nullptr, Wlora + 512 * 256, 256, 64, 512, 64, 0);
        convert_w(stream, in[9] + (size_t)l * 128 * 512, 512, nullptr, Wlora + 1024 * 256, 256, 128, 512, 128, 0);
        if (l == 1) {
            (void)hipMemsetAsync(V1T, 0, 256 * 512 * 2, stream); (void)hipMemsetAsync(V2T, 0, 512 * 256 * 2, stream);
            convert_w(stream, in[16], 32, nullptr, V1T, 512, 0, 32, 512, 0);
            convert_w(stream, in[17], 512, nullptr, V2T, 256, 0, 512, 32, 0);
        }
        const float* xin = (l == 0) ? x0 : xout;
        bf16* proj_r = (bf16*)(ws + RS(0));
        bf16* r_s = (bf16*)(ws + RS(4)); bf16* k_s = (bf16*)(ws + RS(5)); bf16* v_s = (l == 0) ? vfirst : (bf16*)(ws + RS(6)); bf16* lora_in = (bf16*)(ws + RS(7));
        f16* ld = (f16*)(ws + RS(0)); bf16* a = (bf16*)(ws + RS(1)); bf16* g = (bf16*)(ws + RS(2)); bf16* t1 = (bf16*)(ws + RS(3)); bf16* vp = (bf16*)(ws + RS(8));
        bf16* y_raw = (bf16*)(ws + RS(9)); bf16* y_a = (bf16*)(ws + RS(0)); bf16* y_b = (bf16*)(ws + RS(1)); bf16* y_m = (bf16*)(ws + RS(2));
        bf16* proj_sm = (bf16*)(ws + RS(3)); bf16* gates = (bf16*)(ws + RS(3)); bf16* merged = xbA; bf16* xb2 = (bf16*)(ws + RS(0));
        bf16* u = (bf16*)(ws + RS(2)); bf16* hb = (bf16*)(ws + RS(8));

        LAUNCH(gemm_ref<EpiRowScaleBf16>, dim3(RWKV_COLS / 64, M / 64), dim3(256), xbA, WinT, D, D, D, 0, EpiRowScaleBf16{proj_r, ssq, RWKV_COLS, 0});
        LAUNCH(k_shift, dim3(M), dim3(256), proj_r, in[4] + l * RWKV_COLS, in[10] + l * 512, r_s, k_s, v_s, lora_in, nrm);
        LAUNCH(gemm_ref<EpiLora>, dim3(1536 / 64, M / 64), dim3(256), lora_in, Wlora, 256, 256, 256, 0, EpiLora{ld, a, g, in[5] + l * 512, in[7] + l * 512});
        const bf16* vuse = v_s;
        if (l == 1) {
            LAUNCH(gemm_ref<EpiPlainBf16>, dim3(256 / 64, M / 64), dim3(256), v_s, V1T, 512, 512, 512, 0, EpiPlainBf16{t1, 256, 0});
            LAUNCH(gemm_ref<EpiVres>, dim3(512 / 64, M / 64), dim3(256), t1, V2T, 256, 256, 256, 0, EpiVres{v_s, vfirst, in[15], vp});
            vuse = vp;
        }
        LAUNCH(scan_ref, dim3(64), dim3(64), r_s, k_s, vuse, a, ld, nrm, in[10] + l * 512, in[11] + l * 512, y_raw);
        LAUNCH(k_post, dim3(M), dim3(512), y_raw, r_s, k_s, a, vuse, g, in[11] + l * 512, in[12] + l * 512, in[13] + l * 512, in[14] + l * 512, y_a);
        LAUNCH(gemm_ref<EpiRowScaleBf16>, dim3(2048 / 64, M / 64), dim3(256), xbA, WinT + (size_t)RWKV_COLS * D, D, D, D, 0, EpiRowScaleBf16{proj_sm, ssq, 2048, 0});
        LAUNCH(sb_attn_ref, dim3(SEQ / 64, 64), dim3(64), proj_sm, in[18] + l * 64, in[19] + l * 64, y_b);
        LAUNCH(mem_attn_ref, dim3(M * 4), dim3(256), proj_sm, kvmem + (size_t)l * MEM_ROWS * 1024, in[22] + l * 128, y_m);
        LAUNCH(gemm_ref<EpiRowScaleBf16>, dim3(3072 / 64, M / 64), dim3(256), xbA, WinT + (size_t)3840 * D, D, D, D, 0, EpiRowScaleBf16{gates, ssq, 3072, 1});
        LAUNCH(gemm_gated_ref, dim3(D / 64, M / 64), dim3(256), y_a, y_b, y_m, WbrT, gates, merged);
        LAUNCH(gemm_ref<EpiResidual>, dim3(D / 64, M / 64), dim3(256), merged, WoutT, D, D, D, 0, EpiResidual{xin, xout});
        LAUNCH(k_x_to_xb, dim3(M / 4), dim3(256), xout, xb2, ssq, M, 0);
        for (int b = 0; b < BATCH; ++b) {
            LAUNCH(gemm_ref<EpiRowScaleBf16>, dim3(DFF2 / 64, SEQ / 64), dim3(256), xb2 + (size_t)b * SEQ * D, WupT, D, D, D, 0, EpiRowScaleBf16{hb, ssq + (size_t)b * SEQ * 4, DFF2, 0});
            LAUNCH(k_conv, dim3(SEQ), dim3(256), hb, in[28] + (size_t)l * 3 * DFF2, in[29] + (size_t)l * DFF2, u, b * SEQ, 0);
        }
        LAUNCH(gemm_ref<EpiResidual>, dim3(D / 64, M / 64), dim3(256), u, WdnT, DFF, DFF, DFF, 0, EpiResidual{xout, xout});
        if (l == 0) LAUNCH(k_x_to_xb, dim3(M / 4), dim3(256), xout, xbA, ssq, M, 0);
    }
}
```

```cpp
#include <hip/hip_runtime.h>
#include <hip/hip_cooperative_groups.h>
#include <cstdint>
#include <cstdio>

typedef unsigned short bf16;
typedef _Float16 f16;

constexpr int BATCH = 8, SEQ = 2048, D = 1024, M = BATCH * SEQ;
constexpr int RW = 512, NH = 8, HD = 64;
constexpr int RWKV_COLS = 1792, IN_COLS = 6912;
constexpr int MEM_LEN = 256, MEM_ROWS = BATCH * MEM_LEN;
constexpr int DFF = 2816, DFF2 = 5632;
constexpr float NORM_EPS = 1e-6f, LNX_EPS = 64e-5f;

constexpr size_t MiB = 1u << 20;
constexpr size_t WS_CTL = 0;
constexpr size_t WS_WINT = 1 * MiB;
constexpr size_t WS_WUPT = WS_WINT + 13 * MiB + MiB / 2;
constexpr size_t WS_WDNT = WS_WUPT + 11 * MiB;
constexpr size_t WS_WBRT = WS_WDNT + 5 * MiB + MiB / 2;
constexpr size_t WS_WOUTT = WS_WBRT + 3 * MiB;
constexpr size_t WS_WLORA = WS_WOUTT + 2 * MiB;
constexpr size_t WS_V1T = WS_WLORA + 3 * MiB / 4;
constexpr size_t WS_V2T = WS_V1T + MiB / 4;
constexpr size_t WS_VFIRST = 38 * MiB;
constexpr size_t WS_XBA = 54 * MiB;
constexpr size_t WS_KVMEM = 86 * MiB;
constexpr size_t WS_SSQ = 94 * MiB;
constexpr size_t WS_NRM = 95 * MiB;
constexpr size_t WS_SSQM = WS_NRM + MiB / 2;
constexpr size_t WS_R = 96 * MiB;
constexpr size_t SLOT = 16 * MiB;
#define RS(i) (WS_R + (size_t)(i) * SLOT)
static_assert(WS_V2T + MiB / 4 <= WS_VFIRST, "weights region");
static_assert(RS(10) <= 256 * MiB, "ws");

__device__ __forceinline__ float bf2f(bf16 v) { return __uint_as_float((unsigned)v << 16); }
__device__ __forceinline__ bf16 f2bf(float f) { unsigned u = __float_as_uint(f); return (bf16)((u + 0x7fffu + ((u >> 16) & 1u)) >> 16); }
__device__ __forceinline__ float sigmoidf_(float x) { return 1.f / (1.f + __expf(-x)); }
__device__ __forceinline__ float softplusf_(float x) { return fmaxf(x, 0.f) + log1pf(__expf(-fabsf(x))); }
__device__ __forceinline__ float wave_sum(float v) {
#pragma unroll
    for (int o = 1; o < 64; o <<= 1) v += __shfl_xor(v, o);
    return v;
}
__device__ __forceinline__ float wave_max(float v) {
#pragma unroll
    for (int o = 1; o < 64; o <<= 1) v = fmaxf(v, __shfl_xor(v, o));
    return v;
}
__device__ __forceinline__ float rstd_of(const float* ssq, int r) {
    const float4* p = (const float4*)(ssq + 16 * (size_t)r);
    const float4 a = p[0], b = p[1], c = p[2], d = p[3];
    const float s = (((a.x + a.y) + (a.z + a.w)) + ((b.x + b.y) + (b.z + b.w))) + (((c.x + c.y) + (c.z + c.w)) + ((d.x + d.y) + (d.z + d.w)));
    return rsqrtf(s * (1.f / 1024.f) + NORM_EPS);
}

__global__ void k_wt(const float* __restrict__ src, const float* __restrict__ scale, bf16* __restrict__ dst, int ldsrc, int lddst, int koff, int N, int K, int mode) {
    const size_t idx = (size_t)blockIdx.x * blockDim.x + threadIdx.x;
    if (idx >= (size_t)N * K) return;
    const int n = (int)(idx / K), k = (int)(idx % K);
    int sc = n;
    if (mode == 1) { const int pn = n >> 8, j = n & 255; sc = (j < 128) ? (128 * pn + j) : (DFF + 128 * pn + (j - 128)); }
    float v = src[(size_t)k * ldsrc + sc];
    if (scale) v *= scale[k];
    dst[(size_t)n * lddst + koff + k] = f2bf(v);
}

__global__ void k_x_to_xb(const float* __restrict__ x, bf16* __restrict__ xb, float* __restrict__ ssq, int rows, int pad) {
    const int row = blockIdx.x * 4 + (threadIdx.x >> 6), lane = threadIdx.x & 63;
    if (row >= rows) return;
    const float* xr = x + (size_t)row * D;
#pragma unroll
    for (int q = 0; q < 4; ++q) {
        const float4 v = *(const float4*)(xr + q * 256 + lane * 4);
        float s = (v.x * v.x + v.y * v.y) + (v.z * v.z + v.w * v.w);
        s += __shfl_xor(s, 1); s += __shfl_xor(s, 2); s += __shfl_xor(s, 4); s += __shfl_xor(s, 8);
        if ((lane & 15) == 0) ssq[(size_t)row * 16 + q * 4 + (lane >> 4)] = s;
        ushort4 o; o.x = f2bf(v.x); o.y = f2bf(v.y); o.z = f2bf(v.z); o.w = f2bf(v.w);
        *(ushort4*)(xb + (size_t)row * D + q * 256 + lane * 4) = o;
    }
}

struct EpiRowScaleBf16 { bf16* out; const float* ssq; int ldo; int act;
    __device__ __forceinline__ void operator()(int r, int c, float acc) const { float v = acc * rstd_of(ssq, r); if (act == 1) v = sigmoidf_(v); out[(size_t)r * ldo + c] = f2bf(v); } };
struct EpiPlainBf16 { bf16* out; int ldo; int pad;
    __device__ __forceinline__ void operator()(int r, int c, float acc) const { out[(size_t)r * ldo + c] = f2bf(acc); } };
struct EpiLora { f16* ld; bf16* a; bf16* g; const float* w0; const float* a0;
    __device__ __forceinline__ void operator()(int r, int c, float acc) const {
        if (c < 512) { const float wr = w0[c] + acc; const float w = -softplusf_(-wr) - 0.5f; ld[(size_t)r * 512 + c] = (f16)(-__expf(w)); }
        else if (c < 1024) { a[(size_t)r * 512 + c - 512] = f2bf(sigmoidf_(a0[c - 512] + acc)); }
        else { g[(size_t)r * 512 + c - 1024] = f2bf(acc); } } };
struct EpiVres { const bf16* v; const bf16* vf; const float* v0; bf16* out;
    __device__ __forceinline__ void operator()(int r, int c, float acc) const {
        const size_t i = (size_t)r * 512 + c; const float vv = bf2f(v[i]), f = bf2f(vf[i]);
        out[i] = f2bf(vv + (f - vv) * sigmoidf_(v0[c] + acc)); } };
struct EpiResidual { const float* xin; float* xout;
    __device__ __forceinline__ void operator()(int r, int c, float acc) const { const size_t i = (size_t)r * D + c; xout[i] = xin[i] + acc; } };

template <class Epi>
__global__ void __launch_bounds__(256) gemm_ref(const bf16* __restrict__ A, const bf16* __restrict__ Bt, int lda, int ldb, int K, int pad, Epi epi) {
    __shared__ float As[16][65], Bs[16][65];
    const int tx = threadIdx.x & 15, ty = threadIdx.x >> 4;
    const int r0 = blockIdx.y * 64, c0 = blockIdx.x * 64;
    const int lr = threadIdx.x >> 2, lk = (threadIdx.x & 3) * 4;
    float acc[4][4];
#pragma unroll
    for (int i = 0; i < 4; ++i)
#pragma unroll
        for (int j = 0; j < 4; ++j) acc[i][j] = 0.f;
    for (int k0 = 0; k0 < K; k0 += 16) {
        const ushort4 av = *(const ushort4*)(A + (size_t)(r0 + lr) * lda + k0 + lk);
        const ushort4 bv = *(const ushort4*)(Bt + (size_t)(c0 + lr) * ldb + k0 + lk);
        As[lk + 0][lr] = bf2f(av.x); As[lk + 1][lr] = bf2f(av.y); As[lk + 2][lr] = bf2f(av.z); As[lk + 3][lr] = bf2f(av.w);
        Bs[lk + 0][lr] = bf2f(bv.x); Bs[lk + 1][lr] = bf2f(bv.y); Bs[lk + 2][lr] = bf2f(bv.z); Bs[lk + 3][lr] = bf2f(bv.w);
        __syncthreads();
#pragma unroll
        for (int kk = 0; kk < 16; ++kk) {
            float a[4], b[4];
#pragma unroll
            for (int i = 0; i < 4; ++i) { a[i] = As[kk][ty * 4 + i]; b[i] = Bs[kk][tx * 4 + i]; }
#pragma unroll
            for (int i = 0; i < 4; ++i)
#pragma unroll
                for (int j = 0; j < 4; ++j) acc[i][j] += a[i] * b[j];
        }
        __syncthreads();
    }
#pragma unroll
    for (int i = 0; i < 4; ++i)
#pragma unroll
        for (int j = 0; j < 4; ++j) epi(r0 + ty * 4 + i, c0 + tx * 4 + j, acc[i][j]);
}

__global__ void __launch_bounds__(256) gemm_gated_ref(const bf16* __restrict__ ya, const bf16* __restrict__ yb, const bf16* __restrict__ ym, const bf16* __restrict__ WbrT,
                                                      const bf16* __restrict__ gates, bf16* __restrict__ merged) {
    __shared__ float As[16][65], Bs[16][65];
    const int tx = threadIdx.x & 15, ty = threadIdx.x >> 4;
    const int r0 = blockIdx.y * 64, c0 = blockIdx.x * 64;
    const int lr = threadIdx.x >> 2, lk = (threadIdx.x & 3) * 4;
    float tot[4][4];
#pragma unroll
    for (int i = 0; i < 4; ++i)
#pragma unroll
        for (int j = 0; j < 4; ++j) tot[i][j] = 0.f;
    for (int b = 0; b < 3; ++b) {
        const bf16* A = b == 0 ? ya : (b == 1 ? yb : ym);
        float acc[4][4];
#pragma unroll
        for (int i = 0; i < 4; ++i)
#pragma unroll
            for (int j = 0; j < 4; ++j) acc[i][j] = 0.f;
        for (int k0 = 0; k0 < 512; k0 += 16) {
            const ushort4 av = *(const ushort4*)(A + (size_t)(r0 + lr) * 512 + k0 + lk);
            const ushort4 bv = *(const ushort4*)(WbrT + (size_t)(c0 + lr) * 1536 + b * 512 + k0 + lk);
            As[lk + 0][lr] = bf2f(av.x); As[lk + 1][lr] = bf2f(av.y); As[lk + 2][lr] = bf2f(av.z); As[lk + 3][lr] = bf2f(av.w);
            Bs[lk + 0][lr] = bf2f(bv.x); Bs[lk + 1][lr] = bf2f(bv.y); Bs[lk + 2][lr] = bf2f(bv.z); Bs[lk + 3][lr] = bf2f(bv.w);
            __syncthreads();
#pragma unroll
            for (int kk = 0; kk < 16; ++kk) {
                float a[4], bb[4];
#pragma unroll
                for (int i = 0; i < 4; ++i) { a[i] = As[kk][ty * 4 + i]; bb[i] = Bs[kk][tx * 4 + i]; }
#pragma unroll
                for (int i = 0; i < 4; ++i)
#pragma unroll
                    for (int j = 0; j < 4; ++j) acc[i][j] += a[i] * bb[j];
            }
            __syncthreads();
        }
#pragma unroll
        for (int i = 0; i < 4; ++i)
#pragma unroll
            for (int j = 0; j < 4; ++j) { const int r = r0 + ty * 4 + i, c = c0 + tx * 4 + j; tot[i][j] += bf2f(gates[(size_t)r * 3072 + b * 1024 + c]) * acc[i][j]; }
    }
#pragma unroll
    for (int i = 0; i < 4; ++i)
#pragma unroll
        for (int j = 0; j < 4; ++j) merged[(size_t)(r0 + ty * 4 + i) * D + c0 + tx * 4 + j] = f2bf(tot[i][j]);
}


namespace pg8 {
#define PG8_LAS __attribute__((address_space(3)))
typedef unsigned short bf16_t;
typedef short bf16x8 __attribute__((ext_vector_type(8)));
typedef float f32x4 __attribute__((ext_vector_type(4)));
typedef unsigned u32x4 __attribute__((ext_vector_type(4)));
typedef unsigned u32x2 __attribute__((ext_vector_type(2)));
constexpr int BM = 256, BK = 64, HALF = 128, HTB = HALF * BK * 2, STAGE_BYTES = 8 * HTB, NXCD = 8, WGM = 8;

__host__ __device__ __forceinline__ int lds_byte(int r, int c) { const int st = (r >> 4) * 2 + (c >> 5), rr = r & 15, cc = c & 31, ob = rr * 64 + cc * 2; return st * 1024 + (ob ^ (((ob >> 9) & 1) << 5)); }
__host__ __device__ __forceinline__ void stage_rc(int b, int& R, int& C) { const int st = b / 1024, sb = b % 1024, swz = sb ^ (((sb >> 9) & 1) << 5); R = (st >> 1) * 16 + swz / 64; C = (st & 1) * 32 + (swz % 64) / 2; }
__host__ __device__ __forceinline__ int perm32(int rho) { const int n = rho >> 4, i = rho & 15; return 8 * (i >> 2) + 4 * n + (i & 3); }

struct Unit { int pm, pn; };
struct Gemm { const bf16_t* A; const bf16_t* A1; const bf16_t* A2; const bf16_t* Bt; int M, N, K, lda, seg_tiles, pad; };

struct StaticOrder {
    int nM, nN, nwg, G, c;
    __host__ __device__ void init(int M, int N, int G_, int c_) { nM = M / BM; nN = N / BM; nwg = nM * nN; G = G_; c = c_; }
    __host__ __device__ bool next(int i, Unit& u) const {
        const long L = (long)i * G + c; if (L >= nwg) return false;
        int wgid = (int)L; { const int q = nwg / NXCD, r = nwg % NXCD, xcd = wgid % NXCD, off = wgid / NXCD; wgid = (xcd < r ? xcd * (q + 1) : r * (q + 1) + (xcd - r) * q) + off; }
        const int nig = WGM * nN, gid = wgid / nig, fm = gid * WGM, gsz = (nM - fm) < WGM ? (nM - fm) : WGM;
        u.pm = fm + ((wgid % nig) % gsz); u.pn = (wgid % nig) / gsz; return true;
    }
};

__device__ __forceinline__ unsigned cvt_pk_bf16(float lo, float hi) { unsigned r; asm volatile("v_cvt_pk_bf16_f32 %0, %1, %2" : "=v"(r) : "v"(lo), "v"(hi)); return r; }

template <class Epi, bool ALIGN_EPI>
__device__ __forceinline__ void gemm_phase(PG8_LAS unsigned char* lds, const Gemm g, const StaticOrder& S, const Epi& E) {
    const int tid = threadIdx.x, wid = __builtin_amdgcn_readfirstlane(tid >> 6), lane = tid & 63, wr = wid >> 2, wc = wid & 3, fr = lane & 15, fq = lane >> 4;
    const int K = g.K, nt = K / BK, lda = g.lda, segt = g.seg_tiles;
    unsigned voffA[2], voffB[2];
#pragma unroll
    for (int i = 0; i < 2; ++i) { int R, C; stage_rc(tid * 16 + i * 8192, R, C); const int Rb = Epi::PERM ? ((R & ~31) + perm32(R & 31)) : R;
        voffA[i] = (unsigned)(R * lda + C) * 2u; voffB[i] = (unsigned)(Rb * K + C) * 2u; }
    const size_t kstep = (size_t)(BK * 2);
    const size_t hstepA = (size_t)HALF * lda * 2, hstepB = (size_t)HALF * K * 2;
    const size_t tstepA = 2 * hstepA, tstepB = 2 * hstepB;
    const unsigned ldsw = (unsigned)wid * 1024u;
    const int aoff = lds_byte(wr * 64 + fr, fq * 8), boff = lds_byte(wc * 32 + fr, fq * 8);
    auto atile = [&](int pm, int t) -> const char* { const int s = t / segt; const bf16_t* b = (s == 0) ? g.A : ((s == 1) ? g.A1 : g.A2); return (const char*)b + (size_t)pm * tstepA + (size_t)(t - s * segt) * kstep; };
#define PG8_SA(b, h) (((b) * 2 + (h)) * HTB)
#define PG8_SB(b, h) ((4 + (b) * 2 + (h)) * HTB)
#define PG8_STAGE(bufoff, gbase, voff) do { _Pragma("unroll") for (int _i = 0; _i < 2; ++_i) \
        __builtin_amdgcn_global_load_lds((const unsigned*)((const char*)(gbase) + (voff)[_i]), (PG8_LAS unsigned*)(lds + (bufoff) + ldsw + _i * 8192), 16, 0, 0); } while (0)
#define PG8_LDA(dst, b, h) do { _Pragma("unroll") for (int m = 0; m < 4; ++m) _Pragma("unroll") for (int k = 0; k < 2; ++k) dst[m][k] = *(const PG8_LAS bf16x8*)(lds + PG8_SA(b, h) + aoff + m * 2048 + k * 1024); } while (0)
#define PG8_LDB(dst, b, h) do { _Pragma("unroll") for (int n = 0; n < 2; ++n) _Pragma("unroll") for (int k = 0; k < 2; ++k) dst[n][k] = *(const PG8_LAS bf16x8*)(lds + PG8_SB(b, h) + boff + n * 2048 + k * 1024); } while (0)
#define PG8_MMA(ai, bj, At, Bt) do { __builtin_amdgcn_s_setprio(1); _Pragma("unroll") for (int m = 0; m < 4; ++m) _Pragma("unroll") for (int n = 0; n < 2; ++n) _Pragma("unroll") for (int k = 0; k < 2; ++k) \
        acc[ai][bj][m][n] = __builtin_amdgcn_mfma_f32_16x16x32_bf16(Bt[n][k], At[m][k], acc[ai][bj][m][n], 0, 0, 0); __builtin_amdgcn_s_setprio(0); } while (0)
#define PG8_WAIT_V(n) asm volatile("s_waitcnt vmcnt(" #n ")" ::: "memory")
#define PG8_WAIT_L(n) asm volatile("s_waitcnt lgkmcnt(" #n ")" ::: "memory")
#define PG8_BAR __builtin_amdgcn_s_barrier()
#define PG8_SCHED __builtin_amdgcn_sched_barrier(0)
    Unit cur, nxt; int ui = 0;
    if (!S.next(0, cur)) return;
    f32x4 acc[2][2][4][2];
#pragma unroll
    for (int a = 0; a < 2; ++a)
#pragma unroll
        for (int b = 0; b < 2; ++b)
#pragma unroll
            for (int m = 0; m < 4; ++m)
#pragma unroll
                for (int n = 0; n < 2; ++n) acc[a][b][m][n] = (f32x4){0.f, 0.f, 0.f, 0.f};
    bf16x8 At[4][2], B0[2][2], B1[2][2];
    const char* cB = (const char*)g.Bt + (size_t)cur.pn * tstepB;
    {
        const char* cA0 = atile(cur.pm, 0); const char* cA1 = atile(cur.pm, 1);
        PG8_STAGE(PG8_SB(0, 0), cB, voffB); PG8_STAGE(PG8_SB(0, 1), cB + hstepB, voffB); PG8_STAGE(PG8_SA(0, 0), cA0, voffA); PG8_STAGE(PG8_SA(0, 1), cA0 + hstepA, voffA);
        if (wr == 1) PG8_BAR;
        PG8_WAIT_V(2); PG8_BAR;
        PG8_STAGE(PG8_SB(1, 0), cB + kstep, voffB); PG8_STAGE(PG8_SA(1, 0), cA1, voffA); PG8_STAGE(PG8_SB(1, 1), cB + hstepB + kstep, voffB);
        PG8_WAIT_V(6); PG8_BAR;
    }
    for (;;) {
        const bool has_next = S.next(ui + 1, nxt);
        const int npm = has_next ? nxt.pm : cur.pm;
        const char* nB = has_next ? (const char*)g.Bt + (size_t)nxt.pn * tstepB : cB;
        for (int t = 0; t < nt; t += 2) {
            const bool last = (t == nt - 2);
            if constexpr (Epi::HAS_HOOK) E.khook(acc, cur, t, wr, wc, fr, fq);
            const char* a1 = atile(cur.pm, t + 1);
            const char* a2 = last ? atile(npm, 0) : atile(cur.pm, t + 2); const char* b2 = last ? nB : cB + (size_t)(t + 2) * kstep;
            const char* a3 = last ? atile(npm, 1) : atile(cur.pm, t + 3); const char* b3 = b2 + kstep;
            PG8_LDB(B0, 0, 0); PG8_LDB(B1, 0, 1); PG8_SCHED; PG8_LDA(At, 0, 0); PG8_STAGE(PG8_SA(1, 1), a1 + hstepA, voffA);
            PG8_WAIT_V(8); PG8_WAIT_L(0); PG8_BAR; PG8_MMA(0, 0, At, B0); PG8_MMA(0, 1, At, B1); PG8_BAR; PG8_SCHED;
            PG8_LDA(At, 0, 1); PG8_STAGE(PG8_SB(0, 0), b2, voffB); PG8_STAGE(PG8_SB(0, 1), b2 + hstepB, voffB); PG8_STAGE(PG8_SA(0, 0), a2, voffA);
            PG8_WAIT_V(8); PG8_WAIT_L(0); PG8_BAR; PG8_MMA(1, 0, At, B0); PG8_MMA(1, 1, At, B1); PG8_BAR; PG8_SCHED;
            PG8_LDB(B0, 1, 0); PG8_LDB(B1, 1, 1); PG8_SCHED; PG8_LDA(At, 1, 0); PG8_STAGE(PG8_SA(0, 1), a2 + hstepA, voffA);
            PG8_WAIT_V(8); PG8_WAIT_L(0); PG8_BAR; PG8_MMA(0, 0, At, B0); PG8_MMA(0, 1, At, B1); PG8_BAR; PG8_SCHED;
            PG8_LDA(At, 1, 1); PG8_STAGE(PG8_SB(1, 0), b3, voffB); PG8_STAGE(PG8_SB(1, 1), b3 + hstepB, voffB); PG8_STAGE(PG8_SA(1, 0), a3, voffA);
            PG8_WAIT_V(8); PG8_WAIT_L(0); PG8_BAR; PG8_MMA(1, 0, At, B0); PG8_MMA(1, 1, At, B1); PG8_BAR; PG8_SCHED;
        }
        if constexpr (ALIGN_EPI) { if (wr == 0) PG8_BAR; }
        E(acc, cur, wr, wc, fr, fq);
        if (!has_next) break;
#pragma unroll
        for (int a = 0; a < 2; ++a)
#pragma unroll
            for (int b = 0; b < 2; ++b)
#pragma unroll
                for (int m = 0; m < 4; ++m)
#pragma unroll
                    for (int n = 0; n < 2; ++n) acc[a][b][m][n] = (f32x4){0.f, 0.f, 0.f, 0.f};
        cur = nxt; cB = nB; ++ui;
        if constexpr (ALIGN_EPI) { if (wr == 1) PG8_BAR; }
    }
    PG8_WAIT_V(0);
    if constexpr (!ALIGN_EPI) { if (wr == 0) PG8_BAR; }
    PG8_BAR;
#undef PG8_SA
#undef PG8_SB
#undef PG8_STAGE
#undef PG8_LDA
#undef PG8_LDB
#undef PG8_MMA
#undef PG8_WAIT_V
#undef PG8_WAIT_L
#undef PG8_BAR
#undef PG8_SCHED
}

__device__ __forceinline__ float rstd16(const float* ssq, int r) {
    const f32x4* p = (const f32x4*)(ssq + 16 * (size_t)r);
    const f32x4 a = p[0], b = p[1], c = p[2], d = p[3];
    const float s = (((a[0] + a[1]) + (a[2] + a[3])) + ((b[0] + b[1]) + (b[2] + b[3]))) + (((c[0] + c[1]) + (c[2] + c[3])) + ((d[0] + d[1]) + (d[2] + d[3])));
    return rsqrtf(s * (1.f / 1024.f) + 1e-6f);
}
__device__ __forceinline__ float sigm(float x) { return __builtin_amdgcn_rcpf(1.f + __expf(-x)); }

struct EpiRowScale {
    static constexpr bool PERM = true, HAS_HOOK = false;
    bf16_t* O; const float* ssq; int ldc; int act;
    __device__ __forceinline__ void operator()(const f32x4 (&acc)[2][2][4][2], const Unit& u, int wr, int wc, int fr, int fq) const {
        const int row0 = u.pm * BM + wr * 64 + fr, col0 = u.pn * BM + wc * 32 + 8 * fq;
#pragma unroll
        for (int ai = 0; ai < 2; ++ai)
#pragma unroll
            for (int m = 0; m < 4; ++m) { const int r = row0 + ai * HALF + m * 16; const float rs = ssq ? rstd16(ssq, r) : 1.f; bf16_t* rowp = O + (size_t)r * ldc + col0;
#pragma unroll
                for (int bj = 0; bj < 2; ++bj) { f32x4 v0 = acc[ai][bj][m][0] * rs, v1 = acc[ai][bj][m][1] * rs;
                    if (act == 1) {
#pragma unroll
                        for (int i = 0; i < 4; ++i) { v0[i] = sigm(v0[i]); v1[i] = sigm(v1[i]); } }
                    u32x4 w; w.x = cvt_pk_bf16(v0[0], v0[1]); w.y = cvt_pk_bf16(v0[2], v0[3]); w.z = cvt_pk_bf16(v1[0], v1[1]); w.w = cvt_pk_bf16(v1[2], v1[3]);
                    *(u32x4*)(rowp + bj * HALF) = w; } }
    }
};
__device__ __forceinline__ unsigned pk_f16(float lo, float hi) { const _Float16 a = (_Float16)lo, b = (_Float16)hi; return (unsigned)__builtin_bit_cast(unsigned short, a) | ((unsigned)__builtin_bit_cast(unsigned short, b) << 16); }
struct EpiLora {
    static constexpr bool PERM = true, HAS_HOOK = false;
    unsigned short* ld; bf16_t* a; bf16_t* g; const float* w0; const float* a0;
    __device__ __forceinline__ void operator()(const f32x4 (&acc)[2][2][4][2], const Unit& u, int wr, int wc, int fr, int fq) const {
        const int kind = u.pn >> 1;
        const int row0 = u.pm * BM + wr * 64 + fr, col0 = (u.pn & 1) * BM + wc * 32 + 8 * fq;
        unsigned short* O = kind == 0 ? ld : (kind == 1 ? a : g);
        const float* bias = kind == 0 ? w0 : a0;
        f32x4 bv[2][2];
#pragma unroll
        for (int bj = 0; bj < 2; ++bj)
#pragma unroll
            for (int n = 0; n < 2; ++n) bv[bj][n] = (kind < 2) ? *(const f32x4*)(bias + col0 + bj * HALF + 4 * n) : (f32x4){0.f, 0.f, 0.f, 0.f};
#pragma unroll
        for (int ai = 0; ai < 2; ++ai)
#pragma unroll
            for (int m = 0; m < 4; ++m) { unsigned short* rowp = O + (size_t)(row0 + ai * HALF + m * 16) * 512 + col0;
#pragma unroll
                for (int bj = 0; bj < 2; ++bj) { float o[8];
#pragma unroll
                    for (int i = 0; i < 8; ++i) o[i] = acc[ai][bj][m][i >> 2][i & 3] + bv[bj][i >> 2][i & 3];
                    u32x4 w;
                    if (kind == 0) {
#pragma unroll
                        for (int i = 0; i < 8; ++i) { const float x = -o[i]; const float sp = fmaxf(x, 0.f) + __logf(1.f + __expf(-fabsf(x))); o[i] = -__expf(-sp - 0.5f); }
                        w.x = pk_f16(o[0], o[1]); w.y = pk_f16(o[2], o[3]); w.z = pk_f16(o[4], o[5]); w.w = pk_f16(o[6], o[7]);
                    } else {
                        if (kind == 1) {
#pragma unroll
                            for (int i = 0; i < 8; ++i) o[i] = sigm(o[i]); }
                        w.x = cvt_pk_bf16(o[0], o[1]); w.y = cvt_pk_bf16(o[2], o[3]); w.z = cvt_pk_bf16(o[4], o[5]); w.w = cvt_pk_bf16(o[6], o[7]);
                    }
                    *(u32x4*)(rowp + bj * HALF) = w; } }
    }
};
__device__ __forceinline__ float bfl(unsigned w) { return __uint_as_float(w << 16); }
__device__ __forceinline__ float bfh(unsigned w) { return __uint_as_float(w & 0xffff0000u); }
struct EpiVres {
    static constexpr bool PERM = true, HAS_HOOK = false;
    const bf16_t* v; const bf16_t* vf; const float* v0; bf16_t* O;
    __device__ __forceinline__ void operator()(const f32x4 (&acc)[2][2][4][2], const Unit& u, int wr, int wc, int fr, int fq) const {
        const int row0 = u.pm * BM + wr * 64 + fr, col0 = u.pn * BM + wc * 32 + 8 * fq;
#pragma unroll
        for (int ai = 0; ai < 2; ++ai)
#pragma unroll
            for (int m = 0; m < 4; ++m) { const size_t off = (size_t)(row0 + ai * HALF + m * 16) * 512 + col0;
#pragma unroll
                for (int bj = 0; bj < 2; ++bj) {
                    const u32x4 vv = *(const u32x4*)(v + off + bj * HALF), ff = *(const u32x4*)(vf + off + bj * HALF);
                    const f32x4 b0 = *(const f32x4*)(v0 + col0 + bj * HALF), b1 = *(const f32x4*)(v0 + col0 + bj * HALF + 4);
                    float o[8];
#pragma unroll
                    for (int i = 0; i < 8; ++i) { const unsigned vw = vv[i >> 1], fw = ff[i >> 1]; const float x = (i & 1) ? bfh(vw) : bfl(vw), f = (i & 1) ? bfh(fw) : bfl(fw);
                        const float z = ((i < 4) ? b0[i & 3] : b1[i & 3]) + acc[ai][bj][m][i >> 2][i & 3]; o[i] = x + (f - x) * sigm(z); }
                    u32x4 w; w.x = cvt_pk_bf16(o[0], o[1]); w.y = cvt_pk_bf16(o[2], o[3]); w.z = cvt_pk_bf16(o[4], o[5]); w.w = cvt_pk_bf16(o[6], o[7]);
                    *(u32x4*)(O + off + bj * HALF) = w; } }
    }
};
struct EpiResidual {
    static constexpr bool PERM = false, HAS_HOOK = false;
    const float* xin; float* xout; bf16_t* xb; float* ssq;
    __device__ __forceinline__ void operator()(const f32x4 (&acc)[2][2][4][2], const Unit& u, int wr, int wc, int fr, int fq) const {
        const int row0 = u.pm * BM + wr * 64 + fr, col0 = u.pn * BM + wc * 32 + 4 * fq;
#pragma unroll
        for (int ai = 0; ai < 2; ++ai)
#pragma unroll
            for (int m = 0; m < 4; ++m) { const int r = row0 + ai * HALF + m * 16; const size_t off = (size_t)r * 1024 + col0; float s = 0.f;
#pragma unroll
                for (int bj = 0; bj < 2; ++bj)
#pragma unroll
                    for (int n = 0; n < 2; ++n) { const size_t o = off + bj * HALF + n * 16; const f32x4 x = *(const f32x4*)(xin + o) + acc[ai][bj][m][n];
                        *(f32x4*)(xout + o) = x; s += (x[0] * x[0] + x[1] * x[1]) + (x[2] * x[2] + x[3] * x[3]);
                        u32x2 w; w.x = cvt_pk_bf16(x[0], x[1]); w.y = cvt_pk_bf16(x[2], x[3]); *(u32x2*)(xb + o) = w; }
                s += __shfl_xor(s, 16); s += __shfl_xor(s, 32);
                if (fq == 0) ssq[(size_t)r * 16 + u.pn * 4 + wc] = s; }
    }
};
struct EpiGated {
    static constexpr bool PERM = true, HAS_HOOK = true;
    const bf16_t* gates; bf16_t* O;
    __device__ __forceinline__ void load8(float (&gv)[8], const bf16_t* p) const { const u32x4 w = *(const u32x4*)p;
#pragma unroll
        for (int i = 0; i < 8; ++i) gv[i] = fmaxf((i & 1) ? bfh(w[i >> 1]) : bfl(w[i >> 1]), 1e-30f); }
    __device__ __forceinline__ void khook(f32x4 (&acc)[2][2][4][2], const Unit& u, int t, int wr, int wc, int fr, int fq) const {
        if (t != 8 && t != 16) return;
        const int b = (t >> 3) - 1;
        const int row0 = u.pm * BM + wr * 64 + fr, col0 = u.pn * BM + wc * 32 + 8 * fq;
#pragma unroll
        for (int ai = 0; ai < 2; ++ai)
#pragma unroll
            for (int m = 0; m < 4; ++m) { const bf16_t* gp = gates + (size_t)(row0 + ai * HALF + m * 16) * 3072 + b * 1024 + col0;
#pragma unroll
                for (int bj = 0; bj < 2; ++bj) { float g0[8], g1[8]; load8(g0, gp + bj * HALF); load8(g1, gp + 1024 + bj * HALF);
#pragma unroll
                    for (int i = 0; i < 8; ++i) acc[ai][bj][m][i >> 2][i & 3] *= g0[i] * __builtin_amdgcn_rcpf(g1[i]); } }
    }
    __device__ __forceinline__ void operator()(const f32x4 (&acc)[2][2][4][2], const Unit& u, int wr, int wc, int fr, int fq) const {
        const int row0 = u.pm * BM + wr * 64 + fr, col0 = u.pn * BM + wc * 32 + 8 * fq;
#pragma unroll
        for (int ai = 0; ai < 2; ++ai)
#pragma unroll
            for (int m = 0; m < 4; ++m) { const int r = row0 + ai * HALF + m * 16; const bf16_t* gp = gates + (size_t)r * 3072 + 2048 + col0;
#pragma unroll
                for (int bj = 0; bj < 2; ++bj) { float g2[8]; load8(g2, gp + bj * HALF); float o[8];
#pragma unroll
                    for (int i = 0; i < 8; ++i) o[i] = acc[ai][bj][m][i >> 2][i & 3] * g2[i];
                    u32x4 w; w.x = cvt_pk_bf16(o[0], o[1]); w.y = cvt_pk_bf16(o[2], o[3]); w.z = cvt_pk_bf16(o[4], o[5]); w.w = cvt_pk_bf16(o[6], o[7]);
                    *(u32x4*)(O + (size_t)r * 1024 + col0 + bj * HALF) = w; } }
    }
};

template <int N> __device__ __forceinline__ float ror16(float v) { return __builtin_bit_cast(float, __builtin_amdgcn_update_dpp(0, __builtin_bit_cast(int, v), 0x120 + N, 0xf, 0xf, false)); }
__device__ __forceinline__ float silu_mul(float g, float v) { return g * __builtin_amdgcn_rcpf(1.f + __expf(-g)) * v; }
struct EpiConv {
    static constexpr bool PERM = true, HAS_HOOK = false;
    const float* ssq; const float* cw; const float* cb; bf16_t* U; float* side;
    __device__ __forceinline__ void operator()(const f32x4 (&acc)[2][2][4][2], const Unit& u, int wr, int wc, int fr, int fq) const {
        const int ch0 = u.pn * 128 + wc * 32 + 8 * fq;
        float rs[2][4];
#pragma unroll
        for (int ai = 0; ai < 2; ++ai)
#pragma unroll
            for (int m = 0; m < 4; ++m) { rs[ai][m] = rstd16(ssq, u.pm * BM + ai * HALF + wr * 64 + m * 16 + fr); asm volatile("" : "+v"(rs[ai][m]) :: "memory"); }
#pragma unroll
        for (int n = 0; n < 2; ++n) {
            const int ch = ch0 + 4 * n;
            const f32x4 g0 = *(const f32x4*)(cw + ch), g1 = *(const f32x4*)(cw + 5632 + ch), g2 = *(const f32x4*)(cw + 2 * 5632 + ch), gb = *(const f32x4*)(cb + ch);
            const f32x4 v0 = *(const f32x4*)(cw + 2816 + ch), v1 = *(const f32x4*)(cw + 5632 + 2816 + ch), v2 = *(const f32x4*)(cw + 2 * 5632 + 2816 + ch), vb = *(const f32x4*)(cb + 2816 + ch);
#pragma unroll
            for (int ai = 0; ai < 2; ++ai) {
                const int cid = u.pm * 4 + ai * 2 + wr;
                f32x4 pg = (f32x4){0.f, 0.f, 0.f, 0.f}, pv = pg;
#pragma unroll
                for (int m = 0; m < 4; ++m) {
                    const f32x4 cg = acc[ai][0][m][n] * rs[ai][m], cv = acc[ai][1][m][n] * rs[ai][m];
                    if ((m == 0 && fr < 2) || (m == 3 && fr >= 14)) { const int rr = (m == 0) ? fr : fr - 12;
                        float* sp = side + (((size_t)cid * 4 + rr) * 2) * 2816 + ch; *(f32x4*)sp = cg; *(f32x4*)(sp + 2816) = cv; }
                    f32x4 G, V;
#pragma unroll
                    for (int i = 0; i < 4; ++i) {
                        const float y1g = (fr == 15) ? pg[i] : cg[i], y2g = (fr >= 14) ? pg[i] : cg[i];
                        const float y1v = (fr == 15) ? pv[i] : cv[i], y2v = (fr >= 14) ? pv[i] : cv[i];
                        const float h1g = ror16<1>(y1g), h2g = ror16<2>(y2g), h1v = ror16<1>(y1v), h2v = ror16<2>(y2v);
                        G[i] = gb[i] + g0[i] * h2g + g1[i] * h1g + g2[i] * cg[i];
                        V[i] = vb[i] + v0[i] * h2v + v1[i] * h1v + v2[i] * cv[i];
                    }
                    u32x2 w; w.x = cvt_pk_bf16(silu_mul(G[0], V[0]), silu_mul(G[1], V[1])); w.y = cvt_pk_bf16(silu_mul(G[2], V[2]), silu_mul(G[3], V[3]));
                    *(u32x2*)(U + (size_t)(u.pm * BM + ai * HALF + wr * 64 + m * 16 + fr) * 2816 + ch) = w;
                    pg = cg; pv = cv;
                }
            }
        }
    }
};
}

constexpr int GEMM_LDS = 147456;
template <class Epi, bool ALIGN>
__global__ void __launch_bounds__(512, 2) gemm_k(pg8::Gemm g, Epi e) {
    extern __shared__ __attribute__((aligned(16))) unsigned char lds_dyn[];
    pg8::StaticOrder S; S.init(g.M, g.N, (int)gridDim.x, (int)blockIdx.x);
    pg8::gemm_phase<Epi, ALIGN>((PG8_LAS unsigned char*)lds_dyn, g, S, e);
}


#define LAS3 __attribute__((address_space(3)))
typedef float f32x4v __attribute__((ext_vector_type(4)));
typedef float f32x2v __attribute__((ext_vector_type(2)));
typedef unsigned u32x2v __attribute__((ext_vector_type(2)));
template <int CTRL> __device__ __forceinline__ float dppf(float v) { return __builtin_bit_cast(float, __builtin_amdgcn_update_dpp(0, __builtin_bit_cast(int, v), CTRL, 0xf, 0xf, true)); }
__device__ __forceinline__ float allsum16(float v) { v += dppf<0xB1>(v); v += dppf<0x4E>(v); v += dppf<0x141>(v); v += dppf<0x140>(v); return v; }
constexpr int SC_TC = 32, SC_STEP = 352, SC_BUF = SC_TC * SC_STEP;
constexpr int SCAN_LDS = (2 * SC_BUF + SC_TC * 32) * 4;
struct ScanArgs { const bf16* r_s; const bf16* k_s; const bf16* v; const bf16* a; const unsigned short* ld; const float* nrm; const float* k_k; const float* k_a; bf16* y_raw; };

__device__ __forceinline__ void scan_item(LAS3 float* lds, const ScanArgs& A, int item) {
    const int tid = threadIdx.x, lane = tid & 63, wave = tid >> 6, l16 = lane & 15;
    const int bh = item >> 1, half = item & 1, b = bh >> 3, h = bh & 7;
    const int irow = wave * 4 + (lane >> 4);
    LAS3 float* ybuf = lds + 2 * SC_BUF;
    const int tl = tid >> 4, jq = tid & 15;
    const f32x4v kkv = *(const f32x4v*)(A.k_k + h * 64 + 4 * jq), kav = *(const f32x4v*)(A.k_a + h * 64 + 4 * jq);
    const size_t rowbase = (size_t)b * SEQ;
    u32x2v gr, gk, ga, gl; unsigned gv; float gn;
    auto stage_load = [&](int c) {
        const size_t row = rowbase + c * SC_TC + tl, o = row * 512 + h * 64 + 4 * jq;
        gr = *(const u32x2v*)(A.r_s + o); gk = *(const u32x2v*)(A.k_s + o); ga = *(const u32x2v*)(A.a + o); gl = *(const u32x2v*)(A.ld + o);
        gv = *(const unsigned*)(A.v + row * 512 + h * 64 + half * 32 + 2 * jq); gn = A.nrm[row * 8 + h];
    };
    auto stage_store = [&](int bufi) {
        LAS3 float* p = lds + bufi * SC_BUF + tl * SC_STEP;
        f32x4v r, k, aa, l;
        r[0] = __uint_as_float(gr[0] << 16); r[1] = __uint_as_float(gr[0] & 0xffff0000u); r[2] = __uint_as_float(gr[1] << 16); r[3] = __uint_as_float(gr[1] & 0xffff0000u);
        k[0] = __uint_as_float(gk[0] << 16); k[1] = __uint_as_float(gk[0] & 0xffff0000u); k[2] = __uint_as_float(gk[1] << 16); k[3] = __uint_as_float(gk[1] & 0xffff0000u);
        aa[0] = __uint_as_float(ga[0] << 16); aa[1] = __uint_as_float(ga[0] & 0xffff0000u); aa[2] = __uint_as_float(ga[1] << 16); aa[3] = __uint_as_float(ga[1] & 0xffff0000u);
        l[0] = (float)__builtin_bit_cast(_Float16, (unsigned short)(gl[0] & 0xffffu)); l[1] = (float)__builtin_bit_cast(_Float16, (unsigned short)(gl[0] >> 16));
        l[2] = (float)__builtin_bit_cast(_Float16, (unsigned short)(gl[1] & 0xffffu)); l[3] = (float)__builtin_bit_cast(_Float16, (unsigned short)(gl[1] >> 16));
        f32x4v dec, nkk, kka, kt;
#pragma unroll
        for (int i = 0; i < 4; ++i) { dec[i] = __expf(l[i]); const float kk = k[i] * kkv[i] * gn; nkk[i] = -kk; kka[i] = kk * aa[i]; kt[i] = k[i] * (1.f + (aa[i] - 1.f) * kav[i]); }
        *(LAS3 f32x4v*)(p + 4 * jq) = dec; *(LAS3 f32x4v*)(p + 64 + 4 * jq) = nkk; *(LAS3 f32x4v*)(p + 128 + 4 * jq) = kka; *(LAS3 f32x4v*)(p + 192 + 4 * jq) = kt; *(LAS3 f32x4v*)(p + 256 + 4 * jq) = r;
        f32x2v vv; vv[0] = __uint_as_float(gv << 16); vv[1] = __uint_as_float(gv & 0xffff0000u);
        *(LAS3 f32x2v*)(p + 320 + 2 * jq) = vv;
    };
    float s0 = 0.f, s1 = 0.f, s2 = 0.f, s3 = 0.f;
    stage_load(0); stage_store(0);
    __syncthreads();
    constexpr int NCH = SEQ / SC_TC;
    for (int c = 0; c < NCH; ++c) {
        if (c + 1 < NCH) stage_load(c + 1);
        const LAS3 float* p = lds + (c & 1) * SC_BUF + 4 * l16;
        const LAS3 float* pv = lds + (c & 1) * SC_BUF + 320 + irow;
        f32x4v dec = *(const LAS3 f32x4v*)(p), nkk = *(const LAS3 f32x4v*)(p + 64), kka = *(const LAS3 f32x4v*)(p + 128), kt = *(const LAS3 f32x4v*)(p + 192), rr = *(const LAS3 f32x4v*)(p + 256);
        float vv = pv[0];
#pragma unroll 4
        for (int tt = 0; tt < SC_TC; ++tt) {
            const int tn = (tt + 1 < SC_TC) ? (tt + 1) : 0;
            const f32x4v ndec = *(const LAS3 f32x4v*)(p + tn * SC_STEP), nnkk = *(const LAS3 f32x4v*)(p + tn * SC_STEP + 64), nkka = *(const LAS3 f32x4v*)(p + tn * SC_STEP + 128),
                         nkt = *(const LAS3 f32x4v*)(p + tn * SC_STEP + 192), nrr = *(const LAS3 f32x4v*)(p + tn * SC_STEP + 256);
            const float nvv = pv[tn * SC_STEP];
            float pa = s0 * nkk[0]; pa = fmaf(s1, nkk[1], pa); pa = fmaf(s2, nkk[2], pa); pa = fmaf(s3, nkk[3], pa);
            const float t0 = fmaf(s0, dec[0], vv * kt[0]), t1 = fmaf(s1, dec[1], vv * kt[1]), t2 = fmaf(s2, dec[2], vv * kt[2]), t3 = fmaf(s3, dec[3], vv * kt[3]);
            const float sa = allsum16(pa);
            s0 = fmaf(sa, kka[0], t0); s1 = fmaf(sa, kka[1], t1); s2 = fmaf(sa, kka[2], t2); s3 = fmaf(sa, kka[3], t3);
            float py = s0 * rr[0]; py = fmaf(s1, rr[1], py); py = fmaf(s2, rr[2], py); py = fmaf(s3, rr[3], py);
            const float y = allsum16(py);
            if (l16 == 0) ybuf[tt * 32 + irow] = y;
            dec = ndec; nkk = nnkk; kka = nkka; kt = nkt; rr = nrr; vv = nvv;
        }
        __syncthreads();
        {
            const size_t row = rowbase + c * SC_TC + tl;
            const f32x2v yy = *(const LAS3 f32x2v*)(ybuf + tl * 32 + 2 * jq);
            *(unsigned*)(A.y_raw + row * 512 + h * 64 + half * 32 + 2 * jq) = pg8::cvt_pk_bf16(yy[0], yy[1]);
        }
        if (c + 1 < NCH) stage_store((c + 1) & 1);
        __syncthreads();
    }
}
__global__ void __launch_bounds__(512, 2) scan_k(ScanArgs A) {
    extern __shared__ __attribute__((aligned(16))) unsigned char lds_dyn[];
    const int item = (blockIdx.x % 8) * 16 + blockIdx.x / 8;
    scan_item((LAS3 float*)lds_dyn, A, item);
}


typedef float f32x16v __attribute__((ext_vector_type(16)));
typedef short bf16x8v __attribute__((ext_vector_type(8)));
typedef short bf16x4v __attribute__((ext_vector_type(4)));
typedef unsigned u32x4v __attribute__((ext_vector_type(4)));
constexpr int SB_KSTR = 144, SB_VSTR = 136;
constexpr int SB_KOFF = 0, SB_VOFF = 64 * SB_KSTR, SB_LDS = SB_VOFF + 64 * SB_VSTR;
typedef float f32x2c __attribute__((ext_vector_type(2))); typedef __bf16 bf16x2c __attribute__((ext_vector_type(2)));
__device__ __forceinline__ unsigned cvtpk_c(float lo, float hi) { f32x2c v = {lo, hi}; bf16x2c b = __builtin_convertvector(v, bf16x2c); return __builtin_bit_cast(unsigned, b); }
struct SbArgs { const bf16* proj_sm; const float* qg; const float* kg; bf16* y_b; };

__device__ __forceinline__ void sb_unit(LAS3 unsigned char* lds, const SbArgs& A, int bh, int u) {
    const int tid = threadIdx.x, lane = tid & 63, wave = __builtin_amdgcn_readfirstlane(tid >> 6), r32 = lane & 31, hh = lane >> 5;
    const int b = bh >> 3, h = bh & 7;
    const size_t rowbase = (size_t)b * SEQ;
    const int qrow = 256 * u + 32 * wave + r32;
    bf16x8v qf[4];
    {
        const bf16* qp = A.proj_sm + (rowbase + qrow) * 2048 + h * 64 + 8 * hh;
        u32x4v raw[4]; float x[4][8]; float ss = 0.f;
#pragma unroll
        for (int d0 = 0; d0 < 4; ++d0) { raw[d0] = *(const u32x4v*)(qp + 16 * d0);
#pragma unroll
            for (int j = 0; j < 8; ++j) { const unsigned w = raw[d0][j >> 1]; x[d0][j] = (j & 1) ? __uint_as_float(w & 0xffff0000u) : __uint_as_float(w << 16); ss += x[d0][j] * x[d0][j]; } }
        { auto rr = __builtin_amdgcn_permlane32_swap(__float_as_uint(ss), __float_as_uint(ss), false, false); ss = __uint_as_float(rr[0]) + __uint_as_float(rr[1]); }
        const float sc = rsqrtf(ss * (1.f / 64.f) + NORM_EPS) * (0.125f * 1.4426950408889634f);
#pragma unroll
        for (int d0 = 0; d0 < 4; ++d0) { const f32x4v g0 = *(const f32x4v*)(A.qg + 16 * d0 + 8 * hh), g1 = *(const f32x4v*)(A.qg + 16 * d0 + 8 * hh + 4);
            u32x4v w; w[0] = cvtpk_c(x[d0][0] * sc * g0[0], x[d0][1] * sc * g0[1]); w[1] = cvtpk_c(x[d0][2] * sc * g0[2], x[d0][3] * sc * g0[3]);
            w[2] = cvtpk_c(x[d0][4] * sc * g1[0], x[d0][5] * sc * g1[1]); w[3] = cvtpk_c(x[d0][6] * sc * g1[2], x[d0][7] * sc * g1[3]);
            qf[d0] = __builtin_bit_cast(bf16x8v, w); }
    }
    const int skv = tid >> 3, sc8 = tid & 7;
    const f32x4v kg0 = *(const f32x4v*)(A.kg + 8 * sc8), kg1 = *(const f32x4v*)(A.kg + 8 * sc8 + 4);
    u32x4v gK, gV;
    auto stage_load = [&](int kt) { const bf16* kp = A.proj_sm + (rowbase + kt * 64 + skv) * 2048 + 512 + h * 64 + 8 * sc8; gK = *(const u32x4v*)kp; gV = *(const u32x4v*)(kp + 512); };
    auto stage_store = [&]() {
        float x[8]; float ss = 0.f;
#pragma unroll
        for (int j = 0; j < 8; ++j) { const unsigned w = gK[j >> 1]; x[j] = (j & 1) ? __uint_as_float(w & 0xffff0000u) : __uint_as_float(w << 16); ss += x[j] * x[j]; }
        ss += __shfl_xor(ss, 1); ss += __shfl_xor(ss, 2); ss += __shfl_xor(ss, 4);
        const float sc = rsqrtf(ss * (1.f / 64.f) + NORM_EPS);
        u32x4v w; w[0] = cvtpk_c(x[0] * sc * kg0[0], x[1] * sc * kg0[1]); w[1] = cvtpk_c(x[2] * sc * kg0[2], x[3] * sc * kg0[3]);
        w[2] = cvtpk_c(x[4] * sc * kg1[0], x[5] * sc * kg1[1]); w[3] = cvtpk_c(x[6] * sc * kg1[2], x[7] * sc * kg1[3]);
        *(LAS3 u32x4v*)(lds + SB_KOFF + skv * SB_KSTR + 16 * sc8) = w;
#pragma unroll
        for (int j = 0; j < 8; ++j) { const unsigned wv = gV[j >> 1]; const unsigned short e = (j & 1) ? (unsigned short)(wv >> 16) : (unsigned short)(wv & 0xffffu);
            *(LAS3 unsigned short*)(lds + SB_VOFF + (8 * sc8 + j) * SB_VSTR + 2 * skv) = e; }
    };
    f32x16v o0, o1;
#pragma unroll
    for (int i = 0; i < 16; ++i) { o0[i] = 0.f; o1[i] = 0.f; }
    float R = 0.f;
    const float rexit = 165.f + 11.6f * wave_max(fabsf(A.qg[lane])) * wave_max(fabsf(A.kg[lane]));
    const int kt0 = 4 * u + 3;
    const int qmin = 256 * u + 32 * wave;
    stage_load(kt0);
    for (int kt = kt0; kt >= 0; --kt) {
        if (__syncthreads_and(R > rexit)) break;
        stage_store();
        if (kt > 0) stage_load(kt - 1);
        __syncthreads();
        if (kt * 64 <= qmin + 31) {
        f32x16v p0, p1;
        {
            const int kb0 = kt * 64 + 4 * hh;
#pragma unroll
            for (int r = 0; r < 16; ++r) { const int kv = kb0 + (r & 3) + 8 * (r >> 2); p0[r] = (kv >= qrow) ? -1e30f : 0.f; p1[r] = (kv + 32 >= qrow) ? -1e30f : 0.f; }
        }
        asm volatile("" : "+v"(p0), "+v"(p1));
        const LAS3 unsigned char* kb = lds + SB_KOFF + r32 * SB_KSTR + 16 * hh;
#pragma unroll
        for (int d0 = 0; d0 < 4; ++d0) {
            const bf16x8v k0 = *(const LAS3 bf16x8v*)(kb + 32 * d0), k1 = *(const LAS3 bf16x8v*)(kb + 32 * SB_KSTR + 32 * d0);
            p0 = __builtin_amdgcn_mfma_f32_32x32x16_bf16(k0, qf[d0], p0, 0, 0, 0);
            p1 = __builtin_amdgcn_mfma_f32_32x32x16_bf16(k1, qf[d0], p1, 0, 0, 0);
        }
        float e[32], bs[8];
#pragma unroll
        for (int g = 0; g < 8; ++g) {
            float run = 0.f;
#pragma unroll
            for (int i = 3; i >= 0; --i) { const float z = (g < 4) ? p0[4 * g + i] : p1[4 * (g - 4) + i];
                const float sp = fmaxf(z, 0.f) + __builtin_amdgcn_logf(1.f + __builtin_amdgcn_exp2f(-fabsf(z)));
                run += sp; e[4 * g + i] = run; }
            bs[g] = run;
        }
        float T = 0.f, off[8];
#pragma unroll
        for (int g = 7; g >= 0; --g) {
            auto rr = __builtin_amdgcn_permlane32_swap(__float_as_uint(bs[g]), __float_as_uint(bs[g]), false, false);
            const float bE = __uint_as_float(rr[0]), bO = __uint_as_float(rr[1]);
            off[g] = R + T + (hh ? 0.f : bO);
            T += bE + bO;
        }
#pragma unroll
        for (int g = 0; g < 8; ++g)
#pragma unroll
            for (int i = 0; i < 4; ++i) { const float z = (g < 4) ? p0[4 * g + i] : p1[4 * (g - 4) + i]; const float a = __builtin_amdgcn_exp2f(fmaxf(z - (off[g] + e[4 * g + i]), -160.f));
                if (g < 4) p0[4 * g + i] = a; else p1[4 * (g - 4) + i] = a; }
        R += T;
        const LAS3 unsigned char* vb = lds + SB_VOFF + r32 * SB_VSTR + 8 * hh;
#pragma unroll
        for (int half = 0; half < 2; ++half)
#pragma unroll
            for (int s2 = 0; s2 < 2; ++s2) {
                u32x4v pw;
#pragma unroll
                for (int j = 0; j < 4; ++j) { const float x0 = half ? p1[8 * s2 + 2 * j] : p0[8 * s2 + 2 * j], x1 = half ? p1[8 * s2 + 2 * j + 1] : p0[8 * s2 + 2 * j + 1]; pw[j] = cvtpk_c(x0, x1); }
                const bf16x8v pa = __builtin_bit_cast(bf16x8v, pw);
                const int kvo = 2 * (32 * half + 16 * s2);
                const bf16x4v a0 = *(const LAS3 bf16x4v*)(vb + kvo), a1 = *(const LAS3 bf16x4v*)(vb + kvo + 16);
                const bf16x4v c0 = *(const LAS3 bf16x4v*)(vb + 32 * SB_VSTR + kvo), c1 = *(const LAS3 bf16x4v*)(vb + 32 * SB_VSTR + kvo + 16);
                const bf16x8v vf0 = (bf16x8v){a0[0], a0[1], a0[2], a0[3], a1[0], a1[1], a1[2], a1[3]};
                const bf16x8v vf1 = (bf16x8v){c0[0], c0[1], c0[2], c0[3], c1[0], c1[1], c1[2], c1[3]};
                o0 = __builtin_amdgcn_mfma_f32_32x32x16_bf16(pa, vf0, o0, 0, 0, 0);
                o1 = __builtin_amdgcn_mfma_f32_32x32x16_bf16(pa, vf1, o1, 0, 0, 0);
            }
        }
    }
    bf16* op = A.y_b + (rowbase + 256 * u + 32 * wave) * 512 + h * 64 + r32;
#pragma unroll
    for (int r = 0; r < 16; ++r) { const int qq = (r & 3) + 8 * (r >> 2) + 4 * hh; op[(size_t)qq * 512] = f2bf(o0[r]); op[(size_t)qq * 512 + 32] = f2bf(o1[r]); }
}
__global__ void __launch_bounds__(512, 2) sb_k(SbArgs A) {
    extern __shared__ __attribute__((aligned(16))) unsigned char lds_dyn[];
    const int bh = blockIdx.x >> 2, pr = blockIdx.x & 3;
    sb_unit((LAS3 unsigned char*)lds_dyn, A, bh, 7 - pr);
    __syncthreads();
    sb_unit((LAS3 unsigned char*)lds_dyn, A, bh, pr);
}

__global__ void k_memk_norm(bf16* __restrict__ kv, const float* __restrict__ kg) {
    const int row = blockIdx.x, h = threadIdx.x >> 6, lane = threadIdx.x & 63;
    bf16* p = kv + (size_t)row * 1024 + h * 128 + lane * 2;
    const float a = bf2f(p[0]), b = bf2f(p[1]);
    const float ss = wave_sum(a * a + b * b);
    const float rs = rsqrtf(ss * (1.f / 128.f) + NORM_EPS);
    p[0] = f2bf(a * rs * kg[lane * 2]); p[1] = f2bf(b * rs * kg[lane * 2 + 1]);
}

__global__ void __launch_bounds__(256) k_shift(const bf16* __restrict__ proj_r, const float* __restrict__ mu, const float* __restrict__ k_k,
                                              bf16* __restrict__ r_s, bf16* __restrict__ k_s, bf16* __restrict__ v_s, bf16* __restrict__ lora_in, float* __restrict__ nrm) {
    __shared__ float sq[512];
    const int row = blockIdx.x, t = row % SEQ;
    const bf16* cur = proj_r + (size_t)row * RWKV_COLS;
    for (int c = threadIdx.x; c < RWKV_COLS; c += 256) {
        const float pc = bf2f(cur[c]);
        const float pp = (t > 0) ? bf2f(cur[c - RWKV_COLS]) : 0.f;
        const float p = pc + (pp - pc) * mu[c];
        if (c < 512) r_s[(size_t)row * 512 + c] = f2bf(p);
        else if (c < 1024) { k_s[(size_t)row * 512 + c - 512] = f2bf(p); const float q = p * k_k[c - 512]; sq[c - 512] = q * q; }
        else if (c < 1536) v_s[(size_t)row * 512 + c - 1024] = f2bf(p);
        else if (c < 1600) lora_in[(size_t)row * 256 + (c - 1536)] = f2bf(tanhf(p));
        else if (c < 1664) lora_in[(size_t)row * 256 + 64 + (c - 1600)] = f2bf(p);
        else lora_in[(size_t)row * 256 + 128 + (c - 1664)] = f2bf(sigmoidf_(p));
    }
    __syncthreads();
    if (threadIdx.x < 8) {
        float s = 0.f;
        for (int j = 0; j < 64; ++j) s += sq[threadIdx.x * 64 + j];
        nrm[(size_t)row * 8 + threadIdx.x] = 1.f / fmaxf(sqrtf(s), 1e-12f);
    }
}

__global__ void __launch_bounds__(64) scan_ref(const bf16* __restrict__ r_s, const bf16* __restrict__ k_s, const bf16* __restrict__ v, const bf16* __restrict__ a,
                                              const f16* __restrict__ ld, const float* __restrict__ nrm, const float* __restrict__ k_k, const float* __restrict__ k_a,
                                              bf16* __restrict__ y_raw) {
    __shared__ float sr[64], sdec[64], sk[64], skk[64], skka[64];
    const int bh = blockIdx.x, b = bh >> 3, h = bh & 7, i = threadIdx.x;
    float S[64];
#pragma unroll
    for (int j = 0; j < 64; ++j) S[j] = 0.f;
    const float kkj = k_k[h * 64 + i], kaj = k_a[h * 64 + i];
    for (int t = 0; t < SEQ; ++t) {
        const size_t row = (size_t)b * SEQ + t, idx = row * 512 + h * 64 + i;
        const float r = bf2f(r_s[idx]), k = bf2f(k_s[idx]), aa = bf2f(a[idx]), l = (float)ld[idx], vv = bf2f(v[idx]);
        const float n = nrm[row * 8 + h];
        const float kk = k * kkj * n;
        sr[i] = r; sdec[i] = __expf(l); sk[i] = k * (1.f + (aa - 1.f) * kaj); skk[i] = kk; skka[i] = kk * aa;
        __syncthreads();
        float sa = 0.f;
#pragma unroll
        for (int j = 0; j < 64; ++j) sa += S[j] * skk[j];
        sa = -sa;
        float y = 0.f;
#pragma unroll
        for (int j = 0; j < 64; ++j) { S[j] = S[j] * sdec[j] + sa * skka[j] + vv * sk[j]; y += S[j] * sr[j]; }
        y_raw[idx] = f2bf(y);
        __syncthreads();
    }
}

__global__ void __launch_bounds__(512) k_post(const bf16* __restrict__ y_raw, const bf16* __restrict__ r_s, const bf16* __restrict__ k_s, const bf16* __restrict__ a,
                                             const bf16* __restrict__ v, const bf16* __restrict__ g, const float* __restrict__ k_a, const float* __restrict__ r_k,
                                             const float* __restrict__ lnx_g, const float* __restrict__ lnx_b, bf16* __restrict__ y_a) {
    const int row = blockIdx.x, col = threadIdx.x;
    const size_t idx = (size_t)row * 512 + col;
    const float y = bf2f(y_raw[idx]);
    const float mean = wave_sum(y) * (1.f / 64.f);
    const float d = y - mean;
    const float var = wave_sum(d * d) * (1.f / 64.f);
    const float yn = d * rsqrtf(var + LNX_EPS) * lnx_g[col] + lnx_b[col];
    const float r = bf2f(r_s[idx]), k = bf2f(k_s[idx]), aa = bf2f(a[idx]);
    const float kt = k * (1.f + (aa - 1.f) * k_a[col]);
    const float bonus = wave_sum(r * kt * r_k[col]);
    y_a[idx] = f2bf((yn + bonus * bf2f(v[idx])) * bf2f(g[idx]));
}

__global__ void __launch_bounds__(64) sb_attn_ref(const bf16* __restrict__ proj_sm, const float* __restrict__ qg, const float* __restrict__ kg, bf16* __restrict__ y_b, int flags, int pad) {
    __shared__ float ks[64][65], vs[64][65];
    const int bh = blockIdx.y, b = bh >> 3, h = bh & 7, qt = blockIdx.x, tid = threadIdx.x;
    const int t = qt * 64 + tid;
    const size_t rowq = (size_t)b * SEQ + t;
    float q[64], o[64];
    {
        float ss = 0.f;
#pragma unroll
        for (int d = 0; d < 64; ++d) { q[d] = bf2f(proj_sm[rowq * 2048 + h * 64 + d]); ss += q[d] * q[d]; }
        const float rs = (flags & 1) ? 0.125f : rsqrtf(ss * (1.f / 64.f) + NORM_EPS) * 0.125f;
#pragma unroll
        for (int d = 0; d < 64; ++d) { q[d] = q[d] * rs * ((flags & 1) ? 1.f : qg[d]); o[d] = 0.f; }
    }
    float R = 0.f;
    for (int kt = qt; kt >= 0; --kt) {
        {
            const size_t rowk = (size_t)b * SEQ + kt * 64 + tid;
            float kr[64]; float ss = 0.f;
#pragma unroll
            for (int d = 0; d < 64; ++d) { kr[d] = bf2f(proj_sm[rowk * 2048 + 512 + h * 64 + d]); ss += kr[d] * kr[d]; }
            const float rs = (flags & 2) ? 1.f : rsqrtf(ss * (1.f / 64.f) + NORM_EPS);
#pragma unroll
            for (int d = 0; d < 64; ++d) { ks[tid][d] = kr[d] * rs * ((flags & 2) ? 1.f : kg[d]); vs[tid][d] = bf2f(proj_sm[rowk * 2048 + 1024 + h * 64 + d]); }
        }
        __syncthreads();
        for (int jj = 63; jj >= 0; --jj) {
            const int s = kt * 64 + jj;
            if (s < t) {
                float z = 0.f;
#pragma unroll
                for (int d = 0; d < 64; ++d) z += q[d] * ks[jj][d];
                R += softplusf_(z);
                const float A = __expf(z - R);
#pragma unroll
                for (int d = 0; d < 64; ++d) o[d] += A * vs[jj][d];
            }
        }
        __syncthreads();
    }
#pragma unroll
    for (int d = 0; d < 64; ++d) y_b[rowq * 512 + h * 64 + d] = f2bf(o[d]);
}

__global__ void __launch_bounds__(256) mem_attn_ref(const bf16* __restrict__ proj_sm, const bf16* __restrict__ kv, const float* __restrict__ qg, bf16* __restrict__ y_m) {
    __shared__ float qn[128], p[256], red[4];
    const int row = blockIdx.x >> 2, h = blockIdx.x & 3, b = row / SEQ, tid = threadIdx.x, wid = tid >> 6, lane = tid & 63;
    float qv = 0.f;
    if (tid < 128) qv = bf2f(proj_sm[(size_t)row * 2048 + 1536 + h * 128 + tid]);
    float s = wave_sum(qv * qv);
    if (lane == 0) red[wid] = s;
    __syncthreads();
    const float ss = red[0] + red[1];
    if (tid < 128) qn[tid] = qv * rsqrtf(ss * (1.f / 128.f) + NORM_EPS) * qg[tid];
    __syncthreads();
    const bf16* kr = kv + (size_t)(b * MEM_LEN + tid) * 1024 + h * 128;
    float sc = 0.f;
    for (int d = 0; d < 128; ++d) sc += qn[d] * bf2f(kr[d]);
    sc *= 0.08838834764831845f;
    float mx = wave_max(sc);
    __syncthreads();
    if (lane == 0) red[wid] = mx;
    __syncthreads();
    mx = fmaxf(fmaxf(red[0], red[1]), fmaxf(red[2], red[3]));
    const float e = __expf(sc - mx);
    float es = wave_sum(e);
    __syncthreads();
    if (lane == 0) red[wid] = es;
    p[tid] = e;
    __syncthreads();
    const float inv = 1.f / ((red[0] + red[1]) + (red[2] + red[3]));
    if (tid < 128) {
        float o = 0.f;
        const bf16* vr = kv + (size_t)(b * MEM_LEN) * 1024 + 512 + h * 128 + tid;
        for (int m = 0; m < 256; ++m) o += p[m] * bf2f(vr[(size_t)m * 1024]);
        y_m[(size_t)row * 512 + h * 128 + tid] = f2bf(o * inv);
    }
}

__global__ void __launch_bounds__(256) k_conv(const bf16* __restrict__ h, const float* __restrict__ cw, const float* __restrict__ cb, bf16* __restrict__ u, int row0, int pad) {
    const int lr = blockIdx.x, row = row0 + lr, t = row % SEQ;
    for (int ch = threadIdx.x; ch < DFF; ch += 256) {
        const int pn = ch >> 7, j = ch & 127, cg = 256 * pn + j, cv = cg + 128;
        float ga = cb[ch], va = cb[DFF + ch];
#pragma unroll
        for (int i = 0; i < 3; ++i) {
            const int dt = 2 - i;
            if (t - dt >= 0) {
                ga += bf2f(h[(size_t)(lr - dt) * DFF2 + cg]) * cw[i * DFF2 + ch];
                va += bf2f(h[(size_t)(lr - dt) * DFF2 + cv]) * cw[i * DFF2 + DFF + ch];
            }
        }
        u[(size_t)row * DFF + ch] = f2bf(ga * sigmoidf_(ga) * va);
    }
}


__global__ void __launch_bounds__(512) ffn_fixup(const float* __restrict__ side, const float* __restrict__ cw, const float* __restrict__ cb, bf16* __restrict__ u) {
    const int cid = blockIdx.x; const bool first = ((cid * 64) % SEQ) == 0;
    for (int idx = threadIdx.x; idx < 2 * DFF; idx += 512) {
        const int rr = idx / DFF, ch = idx % DFF;
        float G = cb[ch], V = cb[DFF + ch];
#pragma unroll
        for (int i = 0; i < 3; ++i) {
            const int dt = 2 - i, q = rr - dt;
            float hg = 0.f, hv = 0.f;
            if (q >= 0) { const float* sp = side + (((size_t)cid * 4 + q) * 2) * DFF + ch; hg = sp[0]; hv = sp[DFF]; }
            else if (!first) { const float* sp = side + (((size_t)(cid - 1) * 4 + (4 + q)) * 2) * DFF + ch; hg = sp[0]; hv = sp[DFF]; }
            G += cw[i * DFF2 + ch] * hg; V += cw[i * DFF2 + DFF + ch] * hv;
        }
        u[(size_t)(cid * 64 + rr) * DFF + ch] = f2bf(G * sigmoidf_(G) * V);
    }
}

__global__ void __launch_bounds__(512, 2) coop_probe(unsigned* scratch) {
    extern __shared__ __attribute__((aligned(16))) unsigned char lds_dyn[];
    cooperative_groups::grid_group grid = cooperative_groups::this_grid();
    if (threadIdx.x == 0) { ((volatile unsigned*)lds_dyn)[0] = blockIdx.x; scratch[64 + blockIdx.x] = blockIdx.x + 1; }
    grid.sync();
    if (blockIdx.x == 0 && threadIdx.x == 0) { unsigned s = 0; for (unsigned i = 0; i < gridDim.x; ++i) s += scratch[64 + i]; scratch[0] = s; }
    grid.sync();
}


#define LAUNCH(k, g, b, ...) hipLaunchKernelGGL(k, g, b, 0, stream, __VA_ARGS__)
static void convert_w(hipStream_t stream, const float* src, int ldsrc, const float* scale, bf16* dst, int lddst, int koff, int N, int K, int mode) {
    const size_t n = (size_t)N * K;
    LAUNCH(k_wt, dim3((unsigned)((n + 255) / 256)), dim3(256), src, scale, dst, ldsrc, lddst, koff, N, K, mode);
}

template <class Epi, bool ALIGN> static void launch_gemm(hipStream_t stream, const pg8::Gemm& g, const Epi& e) {
    static bool init = false;
    if (!init) { (void)hipFuncSetAttribute((const void*)gemm_k<Epi, ALIGN>, hipFuncAttributeMaxDynamicSharedMemorySize, GEMM_LDS); init = true; }
    hipLaunchKernelGGL((gemm_k<Epi, ALIGN>), dim3(256), dim3(512), GEMM_LDS, stream, g, e);
}
static pg8::Gemm mkgemm(const bf16* A, const bf16* Bt, int Mr, int N, int K) { return pg8::Gemm{A, A, A, Bt, Mr, N, K, K, K / 64, 0}; }

extern "C" void kernel_launch(void* const* d_in, const int* in_sizes, int n_in, void* d_out, int out_size, void* d_ws, size_t ws_size, hipStream_t stream) {
    if (n_in != 31 || ws_size < 256 * MiB) { fprintf(stderr, "kernel_launch: unexpected n_in %d / ws %zu\n", n_in, ws_size); return; }
    const float* const* in = (const float* const*)d_in;
    const float* x0 = in[0]; const float* mem = in[1];
    unsigned char* ws = (unsigned char*)d_ws;
    float* xout = (float*)d_out;
    bf16* WinT = (bf16*)(ws + WS_WINT); bf16* WupT = (bf16*)(ws + WS_WUPT); bf16* WdnT = (bf16*)(ws + WS_WDNT); bf16* WbrT = (bf16*)(ws + WS_WBRT);
    bf16* WoutT = (bf16*)(ws + WS_WOUTT); bf16* Wlora = (bf16*)(ws + WS_WLORA); bf16* V1T = (bf16*)(ws + WS_V1T); bf16* V2T = (bf16*)(ws + WS_V2T);
    bf16* vfirst = (bf16*)(ws + WS_VFIRST); bf16* xbA = (bf16*)(ws + WS_XBA); bf16* kvmem = (bf16*)(ws + WS_KVMEM);
    float* ssq = (float*)(ws + WS_SSQ); float* nrm = (float*)(ws + WS_NRM); float* ssqm = (float*)(ws + WS_SSQM);

    {
        static int grid_blocks = 0;
        if (!grid_blocks) { int dev = 0, cus = 0, per_cu = 0; (void)hipGetDevice(&dev); (void)hipDeviceGetAttribute(&cus, hipDeviceAttributeMultiprocessorCount, dev);
            (void)hipFuncSetAttribute((const void*)coop_probe, hipFuncAttributeMaxDynamicSharedMemorySize, GEMM_LDS);
            (void)hipOccupancyMaxActiveBlocksPerMultiprocessor(&per_cu, (const void*)coop_probe, 512, GEMM_LDS);
            grid_blocks = cus * (per_cu < 1 ? 1 : per_cu); fprintf(stderr, "coop_probe: cus %d per_cu %d grid %d\n", cus, per_cu, grid_blocks); }
        unsigned* scratch = (unsigned*)((unsigned char*)d_ws + WS_CTL);
        void* args[] = {(void*)&scratch};
        hipError_t e = hipLaunchCooperativeKernel((const void*)coop_probe, dim3(grid_blocks), dim3(512), args, GEMM_LDS, stream);
        if (e != hipSuccess) fprintf(stderr, "cooperative launch failed: %s (grid %d)\n", hipGetErrorString(e), grid_blocks);
    }
    {
        bf16* memb = (bf16*)(ws + RS(0)); bf16* WkvT = (bf16*)(ws + RS(1));
        LAUNCH(k_x_to_xb, dim3(MEM_ROWS / 4), dim3(256), mem, memb, ssqm, MEM_ROWS, 0);
        for (int l = 0; l < 2; ++l) {
            convert_w(stream, in[21] + (size_t)l * D * 1024, 1024, in[20] + l * D, WkvT, D, 0, 1024, D, 0);
            bf16* kv = kvmem + (size_t)l * MEM_ROWS * 1024;
            launch_gemm<pg8::EpiRowScale, true>(stream, mkgemm(memb, WkvT, MEM_ROWS, 1024, D), pg8::EpiRowScale{kv, ssqm, 1024, 0});
            LAUNCH(k_memk_norm, dim3(MEM_ROWS), dim3(256), kv, in[23] + l * 128);
        }
        LAUNCH(k_x_to_xb, dim3(M / 4), dim3(256), x0, xbA, ssq, M, 0);
    }

    for (int l = 0; l < 2; ++l) {
        convert_w(stream, in[3] + (size_t)l * D * IN_COLS, IN_COLS, in[2] + l * D, WinT, D, 0, IN_COLS, D, 0);
        convert_w(stream, in[27] + (size_t)l * D * DFF2, DFF2, in[26] + l * D, WupT, D, 0, DFF2, D, 1);
        convert_w(stream, in[30] + (size_t)l * DFF * D, D, nullptr, WdnT, DFF, 0, D, DFF, 0);
        for (int b = 0; b < 3; ++b) convert_w(stream, in[24] + ((size_t)l * 3 + b) * 512 * D, D, nullptr, WbrT, 1536, b * 512, D, 512, 0);
        convert_w(stream, in[25] + (size_t)l * D * D, D, nullptr, WoutT, D, 0, D, D, 0);
        (void)hipMemsetAsync(Wlora, 0, 1536 * 256 * 2, stream);
        convert_w(stream, in[6] + (size_t)l * 64 * 512, 512, nullptr, Wlora, 256, 0, 512, 64, 0);
        convert_w(stream, in[8] + (size_t)l * 64 * 512, 512, nullptr, Wlora + 512 * 256, 256, 64, 512, 64, 0);
        convert_w(stream, in[9] + (size_t)l * 128 * 512, 512, nullptr, Wlora + 1024 * 256, 256, 128, 512, 128, 0);
        if (l == 1) {
            (void)hipMemsetAsync(V1T, 0, 256 * 512 * 2, stream); (void)hipMemsetAsync(V2T, 0, 512 * 256 * 2, stream);
            convert_w(stream, in[16], 32, nullptr, V1T, 512, 0, 32, 512, 0);
            convert_w(stream, in[17], 512, nullptr, V2T, 256, 0, 512, 32, 0);
        }
        const float* xin = (l == 0) ? x0 : xout;
        bf16* proj_r = (bf16*)(ws + RS(0));
        bf16* r_s = (bf16*)(ws + RS(4)); bf16* k_s = (bf16*)(ws + RS(5)); bf16* v_s = (l == 0) ? vfirst : (bf16*)(ws + RS(6)); bf16* lora_in = (bf16*)(ws + RS(7));
        f16* ld = (f16*)(ws + RS(0)); bf16* a = (bf16*)(ws + RS(1)); bf16* g = (bf16*)(ws + RS(2)); bf16* t1 = (bf16*)(ws + RS(3)); bf16* vp = (bf16*)(ws + RS(8));
        bf16* y_raw = (bf16*)(ws + RS(9)); bf16* y_a = (bf16*)(ws + RS(0)); bf16* y_b = (bf16*)(ws + RS(1)); bf16* y_m = (bf16*)(ws + RS(2));
        bf16* proj_sm = (bf16*)(ws + RS(3)); bf16* gates = (bf16*)(ws + RS(3)); bf16* merged = xbA; bf16* xb2 = (bf16*)(ws + RS(0));
        bf16* u = (bf16*)(ws + RS(2)); float* side = (float*)(ws + RS(2) + 88 * MiB);

        launch_gemm<pg8::EpiRowScale, true>(stream, mkgemm(xbA, WinT, M, RWKV_COLS, D), pg8::EpiRowScale{proj_r, ssq, RWKV_COLS, 0});
        LAUNCH(k_shift, dim3(M), dim3(256), proj_r, in[4] + l * RWKV_COLS, in[10] + l * 512, r_s, k_s, v_s, lora_in, nrm);
        launch_gemm<pg8::EpiLora, true>(stream, mkgemm(lora_in, Wlora, M, 1536, 256), pg8::EpiLora{(unsigned short*)ld, a, g, in[5] + l * 512, in[7] + l * 512});
        const bf16* vuse = v_s;
        if (l == 1) {
            launch_gemm<pg8::EpiRowScale, true>(stream, mkgemm(v_s, V1T, M, 256, 512), pg8::EpiRowScale{t1, nullptr, 256, 0});
            launch_gemm<pg8::EpiVres, true>(stream, mkgemm(t1, V2T, M, 512, 256), pg8::EpiVres{v_s, vfirst, in[15], vp});
            vuse = vp;
        }
        {
            static bool init = false;
            if (!init) { (void)hipFuncSetAttribute((const void*)scan_k, hipFuncAttributeMaxDynamicSharedMemorySize, SCAN_LDS); init = true; }
            hipLaunchKernelGGL(scan_k, dim3(128), dim3(512), SCAN_LDS, stream, ScanArgs{r_s, k_s, vuse, a, (const unsigned short*)ld, nrm, in[10] + l * 512, in[11] + l * 512, y_raw});
        }
        LAUNCH(k_post, dim3(M), dim3(512), y_raw, r_s, k_s, a, vuse, g, in[11] + l * 512, in[12] + l * 512, in[13] + l * 512, in[14] + l * 512, y_a);
        launch_gemm<pg8::EpiRowScale, true>(stream, mkgemm(xbA, WinT + (size_t)RWKV_COLS * D, M, 2048, D), pg8::EpiRowScale{proj_sm, ssq, 2048, 0});
        hipLaunchKernelGGL(sb_k, dim3(256), dim3(512), SB_LDS, stream, SbArgs{proj_sm, in[18] + l * 64, in[19] + l * 64, y_b});
        LAUNCH(mem_attn_ref, dim3(M * 4), dim3(256), proj_sm, kvmem + (size_t)l * MEM_ROWS * 1024, in[22] + l * 128, y_m);
        launch_gemm<pg8::EpiRowScale, true>(stream, mkgemm(xbA, WinT + (size_t)3840 * D, M, 3072, D), pg8::EpiRowScale{gates, ssq, 3072, 1});
        launch_gemm<pg8::EpiGated, true>(stream, pg8::Gemm{y_a, y_b, y_m, WbrT, M, D, 1536, 512, 8, 0}, pg8::EpiGated{gates, merged});
        launch_gemm<pg8::EpiResidual, true>(stream, mkgemm(merged, WoutT, M, D, D), pg8::EpiResidual{xin, xout, xb2, ssq});
        launch_gemm<pg8::EpiConv, true>(stream, mkgemm(xb2, WupT, M, DFF2, D), pg8::EpiConv{ssq, in[28] + (size_t)l * 3 * DFF2, in[29] + (size_t)l * DFF2, u, side});
        LAUNCH(ffn_fixup, dim3(M / 64), dim3(512), side, in[28] + (size_t)l * 3 * DFF2, in[29] + (size_t)l * DFF2, u);
        launch_gemm<pg8::EpiResidual, true>(stream, mkgemm(u, WdnT, M, D, DFF), pg8::EpiResidual{xout, xout, xbA, ssq});
    }
}
```

```cpp
#include <hip/hip_runtime.h>
#include <hip/hip_cooperative_groups.h>
#include <cstdint>
#include <cstdio>

typedef unsigned short bf16;
typedef _Float16 f16;

constexpr int BATCH = 8, SEQ = 2048, D = 1024, M = BATCH * SEQ;
constexpr int RW = 512, NH = 8, HD = 64;
constexpr int RWKV_COLS = 1792, IN_COLS = 6912;
constexpr int MEM_LEN = 256, MEM_ROWS = BATCH * MEM_LEN;
constexpr int DFF = 2816, DFF2 = 5632;
constexpr float NORM_EPS = 1e-6f, LNX_EPS = 64e-5f;

constexpr size_t MiB = 1u << 20;
constexpr size_t WS_CTL = 37 * MiB + MiB / 4;
constexpr size_t WS_WINT = 1 * MiB;
constexpr size_t WS_WUPT = WS_WINT + 13 * MiB + MiB / 2;
constexpr size_t WS_WDNT = WS_WUPT + 11 * MiB;
constexpr size_t WS_WBRT = WS_WDNT + 5 * MiB + MiB / 2;
constexpr size_t WS_WOUTT = WS_WBRT + 3 * MiB;
constexpr size_t WS_WLORA = WS_WOUTT + 2 * MiB;
constexpr size_t WS_V1T = WS_WLORA + 3 * MiB / 4;
constexpr size_t WS_V2T = WS_V1T + MiB / 4;
constexpr size_t WS_VFIRST = 38 * MiB;
constexpr size_t WS_XBA = 54 * MiB;
constexpr size_t WS_KVMEM = 86 * MiB;
constexpr size_t WS_SSQ = 94 * MiB;
constexpr size_t WS_NRM = 95 * MiB;
constexpr size_t WS_SSQM = WS_NRM + MiB / 2;
constexpr size_t WS_R = 96 * MiB;
constexpr size_t SLOT = 16 * MiB;
#define RS(i) (WS_R + (size_t)(i) * SLOT)
static_assert(WS_V2T + MiB / 4 == WS_CTL && WS_CTL + 65536 <= WS_VFIRST, "weights region");
static_assert(RS(10) <= 256 * MiB, "ws");

__device__ __forceinline__ int opaque_tid() { int t = threadIdx.x; asm volatile("" : "+v"(t)); return t; }
__device__ __forceinline__ float bf2f(bf16 v) { return __uint_as_float((unsigned)v << 16); }
__device__ __forceinline__ bf16 f2bf(float f) { unsigned u = __float_as_uint(f); return (bf16)((u + 0x7fffu + ((u >> 16) & 1u)) >> 16); }
__device__ __forceinline__ float sigmoidf_(float x) { return 1.f / (1.f + __expf(-x)); }
__device__ __forceinline__ float softplusf_(float x) { return fmaxf(x, 0.f) + log1pf(__expf(-fabsf(x))); }
__device__ __forceinline__ float shfl_xor_t(float v, int m) { return __builtin_bit_cast(float, __builtin_amdgcn_ds_bpermute((int)(((threadIdx.x & 63u) ^ (unsigned)m) << 2), __builtin_bit_cast(int, v))); }
template <int CTRL> __device__ __forceinline__ float dpp_f(float v) { return __builtin_bit_cast(float, __builtin_amdgcn_update_dpp(0, __builtin_bit_cast(int, v), CTRL, 0xf, 0xf, true)); }
__device__ __forceinline__ float sum_lanes8(float v) { v += dpp_f<0xB1>(v); v += dpp_f<0x4E>(v); v += dpp_f<0x141>(v); return v; }
__device__ __forceinline__ float sum_lanes16(float v) { v = sum_lanes8(v); v += dpp_f<0x140>(v); return v; }
__device__ __forceinline__ float sum_rows4(float v) {
    auto a = __builtin_amdgcn_permlane16_swap(__float_as_uint(v), __float_as_uint(v), false, false); const float s2 = __uint_as_float(a[0]) + __uint_as_float(a[1]);
    auto b = __builtin_amdgcn_permlane32_swap(__float_as_uint(s2), __float_as_uint(s2), false, false); return __uint_as_float(b[0]) + __uint_as_float(b[1]); }
__device__ __forceinline__ float wave_sum(float v) {
#pragma unroll
    for (int o = 1; o < 64; o <<= 1) v += shfl_xor_t(v, o);
    return v;
}
__device__ __forceinline__ float wave_max(float v) {
#pragma unroll
    for (int o = 1; o < 64; o <<= 1) v = fmaxf(v, shfl_xor_t(v, o));
    return v;
}
__device__ __forceinline__ float rstd_of(const float* ssq, int r) {
    const float4* p = (const float4*)(ssq + 16 * (size_t)r);
    const float4 a = p[0], b = p[1], c = p[2], d = p[3];
    const float s = (((a.x + a.y) + (a.z + a.w)) + ((b.x + b.y) + (b.z + b.w))) + (((c.x + c.y) + (c.z + c.w)) + ((d.x + d.y) + (d.z + d.w)));
    return rsqrtf(s * (1.f / 1024.f) + NORM_EPS);
}

namespace pg8 {
#define PG8_LAS __attribute__((address_space(3)))
typedef unsigned short bf16_t;
typedef short bf16x8 __attribute__((ext_vector_type(8)));
typedef float f32x4 __attribute__((ext_vector_type(4)));
typedef unsigned u32x4 __attribute__((ext_vector_type(4)));
typedef unsigned u32x2 __attribute__((ext_vector_type(2)));
constexpr int BM = 256, BK = 64, HALF = 128, HTB = HALF * BK * 2, STAGE_BYTES = 8 * HTB, NXCD = 8, WGM = 8;

__host__ __device__ __forceinline__ int lds_byte(int r, int c) { const int st = (r >> 4) * 2 + (c >> 5), rr = r & 15, cc = c & 31, ob = rr * 64 + cc * 2; return st * 1024 + (ob ^ (((ob >> 9) & 1) << 5)); }
__host__ __device__ __forceinline__ void stage_rc(int b, int& R, int& C) { const int st = b / 1024, sb = b % 1024, swz = sb ^ (((sb >> 9) & 1) << 5); R = (st >> 1) * 16 + swz / 64; C = (st & 1) * 32 + (swz % 64) / 2; }
__host__ __device__ __forceinline__ int perm32(int rho) { const int n = rho >> 4, i = rho & 15; return 8 * (i >> 2) + 4 * n + (i & 3); }

struct Unit { int pm, pn; };
struct Gemm { const bf16_t* A; const bf16_t* A1; const bf16_t* A2; const bf16_t* Bt; };

template <int NM, int NN> struct StaticOrderT {
    int G, c;
    __device__ __forceinline__ bool next(int i, Unit& u) const {
        constexpr int nwg = NM * NN;
        const int L = i * G + c; if (c < 0 || L >= nwg) return false;
        int wgid = L; { constexpr int q = nwg / NXCD, r = nwg % NXCD; const int xcd = wgid % NXCD, off = wgid / NXCD; wgid = (xcd < r ? xcd * (q + 1) : r * (q + 1) + (xcd - r) * q) + off; }
        constexpr int nig = WGM * NN; const int gid = wgid / nig, fm = gid * WGM, gsz = (NM - fm) < WGM ? (NM - fm) : WGM;
        u.pm = fm + ((wgid % nig) % gsz); u.pn = (wgid % nig) / gsz; return true;
    }
};

typedef float f32x2k __attribute__((ext_vector_type(2))); typedef __bf16 bf16x2k __attribute__((ext_vector_type(2)));
__device__ __forceinline__ unsigned cvt_pk_bf16(float lo, float hi) { f32x2k v = {lo, hi}; bf16x2k b = __builtin_convertvector(v, bf16x2k); return __builtin_bit_cast(unsigned, b); }

template <class Epi, bool ALIGN_EPI, int M_, int N_, int K_, int LDA_, int SEGT_>
__device__ __forceinline__ void gemm_phase(PG8_LAS unsigned char* lds, const Gemm g, int G_, int c_, const Epi& E) {
    const StaticOrderT<M_ / BM, N_ / BM> S{G_, c_};
    const int tid = opaque_tid(), wid = __builtin_amdgcn_readfirstlane(tid >> 6), lane = tid & 63, wr = wid >> 2, wc = wid & 3, fr = lane & 15, fq = lane >> 4;
    constexpr int K = K_, nt = K / BK, lda = LDA_, segt = SEGT_;
    unsigned voffA[2], voffB[2];
#pragma unroll
    for (int i = 0; i < 2; ++i) { int R, C; stage_rc(tid * 16 + i * 8192, R, C); const int Rb = Epi::PERM ? ((R & ~31) + perm32(R & 31)) : R;
        voffA[i] = (unsigned)(R * lda + C) * 2u; voffB[i] = (unsigned)(Rb * K + C) * 2u; }
    constexpr size_t kstep = (size_t)(BK * 2);
    constexpr size_t hstepA = (size_t)HALF * lda * 2, hstepB = (size_t)HALF * K * 2;
    constexpr size_t tstepA = 2 * hstepA, tstepB = 2 * hstepB;
    const unsigned ldsw = (unsigned)wid * 1024u;
    const int aoff = lds_byte(wr * 64 + fr, fq * 8), boff = lds_byte(wc * 32 + fr, fq * 8);
    auto atile = [&](int pm, int t) -> const char* { if constexpr (segt >= nt) { return (const char*)g.A + (size_t)pm * tstepA + (size_t)t * kstep; }
        else { const int s = t / segt; const bf16_t* b = (s == 0) ? g.A : ((s == 1) ? g.A1 : g.A2); return (const char*)b + (size_t)pm * tstepA + (size_t)(t - s * segt) * kstep; } };
#define PG8_SA(b, h) (((b) * 2 + (h)) * HTB)
#define PG8_SB(b, h) ((4 + (b) * 2 + (h)) * HTB)
#define PG8_STAGE(bufoff, gbase, voff) do { _Pragma("unroll") for (int _i = 0; _i < 2; ++_i) \
        __builtin_amdgcn_global_load_lds((const unsigned*)((const char*)(gbase) + (voff)[_i]), (PG8_LAS unsigned*)(lds + (bufoff) + ldsw + _i * 8192), 16, 0, 0); } while (0)
#define PG8_LDA(dst, b, h) do { _Pragma("unroll") for (int m = 0; m < 4; ++m) _Pragma("unroll") for (int k = 0; k < 2; ++k) dst[m][k] = *(const PG8_LAS bf16x8*)(lds + PG8_SA(b, h) + aoff + m * 2048 + k * 1024); } while (0)
#define PG8_LDB(dst, b, h) do { _Pragma("unroll") for (int n = 0; n < 2; ++n) _Pragma("unroll") for (int k = 0; k < 2; ++k) dst[n][k] = *(const PG8_LAS bf16x8*)(lds + PG8_SB(b, h) + boff + n * 2048 + k * 1024); } while (0)
#define PG8_MMA(ai, bj, At, Bt) do { __builtin_amdgcn_s_setprio(1); _Pragma("unroll") for (int m = 0; m < 4; ++m) _Pragma("unroll") for (int n = 0; n < 2; ++n) _Pragma("unroll") for (int k = 0; k < 2; ++k) \
        acc[ai][bj][m][n] = __builtin_amdgcn_mfma_f32_16x16x32_bf16(Bt[n][k], At[m][k], acc[ai][bj][m][n], 0, 0, 0); __builtin_amdgcn_s_setprio(0); } while (0)
#define PG8_WAIT_V(n) asm volatile("s_waitcnt vmcnt(" #n ")" ::: "memory")
#define PG8_WAIT_L(n) asm volatile("s_waitcnt lgkmcnt(" #n ")" ::: "memory")
#define PG8_BAR __builtin_amdgcn_s_barrier()
#define PG8_SCHED __builtin_amdgcn_sched_barrier(0)
    Unit cur, nxt; int ui = 0;
    if (!S.next(0, cur)) return;
    f32x4 acc[2][2][4][2];
#pragma unroll
    for (int a = 0; a < 2; ++a)
#pragma unroll
        for (int b = 0; b < 2; ++b)
#pragma unroll
            for (int m = 0; m < 4; ++m)
#pragma unroll
                for (int n = 0; n < 2; ++n) acc[a][b][m][n] = (f32x4){0.f, 0.f, 0.f, 0.f};
    bf16x8 At[4][2], B0[2][2], B1[2][2];
    const char* cB = (const char*)g.Bt + (size_t)cur.pn * tstepB;
    {
        const char* cA0 = atile(cur.pm, 0); const char* cA1 = atile(cur.pm, 1);
        PG8_STAGE(PG8_SB(0, 0), cB, voffB); PG8_STAGE(PG8_SB(0, 1), cB + hstepB, voffB); PG8_STAGE(PG8_SA(0, 0), cA0, voffA); PG8_STAGE(PG8_SA(0, 1), cA0 + hstepA, voffA);
        if (wr == 1) PG8_BAR;
        PG8_WAIT_V(2); PG8_BAR;
        PG8_STAGE(PG8_SB(1, 0), cB + kstep, voffB); PG8_STAGE(PG8_SA(1, 0), cA1, voffA); PG8_STAGE(PG8_SB(1, 1), cB + hstepB + kstep, voffB);
        PG8_WAIT_V(6); PG8_BAR;
    }
    for (;;) {
        const bool has_next = S.next(ui + 1, nxt);
        const int npm = has_next ? nxt.pm : cur.pm;
        const char* nB = has_next ? (const char*)g.Bt + (size_t)nxt.pn * tstepB : cB;
#pragma unroll 1
        for (int t = 0; t < nt; t += 2) {
            const bool last = (t == nt - 2);
            if constexpr (Epi::HAS_HOOK) E.khook(acc, cur, t, wr, wc, fr, fq);
            const char* a1 = atile(cur.pm, t + 1);
            const char* a2 = last ? atile(npm, 0) : atile(cur.pm, t + 2); const char* b2 = last ? nB : cB + (size_t)(t + 2) * kstep;
            const char* a3 = last ? atile(npm, 1) : atile(cur.pm, t + 3); const char* b3 = b2 + kstep;
            PG8_LDB(B0, 0, 0); PG8_LDB(B1, 0, 1); PG8_SCHED; PG8_LDA(At, 0, 0); PG8_STAGE(PG8_SA(1, 1), a1 + hstepA, voffA);
            PG8_WAIT_V(8); PG8_WAIT_L(0); PG8_BAR; PG8_MMA(0, 0, At, B0); PG8_MMA(0, 1, At, B1); PG8_BAR; PG8_SCHED;
            PG8_LDA(At, 0, 1); PG8_STAGE(PG8_SB(0, 0), b2, voffB); PG8_STAGE(PG8_SB(0, 1), b2 + hstepB, voffB); PG8_STAGE(PG8_SA(0, 0), a2, voffA);
            PG8_WAIT_V(8); PG8_WAIT_L(0); PG8_BAR; PG8_MMA(1, 0, At, B0); PG8_MMA(1, 1, At, B1); PG8_BAR; PG8_SCHED;
            PG8_LDB(B0, 1, 0); PG8_LDB(B1, 1, 1); PG8_SCHED; PG8_LDA(At, 1, 0); PG8_STAGE(PG8_SA(0, 1), a2 + hstepA, voffA);
            PG8_WAIT_V(8); PG8_WAIT_L(0); PG8_BAR; PG8_MMA(0, 0, At, B0); PG8_MMA(0, 1, At, B1); PG8_BAR; PG8_SCHED;
            PG8_LDA(At, 1, 1); PG8_STAGE(PG8_SB(1, 0), b3, voffB); PG8_STAGE(PG8_SB(1, 1), b3 + hstepB, voffB); PG8_STAGE(PG8_SA(1, 0), a3, voffA);
            PG8_WAIT_V(8); PG8_WAIT_L(0); PG8_BAR; PG8_MMA(1, 0, At, B0); PG8_MMA(1, 1, At, B1); PG8_BAR; PG8_SCHED;
        }
        if constexpr (ALIGN_EPI) { if (wr == 0) PG8_BAR; }
        E(acc, cur, wr, wc, fr, fq);
        if (!has_next) break;
#pragma unroll
        for (int a = 0; a < 2; ++a)
#pragma unroll
            for (int b = 0; b < 2; ++b)
#pragma unroll
                for (int m = 0; m < 4; ++m)
#pragma unroll
                    for (int n = 0; n < 2; ++n) acc[a][b][m][n] = (f32x4){0.f, 0.f, 0.f, 0.f};
        cur = nxt; cB = nB; ++ui;
        if constexpr (ALIGN_EPI) { if (wr == 1) PG8_BAR; }
    }
    PG8_WAIT_V(0);
    if constexpr (!ALIGN_EPI) { if (wr == 0) PG8_BAR; }
    PG8_BAR;
#undef PG8_SA
#undef PG8_SB
#undef PG8_STAGE
#undef PG8_LDA
#undef PG8_LDB
#undef PG8_MMA
#undef PG8_WAIT_V
#undef PG8_WAIT_L
#undef PG8_BAR
#undef PG8_SCHED
}

__device__ __forceinline__ void rstd8(const float* ssq, int row0, int fq, float (&rs)[2][4]) {
    f32x4 p[2][4];
#pragma unroll
    for (int ai = 0; ai < 2; ++ai)
#pragma unroll
        for (int m = 0; m < 4; ++m) p[ai][m] = *(const f32x4*)(ssq + 16 * (size_t)(row0 + ai * HALF + m * 16) + 4 * fq);
#pragma unroll
    for (int ai = 0; ai < 2; ++ai)
#pragma unroll
        for (int m = 0; m < 4; ++m) { float t = (p[ai][m][0] + p[ai][m][1]) + (p[ai][m][2] + p[ai][m][3]); t = sum_rows4(t); rs[ai][m] = rsqrtf(t * (1.f / 1024.f) + 1e-6f); }
    asm volatile("" ::: "memory");
}
__device__ __forceinline__ void rstd4(const float* ssq, int row0, int fq, float (&rs)[4]) {
    f32x4 p[4];
#pragma unroll
    for (int m = 0; m < 4; ++m) p[m] = *(const f32x4*)(ssq + 16 * (size_t)(row0 + m * 16) + 4 * fq);
#pragma unroll
    for (int m = 0; m < 4; ++m) { float t = (p[m][0] + p[m][1]) + (p[m][2] + p[m][3]); t = sum_rows4(t); rs[m] = rsqrtf(t * (1.f / 1024.f) + 1e-6f); }
    asm volatile("" ::: "memory");
}
__device__ __forceinline__ float rstd16(const float* ssq, int r) {
    const f32x4* p = (const f32x4*)(ssq + 16 * (size_t)r);
    const f32x4 a = p[0], b = p[1], c = p[2], d = p[3];
    const float s = (((a[0] + a[1]) + (a[2] + a[3])) + ((b[0] + b[1]) + (b[2] + b[3]))) + (((c[0] + c[1]) + (c[2] + c[3])) + ((d[0] + d[1]) + (d[2] + d[3])));
    return rsqrtf(s * (1.f / 1024.f) + 1e-6f);
}
__device__ __forceinline__ float bfl(unsigned w) { return __uint_as_float(w << 16); }
__device__ __forceinline__ float bfh(unsigned w) { return __uint_as_float(w & 0xffff0000u); }
__device__ __forceinline__ float sigm(float x) { return __builtin_amdgcn_rcpf(1.f + __expf(-x)); }

struct EpiRowScale {
    static constexpr bool PERM = true, HAS_HOOK = false;
    bf16_t* O; const float* ssq; int ldc; int act;
    __device__ __forceinline__ void operator()(const f32x4 (&acc)[2][2][4][2], const Unit& u, int wr, int wc, int fr, int fq) const {
        const int row0 = u.pm * BM + wr * 64 + fr, col0 = u.pn * BM + wc * 32 + 8 * fq;
        float rs8[2][4];
        if (ssq) rstd8(ssq, row0, fq, rs8);
#pragma unroll
        for (int ai = 0; ai < 2; ++ai)
#pragma unroll
            for (int m = 0; m < 4; ++m) { const int r = row0 + ai * HALF + m * 16; const float rs = ssq ? rs8[ai][m] : 1.f; bf16_t* rowp = O + (size_t)r * ldc + col0;
#pragma unroll
                for (int bj = 0; bj < 2; ++bj) { f32x4 v0 = acc[ai][bj][m][0] * rs, v1 = acc[ai][bj][m][1] * rs;
                    if (act == 1) {
#pragma unroll
                        for (int i = 0; i < 4; ++i) { v0[i] = sigm(v0[i]); v1[i] = sigm(v1[i]); } }
                    u32x4 w; w.x = cvt_pk_bf16(v0[0], v0[1]); w.y = cvt_pk_bf16(v0[2], v0[3]); w.z = cvt_pk_bf16(v1[0], v1[1]); w.w = cvt_pk_bf16(v1[2], v1[3]);
                    *(u32x4*)(rowp + bj * HALF) = w; } }
    }
};
__device__ __forceinline__ unsigned pk_f16(float lo, float hi) { const _Float16 a = (_Float16)lo, b = (_Float16)hi; return (unsigned)__builtin_bit_cast(unsigned short, a) | ((unsigned)__builtin_bit_cast(unsigned short, b) << 16); }
struct EpiLora {
    static constexpr bool PERM = true, HAS_HOOK = false;
    unsigned short* base; const float* w0; const float* a0;
    __device__ __forceinline__ void operator()(const f32x4 (&acc)[2][2][4][2], const Unit& u, int wr, int wc, int fr, int fq) const {
        const int kind = u.pn >> 1;
        const int row0 = u.pm * BM + wr * 64 + fr, col0 = (u.pn & 1) * BM + wc * 32 + 8 * fq;
        unsigned short* O = base + (size_t)kind * ((size_t)16384 * 512);
        f32x4 bv[2][2];
#pragma unroll
        for (int bj = 0; bj < 2; ++bj)
#pragma unroll
            for (int n = 0; n < 2; ++n) { const f32x4 b0 = *(const f32x4*)(w0 + col0 + bj * HALF + 4 * n), b1 = *(const f32x4*)(a0 + col0 + bj * HALF + 4 * n);
                bv[bj][n] = (kind == 0) ? b0 : ((kind == 1) ? b1 : (f32x4){0.f, 0.f, 0.f, 0.f}); }
#pragma unroll
        for (int ai = 0; ai < 2; ++ai)
#pragma unroll
            for (int m = 0; m < 4; ++m) { unsigned short* rowp = O + (size_t)(row0 + ai * HALF + m * 16) * 512 + col0;
#pragma unroll
                for (int bj = 0; bj < 2; ++bj) { float o[8];
#pragma unroll
                    for (int i = 0; i < 8; ++i) o[i] = acc[ai][bj][m][i >> 2][i & 3] + bv[bj][i >> 2][i & 3];
                    u32x4 w;
                    if (kind == 0) {
#pragma unroll
                        for (int i = 0; i < 8; ++i) o[i] = -0.60653066f * __builtin_amdgcn_rcpf(1.f + __expf(-o[i]));
                        w.x = pk_f16(o[0], o[1]); w.y = pk_f16(o[2], o[3]); w.z = pk_f16(o[4], o[5]); w.w = pk_f16(o[6], o[7]);
                    } else {
                        if (kind == 1) {
#pragma unroll
                            for (int i = 0; i < 8; ++i) o[i] = sigm(o[i]); }
                        w.x = cvt_pk_bf16(o[0], o[1]); w.y = cvt_pk_bf16(o[2], o[3]); w.z = cvt_pk_bf16(o[4], o[5]); w.w = cvt_pk_bf16(o[6], o[7]);
                    }
                    *(u32x4*)(rowp + bj * HALF) = w; } }
    }
};
struct EpiVres {
    static constexpr bool PERM = true, HAS_HOOK = false;
    const bf16_t* v; const bf16_t* vf; const float* v0; bf16_t* O;
    __device__ __forceinline__ void operator()(const f32x4 (&acc)[2][2][4][2], const Unit& u, int wr, int wc, int fr, int fq) const {
        const int row0 = u.pm * BM + wr * 64 + fr, col0 = u.pn * BM + wc * 32 + 8 * fq;
#pragma unroll
        for (int ai = 0; ai < 2; ++ai)
#pragma unroll
            for (int m = 0; m < 4; ++m) { const size_t off = (size_t)(row0 + ai * HALF + m * 16) * 512 + col0;
#pragma unroll
                for (int bj = 0; bj < 2; ++bj) {
                    const u32x4 vv = *(const u32x4*)(v + off + bj * HALF), ff = *(const u32x4*)(vf + off + bj * HALF);
                    const f32x4 b0 = *(const f32x4*)(v0 + col0 + bj * HALF), b1 = *(const f32x4*)(v0 + col0 + bj * HALF + 4);
                    float o[8];
#pragma unroll
                    for (int i = 0; i < 8; ++i) { const unsigned vw = vv[i >> 1], fw = ff[i >> 1]; const float x = (i & 1) ? bfh(vw) : bfl(vw), f = (i & 1) ? bfh(fw) : bfl(fw);
                        const float z = ((i < 4) ? b0[i & 3] : b1[i & 3]) + acc[ai][bj][m][i >> 2][i & 3]; o[i] = x + (f - x) * sigm(z); }
                    u32x4 w; w.x = cvt_pk_bf16(o[0], o[1]); w.y = cvt_pk_bf16(o[2], o[3]); w.z = cvt_pk_bf16(o[4], o[5]); w.w = cvt_pk_bf16(o[6], o[7]);
                    *(u32x4*)(O + off + bj * HALF) = w; } }
    }
};
template <bool XIN_BF16, bool WRITE_F32> struct EpiResidual {
    static constexpr bool PERM = true, HAS_HOOK = false;
    const float* xin; const bf16_t* xinb; float* xout; bf16_t* xb; float* ssq;
    __device__ __forceinline__ void operator()(const f32x4 (&acc)[2][2][4][2], const Unit& u, int wr, int wc, int fr, int fq) const {
        const int row0 = u.pm * BM + wr * 64 + fr, col0 = u.pn * BM + wc * 32 + 8 * fq;
#pragma unroll
        for (int ai = 0; ai < 2; ++ai) {
            u32x4 xi[4][2]; f32x4 xf[4][2][2];
#pragma unroll
            for (int m = 0; m < 4; ++m)
#pragma unroll
                for (int bj = 0; bj < 2; ++bj) { const size_t o = (size_t)(row0 + ai * HALF + m * 16) * 1024 + col0 + bj * HALF;
                    if constexpr (XIN_BF16) xi[m][bj] = *(const u32x4*)(xinb + o);
                    else { xf[m][bj][0] = *(const f32x4*)(xin + o); xf[m][bj][1] = *(const f32x4*)(xin + o + 4); } }
            asm volatile("" ::: "memory");
#pragma unroll
            for (int m = 0; m < 4; ++m) { const int r = row0 + ai * HALF + m * 16; float s = 0.f;
#pragma unroll
                for (int bj = 0; bj < 2; ++bj) { const size_t o = (size_t)r * 1024 + col0 + bj * HALF;
                    f32x4 x0, x1;
                    if constexpr (XIN_BF16) { const u32x4 wv = xi[m][bj]; x0 = (f32x4){bfl(wv.x), bfh(wv.x), bfl(wv.y), bfh(wv.y)} + acc[ai][bj][m][0]; x1 = (f32x4){bfl(wv.z), bfh(wv.z), bfl(wv.w), bfh(wv.w)} + acc[ai][bj][m][1]; }
                    else { x0 = xf[m][bj][0] + acc[ai][bj][m][0]; x1 = xf[m][bj][1] + acc[ai][bj][m][1]; }
                    if constexpr (WRITE_F32) { *(f32x4*)(xout + o) = x0; *(f32x4*)(xout + o + 4) = x1; }
                    else {
                        s += ((x0[0] * x0[0] + x0[1] * x0[1]) + (x0[2] * x0[2] + x0[3] * x0[3])) + ((x1[0] * x1[0] + x1[1] * x1[1]) + (x1[2] * x1[2] + x1[3] * x1[3]));
                        u32x4 w; w.x = cvt_pk_bf16(x0[0], x0[1]); w.y = cvt_pk_bf16(x0[2], x0[3]); w.z = cvt_pk_bf16(x1[0], x1[1]); w.w = cvt_pk_bf16(x1[2], x1[3]); *(u32x4*)(xb + o) = w; } }
                if constexpr (!WRITE_F32) { s = sum_rows4(s);
                    if (fq == 0) ssq[(size_t)r * 16 + u.pn * 4 + wc] = s; } }
        }
    }
};
__device__ __forceinline__ size_t gate_chunk(int pm, int pnG, int wave, int i, int lane) { return ((((size_t)pm * 12 + pnG) * 8 + wave) * 16 + i) * 512 + (size_t)lane * 8; }
struct EpiGatesFrag {
    static constexpr bool PERM = true, HAS_HOOK = false;
    bf16_t* O; const float* ssq;
    __device__ __forceinline__ void operator()(const f32x4 (&acc)[2][2][4][2], const Unit& u, int wr, int wc, int fr, int fq) const {
        const int row0 = u.pm * BM + wr * 64 + fr, wave = wr * 4 + wc, lane = fq * 16 + fr;
        float rs8[2][4];
        rstd8(ssq, row0, fq, rs8);
#pragma unroll
        for (int ai = 0; ai < 2; ++ai)
#pragma unroll
            for (int m = 0; m < 4; ++m) { const float rs = rs8[ai][m];
#pragma unroll
                for (int bj = 0; bj < 2; ++bj) { f32x4 v0 = acc[ai][bj][m][0] * rs, v1 = acc[ai][bj][m][1] * rs;
#pragma unroll
                    for (int i = 0; i < 4; ++i) { v0[i] = __expf(-fmaxf(v0[i], -60.f)); v1[i] = __expf(-fmaxf(v1[i], -60.f)); }
                    u32x4 w; w.x = cvt_pk_bf16(v0[0], v0[1]); w.y = cvt_pk_bf16(v0[2], v0[3]); w.z = cvt_pk_bf16(v1[0], v1[1]); w.w = cvt_pk_bf16(v1[2], v1[3]);
                    *(u32x4*)(O + gate_chunk(u.pm, u.pn, wave, (ai * 4 + m) * 2 + bj, lane)) = w; } }
    }
};
struct EpiGated {
    static constexpr bool PERM = true, HAS_HOOK = true;
    const bf16_t* gates; bf16_t* O;
    __device__ __forceinline__ void khook(f32x4 (&acc)[2][2][4][2], const Unit& u, int t, int wr, int wc, int fr, int fq) const {
        if (t != 8 && t != 16) return;
        const int b = (t >> 3) - 1, wave = wr * 4 + wc, lane = fq * 16 + fr;
#pragma unroll
        for (int ai = 0; ai < 2; ++ai)
#pragma unroll
            for (int mp = 0; mp < 2; ++mp) {
                u32x4 w0[2][2], w1[2][2];
#pragma unroll
                for (int mm = 0; mm < 2; ++mm)
#pragma unroll
                    for (int bj = 0; bj < 2; ++bj) { const int i = (ai * 4 + 2 * mp + mm) * 2 + bj;
                        w0[mm][bj] = *(const u32x4*)(gates + gate_chunk(u.pm, b * 4 + u.pn, wave, i, lane)); w1[mm][bj] = *(const u32x4*)(gates + gate_chunk(u.pm, (b + 1) * 4 + u.pn, wave, i, lane)); }
                asm volatile("" ::: "memory");
#pragma unroll
                for (int mm = 0; mm < 2; ++mm)
#pragma unroll
                    for (int bj = 0; bj < 2; ++bj) { const int m = 2 * mp + mm;
#pragma unroll
                        for (int n = 0; n < 2; ++n) { const unsigned a0 = n ? w0[mm][bj].z : w0[mm][bj].x, a1 = n ? w0[mm][bj].w : w0[mm][bj].y, c0 = n ? w1[mm][bj].z : w1[mm][bj].x, c1 = n ? w1[mm][bj].w : w1[mm][bj].y;
                            f32x4 r;
                            r[0] = (1.f + bfl(c0)) * __builtin_amdgcn_rcpf(1.f + bfl(a0)); r[1] = (1.f + bfh(c0)) * __builtin_amdgcn_rcpf(1.f + bfh(a0));
                            r[2] = (1.f + bfl(c1)) * __builtin_amdgcn_rcpf(1.f + bfl(a1)); r[3] = (1.f + bfh(c1)) * __builtin_amdgcn_rcpf(1.f + bfh(a1));
                            acc[ai][bj][m][n] *= r; } }
                asm volatile("" ::: "memory");
            }
    }
    __device__ __forceinline__ void operator()(const f32x4 (&acc)[2][2][4][2], const Unit& u, int wr, int wc, int fr, int fq) const {
        const int row0 = u.pm * BM + wr * 64 + fr, col0 = u.pn * BM + wc * 32 + 8 * fq, wave = wr * 4 + wc, lane = fq * 16 + fr;
#pragma unroll
        for (int ai = 0; ai < 2; ++ai) {
            u32x4 w2[4][2];
#pragma unroll
            for (int m = 0; m < 4; ++m)
#pragma unroll
                for (int bj = 0; bj < 2; ++bj) w2[m][bj] = *(const u32x4*)(gates + gate_chunk(u.pm, 8 + u.pn, wave, (ai * 4 + m) * 2 + bj, lane));
            asm volatile("" ::: "memory");
#pragma unroll
            for (int m = 0; m < 4; ++m) { const int r = row0 + ai * HALF + m * 16;
#pragma unroll
                for (int bj = 0; bj < 2; ++bj) { const u32x4 g2 = w2[m][bj];
                    const f32x4 a0 = acc[ai][bj][m][0], a1 = acc[ai][bj][m][1];
                    u32x4 w; w.x = cvt_pk_bf16(a0[0] * __builtin_amdgcn_rcpf(1.f + bfl(g2.x)), a0[1] * __builtin_amdgcn_rcpf(1.f + bfh(g2.x))); w.y = cvt_pk_bf16(a0[2] * __builtin_amdgcn_rcpf(1.f + bfl(g2.y)), a0[3] * __builtin_amdgcn_rcpf(1.f + bfh(g2.y)));
                    w.z = cvt_pk_bf16(a1[0] * __builtin_amdgcn_rcpf(1.f + bfl(g2.z)), a1[1] * __builtin_amdgcn_rcpf(1.f + bfh(g2.z))); w.w = cvt_pk_bf16(a1[2] * __builtin_amdgcn_rcpf(1.f + bfl(g2.w)), a1[3] * __builtin_amdgcn_rcpf(1.f + bfh(g2.w)));
                    *(u32x4*)(O + (size_t)r * 1024 + col0 + bj * HALF) = w; } }
        }
    }
};
template <int N> __device__ __forceinline__ float ror16(float v) { return __builtin_bit_cast(float, __builtin_amdgcn_update_dpp(0, __builtin_bit_cast(int, v), 0x120 + N, 0xf, 0xf, false)); }
__device__ __forceinline__ float silu_mul(float g, float v) { return g * __builtin_amdgcn_rcpf(1.f + __expf(-g)) * v; }
struct EpiConv {
    static constexpr bool PERM = true, HAS_HOOK = false;
    const float* ssq; const float* cw; const float* cb; bf16_t* U; float* side;
    __device__ __forceinline__ void operator()(const f32x4 (&acc)[2][2][4][2], const Unit& u, int wr, int wc, int fr, int fq) const {
        const int ch0 = u.pn * 128 + wc * 32 + 8 * fq;
        float rsa[4], rsb[4];
        rstd4(ssq, u.pm * BM + wr * 64 + fr, fq, rsa); rstd4(ssq, u.pm * BM + HALF + wr * 64 + fr, fq, rsb);
#pragma unroll
        for (int n = 0; n < 2; ++n) {
            const int ch = ch0 + 4 * n;
            const f32x4 g0 = *(const f32x4*)(cw + ch), g1 = *(const f32x4*)(cw + 5632 + ch), g2 = *(const f32x4*)(cw + 2 * 5632 + ch), gb = *(const f32x4*)(cb + ch);
            const f32x4 v0 = *(const f32x4*)(cw + 2816 + ch), v1 = *(const f32x4*)(cw + 5632 + 2816 + ch), v2 = *(const f32x4*)(cw + 2 * 5632 + 2816 + ch), vb = *(const f32x4*)(cb + 2816 + ch);
#pragma unroll
            for (int ai = 0; ai < 2; ++ai) {
                const int cid = u.pm * 4 + ai * 2 + wr;
                f32x4 pg = (f32x4){0.f, 0.f, 0.f, 0.f}, pv = pg;
#pragma unroll
                for (int m = 0; m < 4; ++m) {
                    const float rsm = ai ? rsb[m] : rsa[m];
                    const f32x4 cg = acc[ai][0][m][n] * rsm, cv = acc[ai][1][m][n] * rsm;
                    if ((m == 0 && fr < 2) || (m == 3 && fr >= 14)) { const int rr = (m == 0) ? fr : fr - 12;
                        float* sp = side + (((size_t)cid * 4 + rr) * 2) * 2816 + ch; *(f32x4*)sp = cg; *(f32x4*)(sp + 2816) = cv; }
                    f32x4 G, V;
#pragma unroll
                    for (int i = 0; i < 4; ++i) {
                        const float y1g = (fr == 15) ? pg[i] : cg[i], y2g = (fr >= 14) ? pg[i] : cg[i];
                        const float y1v = (fr == 15) ? pv[i] : cv[i], y2v = (fr >= 14) ? pv[i] : cv[i];
                        const float h1g = ror16<1>(y1g), h2g = ror16<2>(y2g), h1v = ror16<1>(y1v), h2v = ror16<2>(y2v);
                        G[i] = gb[i] + g0[i] * h2g + g1[i] * h1g + g2[i] * cg[i];
                        V[i] = vb[i] + v0[i] * h2v + v1[i] * h1v + v2[i] * cv[i];
                    }
                    u32x2 w; w.x = cvt_pk_bf16(silu_mul(G[0], V[0]), silu_mul(G[1], V[1])); w.y = cvt_pk_bf16(silu_mul(G[2], V[2]), silu_mul(G[3], V[3]));
                    *(u32x2*)(U + (size_t)(u.pm * BM + ai * HALF + wr * 64 + m * 16 + fr) * 2816 + ch) = w;
                    pg = cg; pv = cv;
                }
            }
        }
    }
};
}


#define LAS3 __attribute__((address_space(3)))
typedef float f32x4v __attribute__((ext_vector_type(4)));
typedef float f32x2v __attribute__((ext_vector_type(2)));
typedef unsigned u32x2v __attribute__((ext_vector_type(2)));
typedef unsigned u32x4v __attribute__((ext_vector_type(4)));
template <int CTRL> __device__ __forceinline__ float dppf(float v) { return __builtin_bit_cast(float, __builtin_amdgcn_update_dpp(0, __builtin_bit_cast(int, v), CTRL, 0xf, 0xf, true)); }
__device__ __forceinline__ float allsum16(float v) { v += dppf<0xB1>(v); v += dppf<0x4E>(v); v += dppf<0x141>(v); v += dppf<0x140>(v); return v; }
struct ScanArgs { const bf16* r_s; const bf16* k_s; const bf16* v; const bf16* a; const unsigned short* ld; const float* nrm; const float* k_k; const float* k_a; bf16* y_raw; const float* r_k; float* bonus; };
__device__ __forceinline__ float bf_lo(unsigned w) { return __uint_as_float(w << 16); }
__device__ __forceinline__ float bf_hi(unsigned w) { return __uint_as_float(w & 0xffff0000u); }
__device__ __forceinline__ float h_lo(unsigned w) { return (float)__builtin_bit_cast(_Float16, (unsigned short)(w & 0xffffu)); }
__device__ __forceinline__ float h_hi(unsigned w) { return (float)__builtin_bit_cast(_Float16, (unsigned short)(w >> 16)); }

typedef short bf16x8s __attribute__((ext_vector_type(8)));
typedef float f32x4c __attribute__((ext_vector_type(4)));
constexpr int CS_ROW = 144;
constexpr int CS_TR = 40;
constexpr int RC_P = 0, RC_RT = RC_P + 16 * CS_ROW, RC_KB = RC_RT + 16 * CS_ROW, RC_SM = RC_KB + 64 * 80, RC_GC = RC_SM + 16 * CS_ROW, RC_BYTES = RC_GC + 256;
static_assert(RC_BYTES == 12288, "record size");
__device__ __forceinline__ int rc_pos(int key) { return (key & 32) + 8 * ((key >> 2) & 3) + 4 * ((key >> 4) & 1) + (key & 3); }
constexpr int PS_KT = 0, PS_RT = PS_KT + 16 * CS_ROW, PS_KH = PS_RT + 16 * CS_ROW, PS_BH = PS_KH + 16 * CS_ROW, PS_KTT = PS_BH + 16 * CS_ROW, PS_AB = PS_KTT + 64 * CS_TR, PS_TM = PS_AB + 1024, PS_R2 = PS_TM + 16 * CS_TR, PS_BYTES = PS_R2 + 16 * CS_ROW;
static_assert(PS_BYTES % 16 == 0 && 8 * PS_BYTES <= 147456 - 64, "producer scratch");
constexpr int SL_VT = RC_BYTES, SL_BYTES = SL_VT + 64 * CS_TR, CS_GRP = 2, CS_RING = 4 * CS_GRP;
static_assert(SL_BYTES % 16 == 0 && CS_RING * SL_BYTES <= 147456 - 64, "consumer ring");
constexpr int CS_NCHUNK = SEQ / 16, CS_NITEM = 64 * CS_NCHUNK;
constexpr int CS_NA = (int)((64u << 20) / RC_BYTES);
struct CsRec { unsigned char* a; unsigned char* b; unsigned char* c; };
__device__ __forceinline__ unsigned char* cs_rec(const CsRec& R, int item) {
    constexpr int NB = (int)((32u << 20) / RC_BYTES);
    return item < CS_NA ? R.a + (size_t)item * RC_BYTES : (item < CS_NA + NB ? R.b + (size_t)(item - CS_NA) * RC_BYTES : R.c + (size_t)(item - CS_NA - NB) * RC_BYTES);
}
static_assert(CS_NA + (int)((32u << 20) / RC_BYTES) + (int)((16u << 20) / RC_BYTES) >= CS_NITEM, "record space");

typedef short bf16x4s __attribute__((ext_vector_type(4)));
__device__ __forceinline__ bf16x4s frag4(const LAS3 unsigned char* p) { return __builtin_bit_cast(bf16x4s, *(const LAS3 u32x2v*)p); }
__device__ __forceinline__ bf16x8s frag_2x4(const LAS3 unsigned char* p0, const LAS3 unsigned char* p1) {
    const u32x2v a = *(const LAS3 u32x2v*)p0, b = *(const LAS3 u32x2v*)p1; const u32x4v f = {a[0], a[1], b[0], b[1]}; return __builtin_bit_cast(bf16x8s, f); }
__device__ __forceinline__ bf16x4s pack4(const f32x4c& x) { const u32x2v f = {pg8::cvt_pk_bf16(x[0], x[1]), pg8::cvt_pk_bf16(x[2], x[3])}; return __builtin_bit_cast(bf16x4s, f); }
__device__ __forceinline__ f32x4c zero4_opaque() { int zi = 0; asm volatile("" : "+s"(zi)); const float zf = __builtin_bit_cast(float, zi); f32x4c z = {zf, zf, zf, zf}; asm volatile("" : "+v"(z)); return z; }
__device__ __forceinline__ bf16x8s pad8(bf16x4s a) { const u32x2v w = __builtin_bit_cast(u32x2v, a); const u32x4v f = {w[0], w[1], 0u, 0u}; return __builtin_bit_cast(bf16x8s, f); }
#define MFMA16K(a, b, c) __builtin_amdgcn_mfma_f32_16x16x32_bf16(pad8(a), pad8(b), c, 0, 0, 0)
#define MFMA16(a, b, c) __builtin_amdgcn_mfma_f32_16x16x32_bf16(a, b, c, 0, 0, 0)

__device__ __forceinline__ void cscan_produce(LAS3 unsigned char* sc, const ScanArgs& A, const CsRec& R, int gw_, int NGW_) {
    const int lane = opaque_tid() & 63, li = lane & 15, lq = lane >> 4;
    unsigned wrk[16]; unsigned short wa_[16], wl_[16]; float rnv;
    auto load_raw = [&](int item_v) {
        const int item = __builtin_amdgcn_readfirstlane(item_v);
        const int bh = item >> 7, c = item & 127, b = bh >> 3, h = bh & 7;
        const size_t row0 = (size_t)b * SEQ + (size_t)c * 16;
        const unsigned* prk = (const unsigned*)A.r_s + row0 * 512 + h * 64 + lane; const bf16* pa = A.a + row0 * 512 + h * 64 + lane;
        const unsigned short* pl = A.ld + row0 * 512 + h * 64 + lane; const float* pn = A.nrm + row0 * 8 + h;
#pragma unroll
        for (int s = 0; s < 16; ++s) { wrk[s] = prk[s * 512]; wa_[s] = pa[s * 512]; wl_[s] = pl[s * 512]; }
        rnv = pn[(lane & 15) * 8];
    };
    if (gw_ < CS_NITEM) load_raw(gw_);
    for (int item_v = gw_; item_v < CS_NITEM; item_v += NGW_) {
        const int item = __builtin_amdgcn_readfirstlane(item_v);
        const int h = (item >> 7) & 7;
        const float kkc = A.k_k[h * 64 + lane], kac = A.k_a[h * 64 + lane], rkc = A.r_k[h * 64 + lane];
        unsigned char* rec = cs_rec(R, item);
        float g = 1.f, kh4[4], bh4[4];
        const int lp2 = 2 * rc_pos(lane);
        unsigned ktw[8];
#pragma unroll
        for (int s = 0; s < 16; ++s) {
            const float r = __uint_as_float(wrk[s] << 16), k = __uint_as_float(wrk[s] & 0xffff0000u), aa = __uint_as_float((unsigned)wa_[s] << 16);
            const float dec = __expf((float)__builtin_bit_cast(_Float16, wl_[s]));
            const float gm1 = g; g *= dec;
            const float ig = __builtin_amdgcn_rcpf(g);
            const float rns = __builtin_bit_cast(float, __builtin_amdgcn_readlane(__builtin_bit_cast(int, rnv), s));
            const float kk = k * kkc * rns, bb = kk * aa, kt = k * (1.f + (aa - 1.f) * kac);
            const float ktil = kk * gm1, khs = kt * ig, bhs = bb * ig; kh4[s & 3] = khs; bh4[s & 3] = -bhs;
            const unsigned w0 = pg8::cvt_pk_bf16(ktil, khs), w1 = pg8::cvt_pk_bf16(bhs, r * g);
            *(LAS3 unsigned short*)(sc + PS_R2 + s * CS_ROW + lp2) = (unsigned short)(pg8::cvt_pk_bf16(r * g * rkc, 0.f) & 0xffffu);
            *(LAS3 unsigned short*)(sc + PS_KT + s * CS_ROW + lp2) = (unsigned short)(w0 & 0xffffu);
            *(LAS3 unsigned short*)(sc + PS_KH + s * CS_ROW + lp2) = (unsigned short)(w0 >> 16);
            *(LAS3 unsigned short*)(sc + PS_BH + s * CS_ROW + lp2) = (unsigned short)(w1 & 0xffffu);
            *(LAS3 unsigned short*)(sc + PS_RT + s * CS_ROW + lp2) = (unsigned short)(w1 >> 16);
            if (s & 1) ktw[s >> 1] |= (w0 & 0xffffu) << 16; else ktw[s >> 1] = w0 & 0xffffu;
            if ((s & 3) == 3) { const int q4 = s >> 2;
                *(u32x4v*)(rec + RC_KB + lane * 80 + 16 * q4) = (u32x4v){pg8::cvt_pk_bf16(kh4[0], kh4[1]), pg8::cvt_pk_bf16(kh4[2], kh4[3]), pg8::cvt_pk_bf16(bh4[0], bh4[1]), pg8::cvt_pk_bf16(bh4[2], bh4[3])}; }
        }
        *(float*)(rec + RC_GC + 4 * lane) = g;
#pragma unroll
        for (int q4 = 0; q4 < 4; ++q4) *(LAS3 u32x2v*)(sc + PS_KTT + lane * CS_TR + 8 * q4) = (u32x2v){ktw[2 * q4], ktw[2 * q4 + 1]};
        if (item + NGW_ < CS_NITEM) load_raw(item + NGW_);
        asm volatile("s_waitcnt lgkmcnt(0)" ::: "memory");
        f32x4c ak = zero4_opaque(), ab = zero4_opaque(), bk = zero4_opaque(), bb4 = zero4_opaque(), bd = zero4_opaque();
#pragma unroll
        for (int st = 0; st < 2; ++st) {
            const bf16x8s fkt = *(const LAS3 bf16x8s*)(sc + PS_KT + li * CS_ROW + 64 * st + 16 * lq), frt = *(const LAS3 bf16x8s*)(sc + PS_RT + li * CS_ROW + 64 * st + 16 * lq);
            const bf16x8s fkh = *(const LAS3 bf16x8s*)(sc + PS_KH + li * CS_ROW + 64 * st + 16 * lq), fbh = *(const LAS3 bf16x8s*)(sc + PS_BH + li * CS_ROW + 64 * st + 16 * lq);
            ak = MFMA16(fkt, fkh, ak); ab = MFMA16(fkt, fbh, ab); bk = MFMA16(frt, fkh, bk); bb4 = MFMA16(frt, fbh, bb4);
            bd = MFMA16(*(const LAS3 bf16x8s*)(sc + PS_R2 + li * CS_ROW + 64 * st + 16 * lq), fkh, bd);
        }
        if ((li >> 2) == lq) { const int c_ = li & 3; const float bv = c_ == 0 ? bd[0] : (c_ == 1 ? bd[1] : (c_ == 2 ? bd[2] : bd[3]));
            A.bonus[((size_t)(item >> 10) * SEQ + (size_t)(item & 127) * 16 + li) * 8 + h] = bv; }
        {
            float akm[4], bkm[4], bbm[4];
#pragma unroll
            for (int c = 0; c < 4; ++c) { const int so = 4 * lq + c; const bool strict = li < so, incl = li <= so;
                akm[c] = strict ? ak[c] : 0.f; bkm[c] = incl ? bk[c] : 0.f; bbm[c] = incl ? -bb4[c] : 0.f;
                *(LAS3 float*)(sc + PS_AB + (so * 16 + li) * 4) = strict ? ab[c] : 0.f; }
#pragma unroll
            for (int c = 0; c < 4; c += 2) { const unsigned wa = pg8::cvt_pk_bf16(akm[c], akm[c + 1]), wb = pg8::cvt_pk_bf16(bkm[c], bkm[c + 1]), wn = pg8::cvt_pk_bf16(bbm[c], bbm[c + 1]);
                LAS3 unsigned char* r0 = sc + PS_KH + (4 * lq + c) * CS_ROW + 32 * (li >> 2) + 2 * (li & 3); LAS3 unsigned char* r1 = r0 + CS_ROW;
                *(LAS3 unsigned short*)(r0) = (unsigned short)(wa & 0xffffu); *(LAS3 unsigned short*)(r1) = (unsigned short)(wa >> 16);
                *(LAS3 unsigned short*)(r0 + 16) = (unsigned short)(wb & 0xffffu); *(LAS3 unsigned short*)(r1 + 16) = (unsigned short)(wb >> 16);
                *(LAS3 unsigned short*)(r0 + 24) = (unsigned short)(wn & 0xffffu); *(LAS3 unsigned short*)(r1 + 24) = (unsigned short)(wn >> 16); }
        }
        asm volatile("s_waitcnt lgkmcnt(0)" ::: "memory");
        {
            float x[16];
            int lio = li; asm volatile("" : "+v"(lio));
#pragma unroll
            for (int s = 0; s < 16; ++s) {
                float acc0 = (s == lio) ? 1.f : 0.f, acc1 = 0.f;
#pragma unroll
                for (int q4 = 0; q4 < (s + 3) / 4; ++q4) { const f32x4c nrow = *(const LAS3 f32x4c*)(sc + PS_AB + (s * 16 + 4 * q4) * 4);
#pragma unroll
                    for (int e = 0; e < 4; ++e) if (4 * q4 + e < s) { if (e & 1) acc1 = fmaf(-nrow[e], x[4 * q4 + e], acc1); else acc0 = fmaf(-nrow[e], x[4 * q4 + e], acc0); } }
                x[s] = acc0 + acc1;
            }
            if (lq == 0) {
#pragma unroll
                for (int s = 0; s < 16; s += 2) { const unsigned wt = pg8::cvt_pk_bf16(x[s], x[s + 1]);
                    *(LAS3 unsigned short*)(sc + PS_TM + s * CS_TR + 2 * li) = (unsigned short)(wt & 0xffffu); *(LAS3 unsigned short*)(sc + PS_TM + (s + 1) * CS_TR + 2 * li) = (unsigned short)(wt >> 16);
                    *(LAS3 unsigned short*)(sc + PS_KH + s * CS_ROW + 32 * (li >> 2) + 8 + 2 * (li & 3)) = (unsigned short)(wt & 0xffffu); *(LAS3 unsigned short*)(sc + PS_KH + (s + 1) * CS_ROW + 32 * (li >> 2) + 8 + 2 * (li & 3)) = (unsigned short)(wt >> 16); }
            }
        }
        asm volatile("s_waitcnt lgkmcnt(0)" ::: "memory");
        const bf16x4s ftm = frag4(sc + PS_TM + li * CS_TR + 8 * lq);
#pragma unroll
        for (int tk = 0; tk < 4; ++tk) {
            const f32x4c pt = MFMA16K(ftm, frag4(sc + PS_KTT + (16 * tk + li) * CS_TR + 8 * lq), zero4_opaque());
#pragma unroll
            for (int c = 0; c < 4; c += 2) { const unsigned wp = pg8::cvt_pk_bf16(pt[c], pt[c + 1]);
                *(LAS3 unsigned short*)(sc + PS_KT + (4 * lq + c) * CS_ROW + 2 * rc_pos(16 * tk + li)) = (unsigned short)(wp & 0xffffu); *(LAS3 unsigned short*)(sc + PS_KT + (4 * lq + c + 1) * CS_ROW + 2 * rc_pos(16 * tk + li)) = (unsigned short)(wp >> 16); }
        }
        static_assert(PS_KT == 0 && PS_RT == 2304 && PS_KH == 4608 && RC_P == 0 && RC_RT == 2304, "staging order");
#pragma unroll
        for (int i = 0; i < 7; ++i) { const int pi = lane + 64 * i;
            if (i < 6 || pi < 432) { const u32x4v d = *(const LAS3 u32x4v*)(sc + 16 * pi); *(u32x4v*)(rec + (pi < 288 ? 16 * pi : RC_SM + 16 * (pi - 288))) = d; } }
        asm volatile("s_waitcnt lgkmcnt(0)" ::: "memory");
    }
}

struct CsOps { u32x2v fv; u32x4v sm0, sm1, p0, p1, r0, r1, kb[4]; f32x4c gc[4]; };
__device__ __forceinline__ void cs_load_ops(CsOps& o, const LAS3 unsigned char* sl, int w, int li, int lq) {
    o.fv = *(const LAS3 u32x2v*)(sl + SL_VT + (16 * w + li) * CS_TR + 8 * lq);
    o.sm0 = *(const LAS3 u32x4v*)(sl + RC_SM + li * CS_ROW + 32 * lq); o.sm1 = *(const LAS3 u32x4v*)(sl + RC_SM + li * CS_ROW + 32 * lq + 16);
    o.p0 = *(const LAS3 u32x4v*)(sl + RC_P + li * CS_ROW + 16 * lq); o.p1 = *(const LAS3 u32x4v*)(sl + RC_P + li * CS_ROW + 64 + 16 * lq);
    o.r0 = *(const LAS3 u32x4v*)(sl + RC_RT + li * CS_ROW + 16 * lq); o.r1 = *(const LAS3 u32x4v*)(sl + RC_RT + li * CS_ROW + 64 + 16 * lq);
#pragma unroll
    for (int tk = 0; tk < 4; ++tk) { o.kb[tk] = *(const LAS3 u32x4v*)(sl + RC_KB + (16 * tk + li) * 80 + 16 * lq); o.gc[tk] = *(const LAS3 f32x4c*)(sl + RC_GC + (16 * tk + 4 * lq) * 4); }
}
#define CS_B8(x) __builtin_bit_cast(bf16x8s, x)
__device__ __forceinline__ void cs_chunk(const CsOps& o, f32x4c (&H)[4], const f32x4c& Z, bf16* yp) {
    const u32x4v fvp = {o.fv[0], o.fv[1], 0u, 0u};
    const f32x4c akv = MFMA16(CS_B8(((u32x4v){o.sm0[0], o.sm0[1], 0u, 0u})), CS_B8(fvp), Z);
    u32x4v hb0 = {pg8::cvt_pk_bf16(H[0][0], H[0][1]), pg8::cvt_pk_bf16(H[0][2], H[0][3]), pg8::cvt_pk_bf16(H[1][0], H[1][1]), pg8::cvt_pk_bf16(H[1][2], H[1][3])};
    u32x4v hb1 = {pg8::cvt_pk_bf16(H[2][0], H[2][1]), pg8::cvt_pk_bf16(H[2][2], H[2][3]), pg8::cvt_pk_bf16(H[3][0], H[3][1]), pg8::cvt_pk_bf16(H[3][2], H[3][3])};
    f32x4c Y = MFMA16(CS_B8(o.r0), CS_B8(hb0), Z);
    Y = MFMA16(CS_B8(o.r1), CS_B8(hb1), Y);
    f32x4c U = MFMA16(CS_B8(((u32x4v){o.sm0[2], o.sm0[3], 0u, 0u})), CS_B8(((u32x4v){pg8::cvt_pk_bf16(akv[0], akv[1]), pg8::cvt_pk_bf16(akv[2], akv[3]), 0u, 0u})), Z);
    U = MFMA16(CS_B8(o.p0), CS_B8(hb0), U);
    U = MFMA16(CS_B8(o.p1), CS_B8(hb1), U);
    const u32x4v vu = {o.fv[0], o.fv[1], pg8::cvt_pk_bf16(U[0], U[1]), pg8::cvt_pk_bf16(U[2], U[3])};
    Y = MFMA16(CS_B8(o.sm1), CS_B8(vu), Y);
#pragma unroll
    for (int e = 0; e < 4; e += 2) { const unsigned wy = pg8::cvt_pk_bf16(Y[e], Y[e + 1]); yp[(size_t)e * 512] = (bf16)(wy & 0xffffu); yp[(size_t)(e + 1) * 512] = (bf16)(wy >> 16); }
#pragma unroll
    for (int tk = 0; tk < 4; ++tk) H[tk] = MFMA16(CS_B8(o.kb[tk]), CS_B8(vu), H[tk]) * o.gc[tk];
}
__device__ __forceinline__ void cscan_consume(LAS3 unsigned char* lds, const ScanArgs& A, const CsRec& R, int bh) {
    const int tid = opaque_tid(), lane = tid & 63, wave = __builtin_amdgcn_readfirstlane(tid >> 6), li = lane & 15, lq = lane >> 4;
    const int b = bh >> 3, h = bh & 7;
    const size_t rowbase = (size_t)b * SEQ;
    constexpr int NROUND = CS_NCHUNK / CS_GRP;
    if (wave >= 4) {
        const int lt = tid - 256;
        u32x4v rg[4][CS_GRP][3]; u32x2v vg[4][CS_GRP];
#define CS_LD(g_, S_) do { _Pragma("unroll") for (int k = 0; k < CS_GRP; ++k) { const int c_ = CS_GRP * (g_) + k; const unsigned char* rec_ = cs_rec(R, bh * CS_NCHUNK + c_); \
            _Pragma("unroll") for (int i = 0; i < 3; ++i) rg[S_][k][i] = *(const u32x4v*)(rec_ + (lt + 256 * i) * 16); \
            vg[S_][k] = *(const u32x2v*)(A.v + (rowbase + (size_t)c_ * 16 + (lt >> 4)) * 512 + h * 64 + 4 * (lt & 15)); } } while (0)
#define CS_ST(S_) do { _Pragma("unroll") for (int k = 0; k < CS_GRP; ++k) { LAS3 unsigned char* sl_ = lds + ((S_) * CS_GRP + k) * SL_BYTES; \
            _Pragma("unroll") for (int i = 0; i < 3; ++i) *(LAS3 u32x4v*)(sl_ + (lt + 256 * i) * 16) = rg[S_][k][i]; \
            const int s_ = lt >> 4, ch_ = 4 * (lt & 15); \
            *(LAS3 unsigned short*)(sl_ + SL_VT + (ch_ + 0) * CS_TR + 2 * s_) = (unsigned short)(vg[S_][k][0] & 0xffffu); *(LAS3 unsigned short*)(sl_ + SL_VT + (ch_ + 1) * CS_TR + 2 * s_) = (unsigned short)(vg[S_][k][0] >> 16); \
            *(LAS3 unsigned short*)(sl_ + SL_VT + (ch_ + 2) * CS_TR + 2 * s_) = (unsigned short)(vg[S_][k][1] & 0xffffu); *(LAS3 unsigned short*)(sl_ + SL_VT + (ch_ + 3) * CS_TR + 2 * s_) = (unsigned short)(vg[S_][k][1] >> 16); } } while (0)
        CS_LD(0, 0); CS_LD(1, 1); CS_LD(2, 2); CS_LD(3, 3); CS_ST(0); CS_ST(1); CS_LD(4, 0); CS_LD(5, 1);
        __syncthreads();
        for (int g0 = 0; g0 < NROUND; g0 += 4) {
#pragma unroll
            for (int par = 0; par < 4; ++par) {
                const int g = g0 + par;
                if (g + 2 < NROUND) CS_ST((par + 2) & 3);
                if (g + 6 < NROUND) CS_LD(g + 6, (par + 2) & 3);
                __syncthreads();
            }
        }
#undef CS_LD
#undef CS_ST
    } else {
        const int w = wave;
        f32x4c H[4];
#pragma unroll
        for (int tk = 0; tk < 4; ++tk) H[tk] = zero4_opaque();
        const f32x4c Z = zero4_opaque();
        bf16* yp = A.y_raw + (rowbase + 4 * lq) * 512 + h * 64 + 16 * w + li;
        CsOps oa, ob;
        __syncthreads();
        cs_load_ops(oa, lds, w, li, lq);
#pragma unroll 1
        for (int g = 0; g < NROUND; ++g) {
            const LAS3 unsigned char* sl1 = lds + ((g & 3) * CS_GRP + 1) * SL_BYTES;
            const LAS3 unsigned char* sln = lds + (((g + 1) & 3) * CS_GRP) * SL_BYTES;
            __builtin_amdgcn_s_waitcnt(0xC07F);
            cs_load_ops(ob, sl1, w, li, lq);
            cs_chunk(oa, H, Z, yp);
            __builtin_amdgcn_s_waitcnt(0xC07F);
            cs_load_ops(oa, sln, w, li, lq);
            cs_chunk(ob, H, Z, yp + (size_t)16 * 512);
            yp += (size_t)32 * 512;
            __syncthreads();
        }
    }
}
#undef CS_B8

typedef float f32x16v __attribute__((ext_vector_type(16)));
typedef short bf16x8v __attribute__((ext_vector_type(8)));
typedef short bf16x4v __attribute__((ext_vector_type(4)));
constexpr int SB_KSTR = 144, SB_VSTR = 136;
constexpr int SB_KOFF = 0, SB_VOFF = 64 * SB_KSTR, SB_LDS = SB_VOFF + 64 * SB_VSTR;
typedef float f32x2c __attribute__((ext_vector_type(2))); typedef __bf16 bf16x2c __attribute__((ext_vector_type(2)));
__device__ __forceinline__ unsigned cvtpk_c(float lo, float hi) { f32x2c v = {lo, hi}; bf16x2c b = __builtin_convertvector(v, bf16x2c); return __builtin_bit_cast(unsigned, b); }
struct SbArgs { const bf16* proj_sm; const float* qg; const float* kg; bf16* y_b; };

__device__ __forceinline__ void sb_unit(LAS3 unsigned char* lds, const SbArgs& A, int bh, int u) {
    const int tid = opaque_tid(), lane = tid & 63, wave = __builtin_amdgcn_readfirstlane(tid >> 6), r32 = lane & 31, hh = lane >> 5;
    const int b = bh >> 3, h = bh & 7;
    const size_t rowbase = (size_t)b * SEQ;
    const int qrow = 256 * u + 32 * wave + r32;
    bf16x8v qf[4];
    {
        const bf16* qp = A.proj_sm + (rowbase + qrow) * 2048 + h * 64 + 8 * hh;
        u32x4v raw[4]; float x[4][8]; float ss = 0.f;
#pragma unroll
        for (int d0 = 0; d0 < 4; ++d0) { raw[d0] = *(const u32x4v*)(qp + 16 * d0);
#pragma unroll
            for (int j = 0; j < 8; ++j) { const unsigned w = raw[d0][j >> 1]; x[d0][j] = (j & 1) ? __uint_as_float(w & 0xffff0000u) : __uint_as_float(w << 16); ss += x[d0][j] * x[d0][j]; } }
        { auto rr = __builtin_amdgcn_permlane32_swap(__float_as_uint(ss), __float_as_uint(ss), false, false); ss = __uint_as_float(rr[0]) + __uint_as_float(rr[1]); }
        const float sc = rsqrtf(ss * (1.f / 64.f) + NORM_EPS) * (0.125f * 1.4426950408889634f);
#pragma unroll
        for (int d0 = 0; d0 < 4; ++d0) { const f32x4v g0 = *(const f32x4v*)(A.qg + 16 * d0 + 8 * hh), g1 = *(const f32x4v*)(A.qg + 16 * d0 + 8 * hh + 4);
            u32x4v w; w[0] = cvtpk_c(x[d0][0] * sc * g0[0], x[d0][1] * sc * g0[1]); w[1] = cvtpk_c(x[d0][2] * sc * g0[2], x[d0][3] * sc * g0[3]);
            w[2] = cvtpk_c(x[d0][4] * sc * g1[0], x[d0][5] * sc * g1[1]); w[3] = cvtpk_c(x[d0][6] * sc * g1[2], x[d0][7] * sc * g1[3]);
            qf[d0] = __builtin_bit_cast(bf16x8v, w); }
    }
    const int skv = tid >> 3, sc8 = tid & 7;
    const f32x4v kg0 = *(const f32x4v*)(A.kg + 8 * sc8), kg1 = *(const f32x4v*)(A.kg + 8 * sc8 + 4);
    u32x4v gK, gV;
    auto stage_load = [&](int kt) { const bf16* kp = A.proj_sm + (rowbase + kt * 64 + skv) * 2048 + 512 + h * 64 + 8 * sc8; gK = *(const u32x4v*)kp; gV = *(const u32x4v*)(kp + 512); };
    auto stage_store = [&]() {
        float x[8]; float ss = 0.f;
#pragma unroll
        for (int j = 0; j < 8; ++j) { const unsigned w = gK[j >> 1]; x[j] = (j & 1) ? __uint_as_float(w & 0xffff0000u) : __uint_as_float(w << 16); ss += x[j] * x[j]; }
        ss = sum_lanes8(ss);
        const float sc = rsqrtf(ss * (1.f / 64.f) + NORM_EPS);
        u32x4v w; w[0] = cvtpk_c(x[0] * sc * kg0[0], x[1] * sc * kg0[1]); w[1] = cvtpk_c(x[2] * sc * kg0[2], x[3] * sc * kg0[3]);
        w[2] = cvtpk_c(x[4] * sc * kg1[0], x[5] * sc * kg1[1]); w[3] = cvtpk_c(x[6] * sc * kg1[2], x[7] * sc * kg1[3]);
        *(LAS3 u32x4v*)(lds + SB_KOFF + skv * SB_KSTR + 16 * sc8) = w;
#pragma unroll
        for (int j = 0; j < 8; ++j) { const unsigned wv = gV[j >> 1]; const unsigned short e = (j & 1) ? (unsigned short)(wv >> 16) : (unsigned short)(wv & 0xffffu);
            *(LAS3 unsigned short*)(lds + SB_VOFF + (8 * sc8 + j) * SB_VSTR + 2 * skv) = e; }
    };
    f32x16v o0, o1;
#pragma unroll
    for (int i = 0; i < 16; ++i) { o0[i] = 0.f; o1[i] = 0.f; }
    float R = 1.f;
    const int kt0 = 4 * u + 3;
    const int qmin = 256 * u + 32 * wave;
    stage_load(kt0);
    for (int kt = kt0; kt >= 0; --kt) {
        const bool mine = __all(R == 0.f);
        {
            LAS3 unsigned* flagw = (LAS3 unsigned*)(lds + SB_LDS);
            if (tid == 0) flagw[0] = 0u;
            __syncthreads();
            if (!mine && lane == 0) flagw[0] = 1u;
            __syncthreads();
            if (flagw[0] == 0u) break;
        }
        stage_store();
        if (kt > 0) stage_load(kt - 1);
        __syncthreads();
        if (kt * 64 <= qmin + 31 && !mine) {
        f32x16v p0, p1;
        {
            const int kb0 = kt * 64 + 4 * hh;
#pragma unroll
            for (int r = 0; r < 16; ++r) { const int kv = kb0 + (r & 3) + 8 * (r >> 2); p0[r] = (kv >= qrow) ? -1e30f : 0.f; p1[r] = (kv + 32 >= qrow) ? -1e30f : 0.f; }
        }
        asm volatile("" : "+v"(p0), "+v"(p1));
        const LAS3 unsigned char* kb = lds + SB_KOFF + r32 * SB_KSTR + 16 * hh;
        const LAS3 unsigned char* vb = lds + SB_VOFF + r32 * SB_VSTR + 8 * hh;
        {
            bf16x8v kf0[4], kf1[4];
#pragma unroll
            for (int d0 = 0; d0 < 4; ++d0) { kf0[d0] = *(const LAS3 bf16x8v*)(kb + 32 * d0); kf1[d0] = *(const LAS3 bf16x8v*)(kb + 32 * SB_KSTR + 32 * d0); }
            asm volatile("" ::: "memory");
#pragma unroll
            for (int d0 = 0; d0 < 4; ++d0) {
                p0 = __builtin_amdgcn_mfma_f32_32x32x16_bf16(kf0[d0], qf[d0], p0, 0, 0, 0);
                p1 = __builtin_amdgcn_mfma_f32_32x32x16_bf16(kf1[d0], qf[d0], p1, 0, 0, 0);
            }
        }
        bf16x4v va[4][2], vc[4][2];
#pragma unroll
        for (int hs = 0; hs < 4; ++hs) { const int kvo = 2 * (32 * (hs >> 1) + 16 * (hs & 1));
            va[hs][0] = *(const LAS3 bf16x4v*)(vb + kvo); va[hs][1] = *(const LAS3 bf16x4v*)(vb + kvo + 16);
            vc[hs][0] = *(const LAS3 bf16x4v*)(vb + 32 * SB_VSTR + kvo); vc[hs][1] = *(const LAS3 bf16x4v*)(vb + 32 * SB_VSTR + kvo + 16); }
        asm volatile("" ::: "memory");
        float bs[8];
#pragma unroll
        for (int g = 0; g < 8; ++g) {
            float run = 1.f;
#pragma unroll
            for (int i = 3; i >= 0; --i) { const float z = (g < 4) ? p0[4 * g + i] : p1[4 * (g - 4) + i];
                const float rn = run * __builtin_amdgcn_rcpf(1.f + __builtin_amdgcn_exp2f(z));
                if (g < 4) p0[4 * g + i] = run - rn; else p1[4 * (g - 4) + i] = run - rn;
                run = rn; }
            bs[g] = run;
        }
        float T = 1.f, off[8];
#pragma unroll
        for (int g = 7; g >= 0; --g) {
            auto rr = __builtin_amdgcn_permlane32_swap(__float_as_uint(bs[g]), __float_as_uint(bs[g]), false, false);
            const float bE = __uint_as_float(rr[0]), bO = __uint_as_float(rr[1]);
            off[g] = R * T * (hh ? 1.f : bO);
            T *= bE * bO;
        }
#pragma unroll
        for (int g = 0; g < 8; ++g)
#pragma unroll
            for (int i = 0; i < 4; ++i) { if (g < 4) p0[4 * g + i] *= off[g]; else p1[4 * (g - 4) + i] *= off[g]; }
        R *= T;
#pragma unroll
        for (int half = 0; half < 2; ++half)
#pragma unroll
            for (int s2 = 0; s2 < 2; ++s2) {
                u32x4v pw;
#pragma unroll
                for (int j = 0; j < 4; ++j) { const float x0 = half ? p1[8 * s2 + 2 * j] : p0[8 * s2 + 2 * j], x1 = half ? p1[8 * s2 + 2 * j + 1] : p0[8 * s2 + 2 * j + 1]; pw[j] = cvtpk_c(x0, x1); }
                const bf16x8v pa = __builtin_bit_cast(bf16x8v, pw);
                const bf16x4v a0 = va[2 * half + s2][0], a1 = va[2 * half + s2][1], c0 = vc[2 * half + s2][0], c1 = vc[2 * half + s2][1];
                const bf16x8v vf0 = (bf16x8v){a0[0], a0[1], a0[2], a0[3], a1[0], a1[1], a1[2], a1[3]};
                const bf16x8v vf1 = (bf16x8v){c0[0], c0[1], c0[2], c0[3], c1[0], c1[1], c1[2], c1[3]};
                o0 = __builtin_amdgcn_mfma_f32_32x32x16_bf16(pa, vf0, o0, 0, 0, 0);
                o1 = __builtin_amdgcn_mfma_f32_32x32x16_bf16(pa, vf1, o1, 0, 0, 0);
            }
        }
    }
    bf16* op = A.y_b + (rowbase + 256 * u + 32 * wave) * 512 + h * 64 + r32;
#pragma unroll
    for (int r = 0; r < 16; ++r) { const int qq = (r & 3) + 8 * (r >> 2) + 4 * hh; op[(size_t)qq * 512] = f2bf(o0[r]); op[(size_t)qq * 512 + 32] = f2bf(o1[r]); }
}

__device__ __forceinline__ void wt_item(const float* __restrict__ src, int ldsrc, const float* __restrict__ scale, bf16* __restrict__ dst, int lddst, int koff, int N, int mode, LAS3 float* scr, int item, int lane) {
    const int nblk = N / 32, kb = item / nblk, nb = item % nblk, k0 = 64 * kb, n0 = 32 * nb;
    int sc0 = n0;
    if (mode == 1) { const int pn = n0 >> 8, j0 = n0 & 255; sc0 = (j0 < 128) ? (128 * pn + j0) : (DFF + 128 * pn + (j0 - 128)); }
    {
        const float* sp = src + (size_t)(k0 + (lane >> 5)) * ldsrc + sc0 + (lane & 31);
#pragma unroll
        for (int i0 = 0; i0 < 32; i0 += 8) { float v[8], sv[8];
#pragma unroll
            for (int i = 0; i < 8; ++i) { v[i] = sp[(size_t)(2 * (i0 + i)) * ldsrc]; sv[i] = scale ? scale[k0 + 2 * (i0 + i) + (lane >> 5)] : 1.f; }
            asm volatile("" ::: "memory");
#pragma unroll
            for (int i = 0; i < 8; ++i) scr[(2 * (i0 + i) + (lane >> 5)) * 33 + (lane & 31)] = v[i] * sv[i]; }
    }
    asm volatile("s_waitcnt lgkmcnt(0)" ::: "memory");
    const int c = lane & 7;
#pragma unroll
    for (int j = 0; j < 4; ++j) { const int n = (lane >> 3) + 8 * j; const LAS3 float* s = scr + (8 * c) * 33 + n;
        pg8::u32x4 o; o.x = pg8::cvt_pk_bf16(s[0 * 33], s[1 * 33]); o.y = pg8::cvt_pk_bf16(s[2 * 33], s[3 * 33]); o.z = pg8::cvt_pk_bf16(s[4 * 33], s[5 * 33]); o.w = pg8::cvt_pk_bf16(s[6 * 33], s[7 * 33]);
        *(pg8::u32x4*)(dst + (size_t)(n0 + n) * lddst + koff + k0 + 8 * c) = o; }
    asm volatile("s_waitcnt lgkmcnt(0)" ::: "memory");
}
__device__ __forceinline__ void wt_job(const float* src, const float* scale, bf16* dst, int ldsrc, int lddst, int koff, int K, int N, int mode, LAS3 float* scr, int gw, int NGW, int lane, int rot) {
    const int ni = (K / 64) * (N / 32);
    int first = gw - (rot % NGW); if (first < 0) first += NGW;
    for (int it = first; it < ni; it += NGW) wt_item(src, ldsrc, scale, dst, lddst, koff, N, mode, scr, it, lane);
}
__device__ __forceinline__ void x_to_xb_rows(const float* __restrict__ x, bf16* __restrict__ xb, float* __restrict__ ssq, int rows, int gw, int NGW, int lane) {
    for (int row0 = gw; row0 < rows; row0 += 2 * NGW) {
        float4 v[2][4];
#pragma unroll
        for (int b = 0; b < 2; ++b) { const int row = (row0 + b * NGW < rows) ? row0 + b * NGW : row0;
#pragma unroll
            for (int q = 0; q < 4; ++q) v[b][q] = *(const float4*)(x + (size_t)row * D + q * 256 + lane * 4); }
        asm volatile("" ::: "memory");
#pragma unroll
        for (int b = 0; b < 2; ++b) { const int row = row0 + b * NGW;
            if (row < rows) {
#pragma unroll
                for (int q = 0; q < 4; ++q) { const float4 w = v[b][q];
                    float s = (w.x * w.x + w.y * w.y) + (w.z * w.z + w.w * w.w);
                    s = sum_lanes16(s);
                    if ((lane & 15) == 0) ssq[(size_t)row * 16 + q * 4 + (lane >> 4)] = s;
                    pg8::u32x2 o; o.x = pg8::cvt_pk_bf16(w.x, w.y); o.y = pg8::cvt_pk_bf16(w.z, w.w);
                    *(pg8::u32x2*)(xb + (size_t)row * D + q * 256 + lane * 4) = o; } } }
    }
}
__device__ __forceinline__ void memk_norm_rows(bf16* __restrict__ kv, const float* __restrict__ kg, int gw, int NGW, int lane) {
    for (int it = gw; it < MEM_ROWS * 4; it += NGW) {
        bf16* p = kv + (size_t)(it >> 2) * 1024 + (it & 3) * 128 + lane * 2;
        const unsigned w = *(const unsigned*)p; const float a = __uint_as_float(w << 16), b = __uint_as_float(w & 0xffff0000u);
        const float ss = wave_sum(a * a + b * b), rs = rsqrtf(ss * (1.f / 128.f) + NORM_EPS);
        *(unsigned*)p = pg8::cvt_pk_bf16(a * rs * kg[lane * 2], b * rs * kg[lane * 2 + 1]);
    }
}
struct ShiftArgs { const bf16* proj_r; const float* mu; const float* k_k; bf16* r_s; bf16* k_s; bf16* v_s; bf16* lora_in; float* nrm; };
__device__ __forceinline__ float tanh_fast(float x) { const float e = __expf(-2.f * fabsf(x)); const float t = (1.f - e) * __builtin_amdgcn_rcpf(1.f + e); return x < 0.f ? -t : t; }
__device__ __forceinline__ void shift_rows(const ShiftArgs& A, int gw_, int NGW_) {
    const int lane = opaque_tid() & 63;
    f32x4v mu[7];
#pragma unroll
    for (int i = 0; i < 7; ++i) mu[i] = *(const f32x4v*)(A.mu + 4 * (lane + 64 * i));
    const f32x4v kk0 = *(const f32x4v*)(A.k_k + 4 * lane), kk1 = *(const f32x4v*)(A.k_k + 256 + 4 * lane);
    for (int row = gw_; row < M; row += NGW_) {
        const bool has_prev = (row % SEQ) != 0;
        const bf16* cur = A.proj_r + (size_t)row * RWKV_COLS + 4 * lane;
        u32x2v c[7], pv[7];
#pragma unroll
        for (int i = 0; i < 7; ++i) { c[i] = *(const u32x2v*)(cur + 256 * i); pv[i] = has_prev ? *(const u32x2v*)(cur + 256 * i - RWKV_COLS) : (u32x2v){0u, 0u}; }
        float ssq_[2]; f32x4v xr[2];
#pragma unroll
        for (int i = 0; i < 7; ++i) {
            f32x4v x;
            { const float c0 = __uint_as_float(c[i][0] << 16), c1 = __uint_as_float(c[i][0] & 0xffff0000u), c2 = __uint_as_float(c[i][1] << 16), c3 = __uint_as_float(c[i][1] & 0xffff0000u);
              const float p0 = __uint_as_float(pv[i][0] << 16), p1 = __uint_as_float(pv[i][0] & 0xffff0000u), p2 = __uint_as_float(pv[i][1] << 16), p3 = __uint_as_float(pv[i][1] & 0xffff0000u);
              x[0] = c0 + (p0 - c0) * mu[i][0]; x[1] = c1 + (p1 - c1) * mu[i][1]; x[2] = c2 + (p2 - c2) * mu[i][2]; x[3] = c3 + (p3 - c3) * mu[i][3]; }
            if (i == 2 || i == 3) { const f32x4v kk = (i == 2) ? kk0 : kk1; float q = 0.f;
#pragma unroll
                for (int e = 0; e < 4; ++e) { const float t = x[e] * kk[e]; q += t * t; }
                q = sum_lanes16(q); ssq_[i - 2] = q; }
            if (i == 6) {
                if (lane < 16) {
#pragma unroll
                    for (int e = 0; e < 4; ++e) x[e] = tanh_fast(x[e]);
                } else if (lane >= 32) {
#pragma unroll
                    for (int e = 0; e < 4; ++e) x[e] = sigmoidf_(x[e]);
                }
            }
            if (i < 2) xr[i] = x;
            else if (i < 4) {
                const f32x4v r_ = xr[i - 2]; u32x4v w4 = {pg8::cvt_pk_bf16(r_[0], x[0]), pg8::cvt_pk_bf16(r_[1], x[1]), pg8::cvt_pk_bf16(r_[2], x[2]), pg8::cvt_pk_bf16(r_[3], x[3])};
                *(u32x4v*)((unsigned*)A.r_s + (size_t)row * 512 + 256 * (i - 2) + 4 * lane) = w4;
            } else {
                u32x2v w; w[0] = pg8::cvt_pk_bf16(x[0], x[1]); w[1] = pg8::cvt_pk_bf16(x[2], x[3]);
                bf16* dst = (i < 6) ? A.v_s + (size_t)row * 512 + 256 * (i - 4) : A.lora_in + (size_t)row * 256;
                *(u32x2v*)(dst + 4 * lane) = w; }
        }
        if ((lane & 15) == 0) { A.nrm[(size_t)row * 8 + (lane >> 4)] = 1.f / fmaxf(sqrtf(ssq_[0]), 1e-12f); A.nrm[(size_t)row * 8 + 4 + (lane >> 4)] = 1.f / fmaxf(sqrtf(ssq_[1]), 1e-12f); }
    }
}
struct PostArgs { const bf16* y_raw; const bf16* v; const bf16* g; const float* bonus; const float* lnx_g; const float* lnx_b; bf16* y_a; };
__device__ __forceinline__ void unpack8(float (&o)[8], const u32x4v& w) {
#pragma unroll
    for (int j = 0; j < 4; ++j) { o[2 * j] = __uint_as_float(w[j] << 16); o[2 * j + 1] = __uint_as_float(w[j] & 0xffff0000u); } }
__device__ __forceinline__ float sum8lanes(float v) { return sum_lanes8(v); }
__device__ __forceinline__ void post_rows(const PostArgs& A, int gw_, int NGW_) {
    const int lane = opaque_tid() & 63, col = 8 * lane;
    float lg[8], lb[8];
#pragma unroll
    for (int e = 0; e < 8; ++e) { lg[e] = A.lnx_g[col + e]; lb[e] = A.lnx_b[col + e]; }
    for (int row = gw_; row < M; row += NGW_) {
        const size_t idx = (size_t)row * 512 + col;
        const u32x4v wy = *(const u32x4v*)(A.y_raw + idx), wv = *(const u32x4v*)(A.v + idx), wg = *(const u32x4v*)(A.g + idx);
        const float bonus = A.bonus[(size_t)row * 8 + (lane >> 3)];
        float y[8], v[8], g[8];
        unpack8(y, wy); unpack8(v, wv); unpack8(g, wg);
        float s = 0.f;
#pragma unroll
        for (int e = 0; e < 8; ++e) s += y[e];
        const float mean = sum8lanes(s) * (1.f / 64.f);
        float q = 0.f;
#pragma unroll
        for (int e = 0; e < 8; ++e) { y[e] -= mean; q += y[e] * y[e]; }
        const float rstd = rsqrtf(sum8lanes(q) * (1.f / 64.f) + LNX_EPS);
        u32x4v w;
#pragma unroll
        for (int j = 0; j < 4; ++j) { const float o0 = (y[2 * j] * rstd * lg[2 * j] + lb[2 * j] + bonus * v[2 * j]) * g[2 * j], o1 = (y[2 * j + 1] * rstd * lg[2 * j + 1] + lb[2 * j + 1] + bonus * v[2 * j + 1]) * g[2 * j + 1];
            w[j] = pg8::cvt_pk_bf16(o0, o1); }
        *(u32x4v*)(A.y_a + idx) = w;
    }
}
struct MemArgs { const bf16* proj_sm; const bf16* kv; const float* qg; bf16* y_m; };

constexpr int MA_KSTR = 272, MA_VSTR = 520;
constexpr int MA_KOFF = 0, MA_VOFF = 256 * MA_KSTR, MA_LDS = MA_VOFF + 128 * MA_VSTR;
__device__ __forceinline__ void mem_unit(LAS3 unsigned char* lds, const MemArgs& A, int b, int h, int u) {
    const int tid = opaque_tid(), lane = tid & 63, wave = __builtin_amdgcn_readfirstlane(tid >> 6), r32 = lane & 31, hh = lane >> 5;
    {
        const bf16* kvb = A.kv + (size_t)(b * MEM_LEN) * 1024 + h * 128;
#pragma unroll
        for (int i = 0; i < 8; ++i) { const int c = tid + 512 * i, row = c >> 4, c16 = c & 15;
            const u32x4v kw = *(const u32x4v*)(kvb + (size_t)row * 1024 + 8 * c16), vw = *(const u32x4v*)(kvb + (size_t)row * 1024 + 512 + 8 * c16);
            *(LAS3 u32x4v*)(lds + MA_KOFF + row * MA_KSTR + 16 * c16) = kw;
#pragma unroll
            for (int j = 0; j < 8; ++j) { const unsigned wv = vw[j >> 1]; const unsigned short e = (j & 1) ? (unsigned short)(wv >> 16) : (unsigned short)(wv & 0xffffu);
                *(LAS3 unsigned short*)(lds + MA_VOFF + (8 * c16 + j) * MA_VSTR + 2 * row) = e; } }
    }
    const size_t qrow = (size_t)b * SEQ + 256 * u + 32 * wave + r32;
    bf16x8v qf[8];
    {
        const bf16* qp = A.proj_sm + qrow * 2048 + 1536 + h * 128 + 8 * hh;
        u32x4v raw[8]; float ss = 0.f;
#pragma unroll
        for (int d0 = 0; d0 < 8; ++d0) { raw[d0] = *(const u32x4v*)(qp + 16 * d0);
#pragma unroll
            for (int j = 0; j < 4; ++j) { const float lo = __uint_as_float(raw[d0][j] << 16), hi = __uint_as_float(raw[d0][j] & 0xffff0000u); ss += lo * lo + hi * hi; } }
        { auto rr = __builtin_amdgcn_permlane32_swap(__float_as_uint(ss), __float_as_uint(ss), false, false); ss = __uint_as_float(rr[0]) + __uint_as_float(rr[1]); }
        const float sc = rsqrtf(ss * (1.f / 128.f) + NORM_EPS) * (0.08838834764831845f * 1.4426950408889634f);
#pragma unroll
        for (int d0 = 0; d0 < 8; ++d0) { const f32x4v g0 = *(const f32x4v*)(A.qg + 16 * d0 + 8 * hh), g1 = *(const f32x4v*)(A.qg + 16 * d0 + 8 * hh + 4);
            u32x4v w;
#pragma unroll
            for (int j = 0; j < 4; ++j) { const float lo = __uint_as_float(raw[d0][j] << 16), hi = __uint_as_float(raw[d0][j] & 0xffff0000u);
                const float gl = (j < 2) ? g0[2 * j] : g1[2 * j - 4], gh = (j < 2) ? g0[2 * j + 1] : g1[2 * j - 3]; w[j] = cvtpk_c(lo * sc * gl, hi * sc * gh); }
            qf[d0] = __builtin_bit_cast(bf16x8v, w); }
    }
    __syncthreads();
    f32x16v p[8];
#pragma unroll
    for (int t = 0; t < 8; ++t) {
#pragma unroll
        for (int i = 0; i < 16; ++i) p[t][i] = 0.f;
        asm volatile("" : "+v"(p[t]));
        const LAS3 unsigned char* kb = lds + MA_KOFF + (32 * t + r32) * MA_KSTR + 16 * hh;
#pragma unroll
        for (int d0 = 0; d0 < 8; ++d0) { const bf16x8v kf = *(const LAS3 bf16x8v*)(kb + 32 * d0); p[t] = __builtin_amdgcn_mfma_f32_32x32x16_bf16(kf, qf[d0], p[t], 0, 0, 0); }
    }
    float mx = -1e30f;
#pragma unroll
    for (int t = 0; t < 8; ++t)
#pragma unroll
        for (int i = 0; i < 16; ++i) mx = fmaxf(mx, p[t][i]);
    { auto rr = __builtin_amdgcn_permlane32_swap(__float_as_uint(mx), __float_as_uint(mx), false, false); mx = fmaxf(__uint_as_float(rr[0]), __uint_as_float(rr[1])); }
    float sm = 0.f;
#pragma unroll
    for (int t = 0; t < 8; ++t)
#pragma unroll
        for (int i = 0; i < 16; ++i) { const float e = __builtin_amdgcn_exp2f(p[t][i] - mx); p[t][i] = e; sm += e; }
    { auto rr = __builtin_amdgcn_permlane32_swap(__float_as_uint(sm), __float_as_uint(sm), false, false); sm = __uint_as_float(rr[0]) + __uint_as_float(rr[1]); }
    const float inv = 1.f / sm;
    f32x16v o[4];
#pragma unroll
    for (int db = 0; db < 4; ++db) {
#pragma unroll
        for (int i = 0; i < 16; ++i) o[db][i] = 0.f;
        asm volatile("" : "+v"(o[db])); }
    const LAS3 unsigned char* vb = lds + MA_VOFF + r32 * MA_VSTR + 8 * hh;
#pragma unroll
    for (int t = 0; t < 8; ++t)
#pragma unroll
        for (int s2 = 0; s2 < 2; ++s2) {
            u32x4v pw;
#pragma unroll
            for (int j = 0; j < 4; ++j) pw[j] = cvtpk_c(p[t][8 * s2 + 2 * j] * inv, p[t][8 * s2 + 2 * j + 1] * inv);
            const bf16x8v pa = __builtin_bit_cast(bf16x8v, pw);
            const int kvo = 2 * (32 * t + 16 * s2);
#pragma unroll
            for (int db = 0; db < 4; ++db) {
                const bf16x4v a0 = *(const LAS3 bf16x4v*)(vb + 32 * db * MA_VSTR + kvo), a1 = *(const LAS3 bf16x4v*)(vb + 32 * db * MA_VSTR + kvo + 16);
                const bf16x8v vf = (bf16x8v){a0[0], a0[1], a0[2], a0[3], a1[0], a1[1], a1[2], a1[3]};
                o[db] = __builtin_amdgcn_mfma_f32_32x32x16_bf16(pa, vf, o[db], 0, 0, 0);
            }
        }
    bf16* op = A.y_m + ((size_t)b * SEQ + 256 * u + 32 * wave) * 512 + h * 128 + r32;
#pragma unroll
    for (int r = 0; r < 16; ++r) { const int qq = (r & 3) + 8 * (r >> 2) + 4 * hh;
#pragma unroll
        for (int db = 0; db < 4; ++db) op[(size_t)qq * 512 + 32 * db] = f2bf(o[db][r]); }
}

__device__ __forceinline__ void ffn_fixup_chunks(const float* __restrict__ side, const float* __restrict__ cw, const float* __restrict__ cb, bf16* __restrict__ u, int vb, int G) {
    const int tidf = opaque_tid();
    for (int cid = vb; cid < M / 64; cid += G) {
        const bool first = ((cid * 64) % SEQ) == 0;
        for (int idx = tidf; idx < 2 * DFF; idx += 512) {
            const int rr = idx / DFF, ch = idx % DFF;
            float Gv = cb[ch], V = cb[DFF + ch];
#pragma unroll
            for (int i = 0; i < 3; ++i) {
                const int dt = 2 - i, q = rr - dt;
                float hg = 0.f, hv = 0.f;
                if (q >= 0) { const float* sp = side + (((size_t)cid * 4 + q) * 2) * DFF + ch; hg = sp[0]; hv = sp[DFF]; }
                else if (!first) { const float* sp = side + (((size_t)(cid - 1) * 4 + (4 + q)) * 2) * DFF + ch; hg = sp[0]; hv = sp[DFF]; }
                Gv += cw[i * DFF2 + ch] * hg; V += cw[i * DFF2 + DFF + ch] * hv;
            }
            u[(size_t)(cid * 64 + rr) * DFF + ch] = f2bf(Gv * sigmoidf_(Gv) * V);
        }
    }
}


#define XB_TMO      128
#define XB_XCNT(j)  (256  + 64 * (j))
#define XB_XSUB(j)  (1280 + 64 * (j))
#define XB_XGEN(j)  (2304 + 64 * (j))
#define XB_TOP      3328
#define XB_TOPGEN   3392
#define XCD_BAR_WORDS 3456
#define XB_SPIN_CAP (1u << 22)
__device__ __forceinline__ unsigned xb_ld(unsigned* p)              { return __hip_atomic_load(p, __ATOMIC_RELAXED, __HIP_MEMORY_SCOPE_AGENT); }
__device__ __forceinline__ unsigned xb_add(unsigned* p, unsigned v) { return __hip_atomic_fetch_add(p, v, __ATOMIC_RELAXED, __HIP_MEMORY_SCOPE_AGENT); }
__device__ __forceinline__ unsigned xb_xcc_id() { return (unsigned)__builtin_amdgcn_s_getreg((3 << 11) | 20) & 0xFu; }
#define XB_SPIN(cond, bar) do { unsigned _sp = 0; while (cond) { __builtin_amdgcn_s_sleep(1); \
    if ((++_sp & 255u) == 0u) { if (xb_ld(&(bar)[XB_TMO])) break; if (_sp > XB_SPIN_CAP) { atomicAdd(&(bar)[XB_TMO], 1u); break; } } } } while (0)
struct XcdBarrier { unsigned* bar; unsigned x; volatile LAS3 unsigned* st; };
__device__ __forceinline__ XcdBarrier xcd_barrier_post(unsigned* bar, volatile LAS3 unsigned* st) {
    XcdBarrier b; b.bar = bar; b.x = xb_xcc_id(); b.st = st;
    if (threadIdx.x == 0) (void)xb_add(&bar[XB_XCNT(b.x)], 1u);
    return b;
}
__device__ __forceinline__ void xcd_barrier_complete(unsigned* bar, unsigned x, unsigned& nloc, unsigned& nx) {
    const unsigned G = gridDim.x * gridDim.y * gridDim.z;
    unsigned sum, cnt, mine, sp = 0u;
    for (;;) {
        sum = 0u; cnt = 0u; mine = 0u;
#pragma unroll
        for (unsigned j = 0; j < 16; ++j) { const unsigned c = xb_ld(&bar[XB_XCNT(j)]); sum += c; cnt += (c > 0u) ? 1u : 0u; mine = (j == x) ? c : mine; }
        if (sum == G) break;
        __builtin_amdgcn_s_sleep(1);
        if ((++sp & 255u) == 0u) { if (xb_ld(&bar[XB_TMO])) break; if (sp > XB_SPIN_CAP) { atomicAdd(&bar[XB_TMO], 1u); break; } }
    }
    nloc = mine > 0u ? mine : 1u; nx = cnt > 0u ? cnt : 1u;
}
__device__ __forceinline__ void xcd_barrier(const XcdBarrier& b) {
    asm volatile("s_waitcnt vmcnt(0)" ::: "memory");
    __syncthreads();
    if (threadIdx.x == 0) {
        unsigned* bar = b.bar;
        __builtin_amdgcn_s_waitcnt(0);
        unsigned nloc = b.st[0], nx = b.st[1];
        if (nloc == 0u) { xcd_barrier_complete(bar, b.x, nloc, nx); b.st[0] = nloc; b.st[1] = nx; }
        const unsigned old = xb_add(&bar[XB_XSUB(b.x)], 1u);
        const unsigned gen = old / nloc;
        if (old + 1u == (gen + 1u) * nloc) {
            __builtin_amdgcn_fence(__ATOMIC_RELEASE, "agent");
            asm volatile("s_waitcnt vmcnt(0)" ::: "memory");
            const unsigned og = xb_add(&bar[XB_TOP], 1u);
            const unsigned target = (og / nx + 1u) * nx;
            if (og + 1u != target) XB_SPIN(xb_ld(&bar[XB_TOP]) < target, bar);
            __builtin_amdgcn_fence(__ATOMIC_ACQUIRE, "agent");
            asm volatile("s_waitcnt vmcnt(0)" ::: "memory");
            xb_add(&bar[XB_XGEN(b.x)], 1u);
            asm volatile("s_waitcnt vmcnt(0)" ::: "memory");
        } else {
            XB_SPIN(xb_ld(&bar[XB_XGEN(b.x)]) == gen, bar);
            asm volatile("buffer_inv sc0\n\ts_waitcnt vmcnt(0)" ::: "memory");
        }
    }
    __syncthreads();
}

constexpr int MEGA_LDS = 147456;
struct Params { const float* in[31]; float* out; unsigned char* wsp; int ph_lo, ph_hi; };
enum { PH_P0 = 0, PH_GEMMA, PH_SHIFT, PH_LORA, PH_VRES2, PH_SCAN, PH_SCAN2, PH_POST, PH_GEMMB, PH_ATTN, PH_GEMMC, PH_BRANCH, PH_WOUT, PH_UP, PH_FIX, PH_DOWN, PH_NCODES };
struct PhaseDesc { int code, layer; };
__device__ __constant__ const int kPhaseCode[30] = { PH_P0,
    PH_GEMMA, PH_SHIFT, PH_LORA, PH_SCAN, PH_SCAN2, PH_POST, PH_GEMMB, PH_ATTN, PH_GEMMC, PH_BRANCH, PH_WOUT, PH_UP, PH_FIX, PH_DOWN,
    PH_GEMMA, PH_SHIFT, PH_LORA, PH_VRES2, PH_SCAN, PH_SCAN2, PH_POST, PH_GEMMB, PH_ATTN, PH_GEMMC, PH_BRANCH, PH_WOUT, PH_UP, PH_FIX, PH_DOWN };
constexpr int N_PHASES = 30, L1_FIRST = 15;

#define WTJ(src, scale, dst, ldsrc, lddst, koff, K, N, mode) do { wt_job(src, scale, dst, ldsrc, lddst, koff, K, N, mode, (LAS3 float*)(lds + wave * 16384), vb * 8 + wave, G * 8, lane, rot_); rot_ += ((K) / 64) * ((N) / 32); } while (0)
#define WTJI(src, scale, dst, ldsrc, lddst, koff, K, N, mode) do { wt_job(src, scale, dst, ldsrc, lddst, koff, K, N, mode, (LAS3 float*)(lds + wave * 16384), (vb - 64) * 8 + wave, 192 * 8, lane, rot_); rot_ += ((K) / 64) * ((N) / 32); } while (0)
#define WTJX(b0, nb, src, scale, dst, ldsrc, lddst, koff, K, N, mode) do { wt_job(src, scale, dst, ldsrc, lddst, koff, K, N, mode, (LAS3 float*)(lds + wave * 16384), (vb - (b0)) * 8 + wave, (nb) * 8, lane, rot_); rot_ += ((K) / 64) * ((N) / 32); } while (0)
#define P_PROJ_R ((bf16*)(ws + RS(0)))
#define P_R_S ((bf16*)(ws + RS(4)))
#define P_BONUS ((float*)(ws + RS(3) + MiB))
#define P_K_S ((bf16*)(ws + RS(5)))
#define P_V_S ((l == 0) ? (bf16*)(ws + WS_VFIRST) : (bf16*)(ws + RS(6)))
#define P_LORA_IN ((bf16*)(ws + RS(7)))
#define P_LD ((unsigned short*)(ws + RS(0)))
#define P_A ((bf16*)(ws + RS(1)))
#define P_G ((bf16*)(ws + RS(2)))
#define P_T1 ((bf16*)(ws + RS(3)))
#define P_VP ((bf16*)(ws + RS(8)))
#define P_VUSE ((l == 0) ? (bf16*)(ws + WS_VFIRST) : (bf16*)(ws + RS(8)))
#define P_Y_RAW ((bf16*)(ws + RS(9)))
#define P_Y_A ((bf16*)(ws + RS(0)))
#define P_Y_B ((bf16*)(ws + RS(1)))
#define P_Y_M ((bf16*)(ws + RS(2)))
#define P_PROJ_SM ((bf16*)(ws + RS(3)))
#define P_GATES ((bf16*)(ws + RS(3)))
#define P_MERGED ((bf16*)xout)
#define P_XB2 ((bf16*)(ws + RS(0)))
#define P_U ((bf16*)(ws + RS(2)))
#define P_SIDE ((float*)(ws + RS(2) + 88 * MiB))
#define P_XIN ((l == 0) ? in[0] : (const float*)xout)
#define WinT ((bf16*)(ws + WS_WINT))
#define WupT ((bf16*)(ws + WS_WUPT))
#define WdnT ((bf16*)(ws + WS_WDNT))
#define WbrT ((bf16*)(ws + WS_WBRT))
#define WoutT ((bf16*)(ws + WS_WOUTT))
#define Wlora ((bf16*)(ws + WS_WLORA))
#define V1T ((bf16*)(ws + WS_V1T))
#define V2T ((bf16*)(ws + WS_V2T))
#define xbA ((bf16*)(ws + WS_XBA))
#define kvmem ((bf16*)(ws + WS_KVMEM))
#define ssq ((float*)(ws + WS_SSQ))
#define nrm ((float*)(ws + WS_NRM))
#define ssqm ((float*)(ws + WS_SSQM))
#define memb ((bf16*)(ws + RS(8)))
#define WkvT ((bf16*)(ws + RS(9)))
#define xout (P.out)
#define in (P.in + z0)
#define ws (P.wsp + z0)
#define gw (vb * 8 + wave)
#define lane (opaque_tid() & 63)
#define NGW (G * 8)
__global__ void __launch_bounds__(512, 2) mega(Params P) {
    extern __shared__ __attribute__((aligned(16))) unsigned char lds_dyn[];
    cooperative_groups::grid_group grid = cooperative_groups::this_grid();
    LAS3 unsigned char* lds = (LAS3 unsigned char*)lds_dyn;
    volatile LAS3 unsigned* bst = (volatile LAS3 unsigned*)(lds + MEGA_LDS - 16);
    if (threadIdx.x < 4) bst[threadIdx.x] = 0u;
    __syncthreads();
    (void)xcd_barrier_post((unsigned*)(P.wsp + WS_CTL), bst);
    for (int ph = P.ph_lo; ph < P.ph_hi; ++ph) {
        const int wave = __builtin_amdgcn_readfirstlane(opaque_tid() >> 6);
        int vb = blockIdx.x; asm volatile("" : "+s"(vb));
        int z0 = 0; asm volatile("" : "+s"(z0));
        constexpr int G = 256;
        const int code = kPhaseCode[ph], l = (ph >= L1_FIRST) ? 1 : 0;
#ifdef ONLY_PHASE
        if (code != ONLY_PHASE) continue;
#endif
        switch (code) {
#if !defined(ONLY_PHASE) || ONLY_PHASE == 0
        case PH_P0: {
            int rot_ = 0;
            WTJ(in[3], in[2], WinT, IN_COLS, D, 0, D, RWKV_COLS, 0);
            WTJ(in[6], nullptr, Wlora, 512, 256, 0, 64, 512, 0); WTJ(in[8], nullptr, Wlora + 512 * 256, 512, 256, 64, 64, 512, 0); WTJ(in[9], nullptr, Wlora + 1024 * 256, 512, 256, 128, 128, 512, 0);
            WTJ(in[21], in[20], WkvT, 1024, D, 0, D, 1024, 0); WTJ(in[21] + (size_t)D * 1024, in[20] + D, WkvT + (size_t)1024 * D, 1024, D, 0, D, 1024, 0);
            x_to_xb_rows(in[1], memb, ssqm, MEM_ROWS, gw, NGW, lane);
            x_to_xb_rows(in[0], xbA, ssq, M, gw, NGW, lane);
        } break;
#endif
#if !defined(ONLY_PHASE) || ONLY_PHASE == 1
        case PH_GEMMA: {
            pg8::gemm_phase<pg8::EpiRowScale, true, M, RWKV_COLS, D, D, D / 64>(lds, pg8::Gemm{xbA, xbA, xbA, WinT}, G, vb, pg8::EpiRowScale{P_PROJ_R, ssq, RWKV_COLS, 0});
            if (l == 1 && vb >= 192) {
                __syncthreads();
                int rot_ = 0;
                WTJX(192, 64, in[25] + (size_t)D * D, nullptr, WoutT, D, D, 0, D, D, 0);
            }
            if (l == 0) {
#pragma unroll 1
                for (int ll = 0; ll < 2; ++ll) { const int cc = (vb >= 192 + 32 * ll && vb < 224 + 32 * ll) ? vb - 192 - 32 * ll : -1;
                    pg8::gemm_phase<pg8::EpiRowScale, true, MEM_ROWS, 1024, D, D, D / 64>(lds, pg8::Gemm{memb, memb, memb, WkvT + (size_t)ll * 1024 * D}, 32, cc,
                                                           pg8::EpiRowScale{kvmem + (size_t)ll * MEM_ROWS * 1024, ssqm, 1024, 0}); }
            }
        } break;
#endif
#if !defined(ONLY_PHASE) || ONLY_PHASE == 2
        case PH_SHIFT: {
            shift_rows(ShiftArgs{P_PROJ_R, in[4] + l * RWKV_COLS, in[10] + l * 512, P_R_S, P_K_S, P_V_S, P_LORA_IN, nrm}, gw, NGW);
            if (l == 0) { memk_norm_rows(kvmem, in[23], gw, NGW, lane); memk_norm_rows(kvmem + (size_t)MEM_ROWS * 1024, in[23] + 128, gw, NGW, lane); }
        } break;
#endif
#if !defined(ONLY_PHASE) || ONLY_PHASE == 3
        case PH_LORA: {
            pg8::gemm_phase<pg8::EpiLora, true, M, 1536, 256, 256, 4>(lds, pg8::Gemm{P_LORA_IN, P_LORA_IN, P_LORA_IN, Wlora}, G, vb, pg8::EpiLora{P_LD, in[5] + l * 512, in[7] + l * 512});
            if (l == 0 && vb >= 128) {
                __syncthreads();
                int rot_ = 0;
                WTJX(128, 128, in[24], nullptr, WbrT, D, 1536, 0, 512, D, 0); WTJX(128, 128, in[24] + (size_t)512 * D, nullptr, WbrT, D, 1536, 512, 512, D, 0); WTJX(128, 128, in[24] + (size_t)2 * 512 * D, nullptr, WbrT, D, 1536, 1024, 512, D, 0);
            }
            if (l == 1) {
                pg8::gemm_phase<pg8::EpiRowScale, true, M, 256, 512, 512, 8>(lds, pg8::Gemm{P_V_S, P_V_S, P_V_S, V1T}, G, (vb + 128) % G, pg8::EpiRowScale{P_T1, nullptr, 256, 0}); }
        } break;
#endif
#if !defined(ONLY_PHASE) || ONLY_PHASE == 4
        case PH_VRES2: {
            pg8::gemm_phase<pg8::EpiVres, true, M, 512, 256, 256, 4>(lds, pg8::Gemm{P_T1, P_T1, P_T1, V2T}, G, vb, pg8::EpiVres{P_V_S, ((bf16*)(ws + WS_VFIRST)), in[15], P_VP});
        } break;
#endif
#if !defined(ONLY_PHASE) || ONLY_PHASE == 5
        case PH_SCAN: {
            cscan_produce(lds + wave * PS_BYTES, ScanArgs{P_R_S, P_K_S, P_VUSE, P_A, P_LD, nrm, in[10] + l * 512, in[11] + l * 512, P_Y_RAW, in[12] + l * 512, P_BONUS}, CsRec{(unsigned char*)xout, ws + RS(6), ws + RS(3)}, gw, NGW);
        } break;
#endif
#if !defined(ONLY_PHASE) || ONLY_PHASE == 15
        case PH_SCAN2: {
            if (vb < 64) cscan_consume(lds, ScanArgs{P_R_S, P_K_S, P_VUSE, P_A, P_LD, nrm, in[10] + l * 512, in[11] + l * 512, P_Y_RAW, in[12] + l * 512, P_BONUS}, CsRec{(unsigned char*)xout, ws + RS(6), ws + RS(3)}, vb);
            else {
                int rot_ = 0;
                WTJI(in[27] + (size_t)l * D * DFF2, in[26] + l * D, WupT, DFF2, D, 0, D, DFF2, 1);
                if (l == 0) WTJI(in[25], nullptr, WoutT, D, D, 0, D, D, 0);
                if (l == 0) {
                    WTJI(in[3] + RWKV_COLS, in[2], WinT + (size_t)RWKV_COLS * D, IN_COLS, D, 0, D, IN_COLS - RWKV_COLS, 0);
                    WTJI(in[3] + (size_t)D * IN_COLS, in[2] + D, WinT, IN_COLS, D, 0, D, RWKV_COLS, 0);
                    WTJI(in[6] + 64 * 512, nullptr, Wlora, 512, 256, 0, 64, 512, 0); WTJI(in[8] + 64 * 512, nullptr, Wlora + 512 * 256, 512, 256, 64, 64, 512, 0); WTJI(in[9] + 128 * 512, nullptr, Wlora + 1024 * 256, 512, 256, 128, 128, 512, 0);
                    WTJI(in[16], nullptr, V1T, 32, 512, 0, 512, 32, 0);
                    for (int idx = ((vb - 64) * 8 + wave) * 64 + lane; idx < 512 * 32; idx += 192 * 8 * 64) { const int n = idx >> 5, k = idx & 31; V2T[(size_t)n * 256 + k] = f2bf(in[17][(size_t)k * 512 + n]); }
                } else {
                    WTJI(in[3] + (size_t)D * IN_COLS + RWKV_COLS, in[2] + D, WinT + (size_t)RWKV_COLS * D, IN_COLS, D, 0, D, IN_COLS - RWKV_COLS, 0);
                }
            }
        } break;
#endif
#if !defined(ONLY_PHASE) || ONLY_PHASE == 6
        case PH_POST: {
            post_rows(PostArgs{P_Y_RAW, P_VUSE, P_G, P_BONUS, in[13] + l * 512, in[14] + l * 512, P_Y_A}, gw, NGW);
        } break;
#endif
#if !defined(ONLY_PHASE) || ONLY_PHASE == 7
        case PH_GEMMB: {
            pg8::gemm_phase<pg8::EpiRowScale, true, M, 2048, D, D, D / 64>(lds, pg8::Gemm{xbA, xbA, xbA, WinT + (size_t)RWKV_COLS * D}, G, vb, pg8::EpiRowScale{P_PROJ_SM, ssq, 2048, 0});
        } break;
#endif
#if !defined(ONLY_PHASE) || ONLY_PHASE == 8
        case PH_ATTN: {
            const SbArgs sa{P_PROJ_SM, in[18] + l * 64, in[19] + l * 64, P_Y_B};
            const int bh = vb >> 2, pr = vb & 3;
            sb_unit(lds, sa, bh, 7 - pr);
            __syncthreads();
            sb_unit(lds, sa, bh, pr);
            __syncthreads();
            { const int pair = vb >> 3; mem_unit(lds, MemArgs{P_PROJ_SM, kvmem + (size_t)l * MEM_ROWS * 1024, in[22] + l * 128, P_Y_M}, pair >> 2, pair & 3, vb & 7); }
        } break;
#endif
#if !defined(ONLY_PHASE) || ONLY_PHASE == 9
        case PH_GEMMC: {
            pg8::gemm_phase<pg8::EpiGatesFrag, true, M, 3072, D, D, D / 64>(lds, pg8::Gemm{xbA, xbA, xbA, WinT + (size_t)3840 * D}, G, vb, pg8::EpiGatesFrag{P_GATES, ssq});
        } break;
#endif
#if !defined(ONLY_PHASE) || ONLY_PHASE == 10
        case PH_BRANCH: {
            pg8::gemm_phase<pg8::EpiGated, true, M, D, 1536, 512, 8>(lds, pg8::Gemm{P_Y_A, P_Y_B, P_Y_M, WbrT}, G, vb, pg8::EpiGated{P_GATES, P_MERGED});
        } break;
#endif
#if !defined(ONLY_PHASE) || ONLY_PHASE == 11
        case PH_WOUT: {
            pg8::gemm_phase<pg8::EpiResidual<true, false>, true, M, D, D, D, D / 64>(lds, pg8::Gemm{P_MERGED, P_MERGED, P_MERGED, WoutT}, G, vb, pg8::EpiResidual<true, false>{nullptr, xbA, nullptr, P_XB2, ssq});
        } break;
#endif
#if !defined(ONLY_PHASE) || ONLY_PHASE == 12
        case PH_UP: {
            pg8::gemm_phase<pg8::EpiConv, true, M, DFF2, D, D, D / 64>(lds, pg8::Gemm{P_XB2, P_XB2, P_XB2, WupT}, G, vb, pg8::EpiConv{ssq, in[28] + (size_t)l * 3 * DFF2, in[29] + (size_t)l * DFF2, P_U, P_SIDE});
            if (vb >= 128) {
                __syncthreads();
                int rot_ = 0;
                WTJX(128, 128, in[30] + (size_t)l * DFF * D, nullptr, WdnT, D, DFF, 0, DFF, D, 0);
                if (l == 0) {
                    WTJX(128, 128, in[24] + (size_t)3 * 512 * D, nullptr, WbrT, D, 1536, 0, 512, D, 0); WTJX(128, 128, in[24] + (size_t)4 * 512 * D, nullptr, WbrT, D, 1536, 512, 512, D, 0); WTJX(128, 128, in[24] + (size_t)5 * 512 * D, nullptr, WbrT, D, 1536, 1024, 512, D, 0); }
            }
        } break;
#endif
#if !defined(ONLY_PHASE) || ONLY_PHASE == 13
        case PH_FIX: {
            ffn_fixup_chunks(P_SIDE, in[28] + (size_t)l * 3 * DFF2, in[29] + (size_t)l * DFF2, P_U, vb, G);
        } break;
#endif
#if !defined(ONLY_PHASE) || ONLY_PHASE == 14
        case PH_DOWN: {
            if (l == 0) pg8::gemm_phase<pg8::EpiResidual<true, false>, true, M, D, DFF, DFF, DFF / 64>(lds, pg8::Gemm{P_U, P_U, P_U, WdnT}, G, vb, pg8::EpiResidual<true, false>{nullptr, P_XB2, nullptr, xbA, ssq});
            else        pg8::gemm_phase<pg8::EpiResidual<true, true>, true, M, D, DFF, DFF, DFF / 64>(lds, pg8::Gemm{P_U, P_U, P_U, WdnT}, G, vb, pg8::EpiResidual<true, true>{nullptr, P_XB2, xout, xbA, ssq});
        } break;
#endif
        default: break;
        }
        if (ph + 1 < P.ph_hi) { if (P.ph_hi > N_PHASES) grid.sync(); else { XcdBarrier xb_; xb_.bar = (unsigned*)(ws + WS_CTL); xb_.x = xb_xcc_id(); xb_.st = (volatile LAS3 unsigned*)(lds + MEGA_LDS - 16); xcd_barrier(xb_); } }
    }
}

#undef lane
#undef WinT
#undef WupT
#undef WdnT
#undef WbrT
#undef WoutT
#undef Wlora
#undef V1T
#undef V2T
#undef xbA
#undef kvmem
#undef ssq
#undef nrm
#undef ssqm
#undef memb
#undef WkvT
#undef xout
#undef in
#undef ws
#undef gw
#undef NGW
#ifndef MK_SPLIT
#define MK_SPLIT 0
#endif
extern "C" void kernel_launch(void* const* d_in, const int* in_sizes, int n_in, void* d_out, int out_size, void* d_ws, size_t ws_size, hipStream_t stream) {
    static int grid_blocks = 0;
    if (!grid_blocks) {
        if (n_in != 31 || ws_size < 256 * MiB) { fprintf(stderr, "kernel_launch: unexpected n_in %d / ws %zu\n", n_in, ws_size); grid_blocks = -1; return; }
        int dev = 0, cus = 0, per_cu = 0;
        (void)hipGetDevice(&dev); (void)hipDeviceGetAttribute(&cus, hipDeviceAttributeMultiprocessorCount, dev);
        (void)hipFuncSetAttribute((const void*)mega, hipFuncAttributeMaxDynamicSharedMemorySize, MEGA_LDS);
        (void)hipOccupancyMaxActiveBlocksPerMultiprocessor(&per_cu, (const void*)mega, 512, MEGA_LDS);
        grid_blocks = (per_cu >= 1 && cus >= 256) ? 256 : -1;
        if (grid_blocks != 256) fprintf(stderr, "kernel_launch: %d CUs, %d blocks/CU: this kernel needs a 256-CU device; nothing launched\n", cus, per_cu);
    }
    if (grid_blocks < 0) return;
    unsigned char* ws = (unsigned char*)d_ws;
    (void)hipMemsetAsync(ws + WS_WLORA, 0, 3 * MiB / 4 + MiB / 2 + 65536, stream);
    Params p{};
    for (int i = 0; i < 31; ++i) p.in[i] = (const float*)d_in[i];
    p.out = (float*)d_out; p.wsp = ws;
#if MK_SPLIT
    for (int ph = 0; ph < N_PHASES; ++ph) { p.ph_lo = ph; p.ph_hi = ph + 1; void* args[] = {(void*)&p};
        hipError_t e = hipLaunchCooperativeKernel((const void*)mega, dim3(grid_blocks), dim3(512), args, MEGA_LDS, stream);
        if (e != hipSuccess) { fprintf(stderr, "cooperative launch failed: %s\n", hipGetErrorString(e)); return; } }
#else
    p.ph_lo = 0; p.ph_hi = N_PHASES; void* args[] = {(void*)&p};
    hipError_t e = hipLaunchCooperativeKernel((const void*)mega, dim3(grid_blocks), dim3(512), args, MEGA_LDS, stream);
    if (e != hipSuccess) fprintf(stderr, "cooperative launch failed: %s (grid %d)\n", hipGetErrorString(e), grid_blocks);
#endif
}
```

```cpp
#include <hip/hip_runtime.h>
#include <hip/hip_cooperative_groups.h>
#include <cstdint>
#include <cstdio>

typedef unsigned short bf16;
typedef _Float16 f16;

constexpr int BATCH = 8, SEQ = 2048, D = 1024, M = BATCH * SEQ;
constexpr int RW = 512, NH = 8, HD = 64;
constexpr int RWKV_COLS = 1792, IN_COLS = 6912;
constexpr int MEM_LEN = 256, MEM_ROWS = BATCH * MEM_LEN;
constexpr int DFF = 2816, DFF2 = 5632;
constexpr float NORM_EPS = 1e-6f, LNX_EPS = 64e-5f;

constexpr size_t MiB = 1u << 20;
constexpr size_t WS_CTL = 37 * MiB + MiB / 4;
constexpr size_t WS_WINT = 1 * MiB;
constexpr size_t WS_WUPT = WS_WINT + 13 * MiB + MiB / 2;
constexpr size_t WS_WDNT = WS_WUPT + 11 * MiB;
constexpr size_t WS_WBRT = WS_WDNT + 5 * MiB + MiB / 2;
constexpr size_t WS_WOUTT = WS_WBRT + 3 * MiB;
constexpr size_t WS_WLORA = WS_WOUTT + 2 * MiB;
constexpr size_t WS_V1T = WS_WLORA + 3 * MiB / 4;
constexpr size_t WS_V2T = WS_V1T + MiB / 4;
constexpr size_t WS_VFIRST = 38 * MiB;
constexpr size_t WS_XBA = 54 * MiB;
constexpr size_t WS_KVMEM = 86 * MiB;
constexpr size_t WS_SSQ = 94 * MiB;
constexpr size_t WS_NRM = 95 * MiB;
constexpr size_t WS_SSQM = WS_NRM + MiB / 2;
constexpr size_t WS_R = 96 * MiB;
constexpr size_t SLOT = 16 * MiB;
#define RS(i) (WS_R + (size_t)(i) * SLOT)
static_assert(WS_V2T + MiB / 4 == WS_CTL && WS_CTL + 65536 <= WS_VFIRST, "weights region");
static_assert(RS(10) <= 256 * MiB, "ws");

__device__ __forceinline__ int opaque_tid() { int t = threadIdx.x; asm volatile("" : "+v"(t)); return t; }
__device__ __forceinline__ float bf2f(bf16 v) { return __uint_as_float((unsigned)v << 16); }
__device__ __forceinline__ bf16 f2bf(float f) { unsigned u = __float_as_uint(f); return (bf16)((u + 0x7fffu + ((u >> 16) & 1u)) >> 16); }
__device__ __forceinline__ float sigmoidf_(float x) { return 1.f / (1.f + __expf(-x)); }
__device__ __forceinline__ float softplusf_(float x) { return fmaxf(x, 0.f) + log1pf(__expf(-fabsf(x))); }
__device__ __forceinline__ float shfl_xor_t(float v, int m) { return __builtin_bit_cast(float, __builtin_amdgcn_ds_bpermute((int)(((threadIdx.x & 63u) ^ (unsigned)m) << 2), __builtin_bit_cast(int, v))); }
__device__ __forceinline__ float wave_sum(float v) {
#pragma unroll
    for (int o = 1; o < 64; o <<= 1) v += shfl_xor_t(v, o);
    return v;
}
__device__ __forceinline__ float wave_max(float v) {
#pragma unroll
    for (int o = 1; o < 64; o <<= 1) v = fmaxf(v, shfl_xor_t(v, o));
    return v;
}
__device__ __forceinline__ float rstd_of(const float* ssq, int r) {
    const float4* p = (const float4*)(ssq + 16 * (size_t)r);
    const float4 a = p[0], b = p[1], c = p[2], d = p[3];
    const float s = (((a.x + a.y) + (a.z + a.w)) + ((b.x + b.y) + (b.z + b.w))) + (((c.x + c.y) + (c.z + c.w)) + ((d.x + d.y) + (d.z + d.w)));
    return rsqrtf(s * (1.f / 1024.f) + NORM_EPS);
}

namespace pg8 {
#define PG8_LAS __attribute__((address_space(3)))
typedef unsigned short bf16_t;
typedef short bf16x8 __attribute__((ext_vector_type(8)));
typedef float f32x4 __attribute__((ext_vector_type(4)));
typedef unsigned u32x4 __attribute__((ext_vector_type(4)));
typedef unsigned u32x2 __attribute__((ext_vector_type(2)));
constexpr int BM = 256, BK = 64, HALF = 128, HTB = HALF * BK * 2, STAGE_BYTES = 8 * HTB, NXCD = 8, WGM = 8;

__host__ __device__ __forceinline__ int lds_byte(int r, int c) { const int st = (r >> 4) * 2 + (c >> 5), rr = r & 15, cc = c & 31, ob = rr * 64 + cc * 2; return st * 1024 + (ob ^ (((ob >> 9) & 1) << 5)); }
__host__ __device__ __forceinline__ void stage_rc(int b, int& R, int& C) { const int st = b / 1024, sb = b % 1024, swz = sb ^ (((sb >> 9) & 1) << 5); R = (st >> 1) * 16 + swz / 64; C = (st & 1) * 32 + (swz % 64) / 2; }
__host__ __device__ __forceinline__ int perm32(int rho) { const int n = rho >> 4, i = rho & 15; return 8 * (i >> 2) + 4 * n + (i & 3); }

struct Unit { int pm, pn; };
struct Gemm { const bf16_t* A; const bf16_t* A1; const bf16_t* A2; const bf16_t* Bt; };

template <int NM, int NN> struct StaticOrderT {
    int G, c;
    __device__ __forceinline__ bool next(int i, Unit& u) const {
        constexpr int nwg = NM * NN;
        const int L = i * G + c; if (c < 0 || L >= nwg) return false;
        int wgid = L; { constexpr int q = nwg / NXCD, r = nwg % NXCD; const int xcd = wgid % NXCD, off = wgid / NXCD; wgid = (xcd < r ? xcd * (q + 1) : r * (q + 1) + (xcd - r) * q) + off; }
        constexpr int nig = WGM * NN; const int gid = wgid / nig, fm = gid * WGM, gsz = (NM - fm) < WGM ? (NM - fm) : WGM;
        u.pm = fm + ((wgid % nig) % gsz); u.pn = (wgid % nig) / gsz; return true;
    }
};

typedef float f32x2k __attribute__((ext_vector_type(2))); typedef __bf16 bf16x2k __attribute__((ext_vector_type(2)));
__device__ __forceinline__ unsigned cvt_pk_bf16(float lo, float hi) { f32x2k v = {lo, hi}; bf16x2k b = __builtin_convertvector(v, bf16x2k); return __builtin_bit_cast(unsigned, b); }

template <class Epi, bool ALIGN_EPI, int M_, int N_, int K_, int LDA_, int SEGT_>
__device__ __forceinline__ void gemm_phase(PG8_LAS unsigned char* lds, const Gemm g, int G_, int c_, const Epi& E) {
    const StaticOrderT<M_ / BM, N_ / BM> S{G_, c_};
    const int tid = opaque_tid(), wid = __builtin_amdgcn_readfirstlane(tid >> 6), lane = tid & 63, wr = wid >> 2, wc = wid & 3, fr = lane & 15, fq = lane >> 4;
    constexpr int K = K_, nt = K / BK, lda = LDA_, segt = SEGT_;
    unsigned voffA[2], voffB[2];
#pragma unroll
    for (int i = 0; i < 2; ++i) { int R, C; stage_rc(tid * 16 + i * 8192, R, C); const int Rb = Epi::PERM ? ((R & ~31) + perm32(R & 31)) : R;
        voffA[i] = (unsigned)(R * lda + C) * 2u; voffB[i] = (unsigned)(Rb * K + C) * 2u; }
    constexpr size_t kstep = (size_t)(BK * 2);
    constexpr size_t hstepA = (size_t)HALF * lda * 2, hstepB = (size_t)HALF * K * 2;
    constexpr size_t tstepA = 2 * hstepA, tstepB = 2 * hstepB;
    const unsigned ldsw = (unsigned)wid * 1024u;
    const int aoff = lds_byte(wr * 64 + fr, fq * 8), boff = lds_byte(wc * 32 + fr, fq * 8);
    auto atile = [&](int pm, int t) -> const char* { if constexpr (segt >= nt) { return (const char*)g.A + (size_t)pm * tstepA + (size_t)t * kstep; }
        else { const int s = t / segt; const bf16_t* b = (s == 0) ? g.A : ((s == 1) ? g.A1 : g.A2); return (const char*)b + (size_t)pm * tstepA + (size_t)(t - s * segt) * kstep; } };
#define PG8_SA(b, h) (((b) * 2 + (h)) * HTB)
#define PG8_SB(b, h) ((4 + (b) * 2 + (h)) * HTB)
#define PG8_STAGE(bufoff, gbase, voff) do { _Pragma("unroll") for (int _i = 0; _i < 2; ++_i) \
        __builtin_amdgcn_global_load_lds((const unsigned*)((const char*)(gbase) + (voff)[_i]), (PG8_LAS unsigned*)(lds + (bufoff) + ldsw + _i * 8192), 16, 0, 0); } while (0)
#define PG8_LDA(dst, b, h) do { _Pragma("unroll") for (int m = 0; m < 4; ++m) _Pragma("unroll") for (int k = 0; k < 2; ++k) dst[m][k] = *(const PG8_LAS bf16x8*)(lds + PG8_SA(b, h) + aoff + m * 2048 + k * 1024); } while (0)
#define PG8_LDB(dst, b, h) do { _Pragma("unroll") for (int n = 0; n < 2; ++n) _Pragma("unroll") for (int k = 0; k < 2; ++k) dst[n][k] = *(const PG8_LAS bf16x8*)(lds + PG8_SB(b, h) + boff + n * 2048 + k * 1024); } while (0)
#define PG8_MMA(ai, bj, At, Bt) do { __builtin_amdgcn_s_setprio(1); _Pragma("unroll") for (int m = 0; m < 4; ++m) _Pragma("unroll") for (int n = 0; n < 2; ++n) _Pragma("unroll") for (int k = 0; k < 2; ++k) \
        acc[ai][bj][m][n] = __builtin_amdgcn_mfma_f32_16x16x32_bf16(Bt[n][k], At[m][k], acc[ai][bj][m][n], 0, 0, 0); __builtin_amdgcn_s_setprio(0); } while (0)
#define PG8_WAIT_V(n) asm volatile("s_waitcnt vmcnt(" #n ")" ::: "memory")
#define PG8_WAIT_L(n) asm volatile("s_waitcnt lgkmcnt(" #n ")" ::: "memory")
#define PG8_BAR __builtin_amdgcn_s_barrier()
#define PG8_SCHED __builtin_amdgcn_sched_barrier(0)
    Unit cur, nxt; int ui = 0;
    if (!S.next(0, cur)) return;
    f32x4 acc[2][2][4][2];
#pragma unroll
    for (int a = 0; a < 2; ++a)
#pragma unroll
        for (int b = 0; b < 2; ++b)
#pragma unroll
            for (int m = 0; m < 4; ++m)
#pragma unroll
                for (int n = 0; n < 2; ++n) acc[a][b][m][n] = (f32x4){0.f, 0.f, 0.f, 0.f};
    bf16x8 At[4][2], B0[2][2], B1[2][2];
    const char* cB = (const char*)g.Bt + (size_t)cur.pn * tstepB;
    {
        const char* cA0 = atile(cur.pm, 0); const char* cA1 = atile(cur.pm, 1);
        PG8_STAGE(PG8_SB(0, 0), cB, voffB); PG8_STAGE(PG8_SB(0, 1), cB + hstepB, voffB); PG8_STAGE(PG8_SA(0, 0), cA0, voffA); PG8_STAGE(PG8_SA(0, 1), cA0 + hstepA, voffA);
        if (wr == 1) PG8_BAR;
        PG8_WAIT_V(2); PG8_BAR;
        PG8_STAGE(PG8_SB(1, 0), cB + kstep, voffB); PG8_STAGE(PG8_SA(1, 0), cA1, voffA); PG8_STAGE(PG8_SB(1, 1), cB + hstepB + kstep, voffB);
        PG8_WAIT_V(6); PG8_BAR;
    }
    for (;;) {
        const bool has_next = S.next(ui + 1, nxt);
        const int npm = has_next ? nxt.pm : cur.pm;
        const char* nB = has_next ? (const char*)g.Bt + (size_t)nxt.pn * tstepB : cB;
#pragma unroll 1
        for (int t = 0; t < nt; t += 2) {
            const bool last = (t == nt - 2);
            if constexpr (Epi::HAS_HOOK) E.khook(acc, cur, t, wr, wc, fr, fq);
            const char* a1 = atile(cur.pm, t + 1);
            const char* a2 = last ? atile(npm, 0) : atile(cur.pm, t + 2); const char* b2 = last ? nB : cB + (size_t)(t + 2) * kstep;
            const char* a3 = last ? atile(npm, 1) : atile(cur.pm, t + 3); const char* b3 = b2 + kstep;
            PG8_LDB(B0, 0, 0); PG8_LDB(B1, 0, 1); PG8_SCHED; PG8_LDA(At, 0, 0); PG8_STAGE(PG8_SA(1, 1), a1 + hstepA, voffA);
            PG8_WAIT_V(8); PG8_WAIT_L(0); PG8_BAR; PG8_MMA(0, 0, At, B0); PG8_MMA(0, 1, At, B1); PG8_BAR; PG8_SCHED;
            PG8_LDA(At, 0, 1); PG8_STAGE(PG8_SB(0, 0), b2, voffB); PG8_STAGE(PG8_SB(0, 1), b2 + hstepB, voffB); PG8_STAGE(PG8_SA(0, 0), a2, voffA);
            PG8_WAIT_V(8); PG8_WAIT_L(0); PG8_BAR; PG8_MMA(1, 0, At, B0); PG8_MMA(1, 1, At, B1); PG8_BAR; PG8_SCHED;
            PG8_LDB(B0, 1, 0); PG8_LDB(B1, 1, 1); PG8_SCHED; PG8_LDA(At, 1, 0); PG8_STAGE(PG8_SA(0, 1), a2 + hstepA, voffA);
            PG8_WAIT_V(8); PG8_WAIT_L(0); PG8_BAR; PG8_MMA(0, 0, At, B0); PG8_MMA(0, 1, At, B1); PG8_BAR; PG8_SCHED;
            PG8_LDA(At, 1, 1); PG8_STAGE(PG8_SB(1, 0), b3, voffB); PG8_STAGE(PG8_SB(1, 1), b3 + hstepB, voffB); PG8_STAGE(PG8_SA(1, 0), a3, voffA);
            PG8_WAIT_V(8); PG8_WAIT_L(0); PG8_BAR; PG8_MMA(1, 0, At, B0); PG8_MMA(1, 1, At, B1); PG8_BAR; PG8_SCHED;
        }
        if constexpr (ALIGN_EPI) { if (wr == 0) PG8_BAR; }
        E(acc, cur, wr, wc, fr, fq);
        if (!has_next) break;
#pragma unroll
        for (int a = 0; a < 2; ++a)
#pragma unroll
            for (int b = 0; b < 2; ++b)
#pragma unroll
                for (int m = 0; m < 4; ++m)
#pragma unroll
                    for (int n = 0; n < 2; ++n) acc[a][b][m][n] = (f32x4){0.f, 0.f, 0.f, 0.f};
        cur = nxt; cB = nB; ++ui;
        if constexpr (ALIGN_EPI) { if (wr == 1) PG8_BAR; }
    }
    PG8_WAIT_V(0);
    if constexpr (!ALIGN_EPI) { if (wr == 0) PG8_BAR; }
    PG8_BAR;
#undef PG8_SA
#undef PG8_SB
#undef PG8_STAGE
#undef PG8_LDA
#undef PG8_LDB
#undef PG8_MMA
#undef PG8_WAIT_V
#undef PG8_WAIT_L
#undef PG8_BAR
#undef PG8_SCHED
}

__device__ __forceinline__ void rstd8(const float* ssq, int row0, int fq, float (&rs)[2][4]) {
    f32x4 p[2][4];
#pragma unroll
    for (int ai = 0; ai < 2; ++ai)
#pragma unroll
        for (int m = 0; m < 4; ++m) p[ai][m] = *(const f32x4*)(ssq + 16 * (size_t)(row0 + ai * HALF + m * 16) + 4 * fq);
#pragma unroll
    for (int ai = 0; ai < 2; ++ai)
#pragma unroll
        for (int m = 0; m < 4; ++m) { float t = (p[ai][m][0] + p[ai][m][1]) + (p[ai][m][2] + p[ai][m][3]); t += shfl_xor_t(t, 16); t += shfl_xor_t(t, 32); rs[ai][m] = rsqrtf(t * (1.f / 1024.f) + 1e-6f); }
    asm volatile("" ::: "memory");
}
__device__ __forceinline__ void rstd4(const float* ssq, int row0, int fq, float (&rs)[4]) {
    f32x4 p[4];
#pragma unroll
    for (int m = 0; m < 4; ++m) p[m] = *(const f32x4*)(ssq + 16 * (size_t)(row0 + m * 16) + 4 * fq);
#pragma unroll
    for (int m = 0; m < 4; ++m) { float t = (p[m][0] + p[m][1]) + (p[m][2] + p[m][3]); t += shfl_xor_t(t, 16); t += shfl_xor_t(t, 32); rs[m] = rsqrtf(t * (1.f / 1024.f) + 1e-6f); }
    asm volatile("" ::: "memory");
}
__device__ __forceinline__ float rstd16(const float* ssq, int r) {
    const f32x4* p = (const f32x4*)(ssq + 16 * (size_t)r);
    const f32x4 a = p[0], b = p[1], c = p[2], d = p[3];
    const float s = (((a[0] + a[1]) + (a[2] + a[3])) + ((b[0] + b[1]) + (b[2] + b[3]))) + (((c[0] + c[1]) + (c[2] + c[3])) + ((d[0] + d[1]) + (d[2] + d[3])));
    return rsqrtf(s * (1.f / 1024.f) + 1e-6f);
}
__device__ __forceinline__ float bfl(unsigned w) { return __uint_as_float(w << 16); }
__device__ __forceinline__ float bfh(unsigned w) { return __uint_as_float(w & 0xffff0000u); }
__device__ __forceinline__ float sigm(float x) { return __builtin_amdgcn_rcpf(1.f + __expf(-x)); }

struct EpiRowScale {
    static constexpr bool PERM = true, HAS_HOOK = false;
    bf16_t* O; const float* ssq; int ldc; int act;
    __device__ __forceinline__ void operator()(const f32x4 (&acc)[2][2][4][2], const Unit& u, int wr, int wc, int fr, int fq) const {
        const int row0 = u.pm * BM + wr * 64 + fr, col0 = u.pn * BM + wc * 32 + 8 * fq;
        float rs8[2][4];
        if (ssq) rstd8(ssq, row0, fq, rs8);
#pragma unroll
        for (int ai = 0; ai < 2; ++ai)
#pragma unroll
            for (int m = 0; m < 4; ++m) { const int r = row0 + ai * HALF + m * 16; const float rs = ssq ? rs8[ai][m] : 1.f; bf16_t* rowp = O + (size_t)r * ldc + col0;
#pragma unroll
                for (int bj = 0; bj < 2; ++bj) { f32x4 v0 = acc[ai][bj][m][0] * rs, v1 = acc[ai][bj][m][1] * rs;
                    if (act == 1) {
#pragma unroll
                        for (int i = 0; i < 4; ++i) { v0[i] = sigm(v0[i]); v1[i] = sigm(v1[i]); } }
                    u32x4 w; w.x = cvt_pk_bf16(v0[0], v0[1]); w.y = cvt_pk_bf16(v0[2], v0[3]); w.z = cvt_pk_bf16(v1[0], v1[1]); w.w = cvt_pk_bf16(v1[2], v1[3]);
                    *(u32x4*)(rowp + bj * HALF) = w; } }
    }
};
__device__ __forceinline__ unsigned pk_f16(float lo, float hi) { const _Float16 a = (_Float16)lo, b = (_Float16)hi; return (unsigned)__builtin_bit_cast(unsigned short, a) | ((unsigned)__builtin_bit_cast(unsigned short, b) << 16); }
struct EpiLora {
    static constexpr bool PERM = true, HAS_HOOK = false;
    unsigned short* base; const float* w0; const float* a0;
    __device__ __forceinline__ void operator()(const f32x4 (&acc)[2][2][4][2], const Unit& u, int wr, int wc, int fr, int fq) const {
        const int kind = u.pn >> 1;
        const int row0 = u.pm * BM + wr * 64 + fr, col0 = (u.pn & 1) * BM + wc * 32 + 8 * fq;
        unsigned short* O = base + (size_t)kind * ((size_t)16384 * 512);
        f32x4 bv[2][2];
#pragma unroll
        for (int bj = 0; bj < 2; ++bj)
#pragma unroll
            for (int n = 0; n < 2; ++n) { const f32x4 b0 = *(const f32x4*)(w0 + col0 + bj * HALF + 4 * n), b1 = *(const f32x4*)(a0 + col0 + bj * HALF + 4 * n);
                bv[bj][n] = (kind == 0) ? b0 : ((kind == 1) ? b1 : (f32x4){0.f, 0.f, 0.f, 0.f}); }
#pragma unroll
        for (int ai = 0; ai < 2; ++ai)
#pragma unroll
            for (int m = 0; m < 4; ++m) { unsigned short* rowp = O + (size_t)(row0 + ai * HALF + m * 16) * 512 + col0;
#pragma unroll
                for (int bj = 0; bj < 2; ++bj) { float o[8];
#pragma unroll
                    for (int i = 0; i < 8; ++i) o[i] = acc[ai][bj][m][i >> 2][i & 3] + bv[bj][i >> 2][i & 3];
                    u32x4 w;
                    if (kind == 0) {
#pragma unroll
                        for (int i = 0; i < 8; ++i) o[i] = -0.60653066f * __builtin_amdgcn_rcpf(1.f + __expf(-o[i]));
                        w.x = pk_f16(o[0], o[1]); w.y = pk_f16(o[2], o[3]); w.z = pk_f16(o[4], o[5]); w.w = pk_f16(o[6], o[7]);
                    } else {
                        if (kind == 1) {
#pragma unroll
                            for (int i = 0; i < 8; ++i) o[i] = sigm(o[i]); }
                        w.x = cvt_pk_bf16(o[0], o[1]); w.y = cvt_pk_bf16(o[2], o[3]); w.z = cvt_pk_bf16(o[4], o[5]); w.w = cvt_pk_bf16(o[6], o[7]);
                    }
                    *(u32x4*)(rowp + bj * HALF) = w; } }
    }
};
struct EpiVres {
    static constexpr bool PERM = true, HAS_HOOK = false;
    const bf16_t* v; const bf16_t* vf; const float* v0; bf16_t* O;
    __device__ __forceinline__ void operator()(const f32x4 (&acc)[2][2][4][2], const Unit& u, int wr, int wc, int fr, int fq) const {
        const int row0 = u.pm * BM + wr * 64 + fr, col0 = u.pn * BM + wc * 32 + 8 * fq;
#pragma unroll
        for (int ai = 0; ai < 2; ++ai)
#pragma unroll
            for (int m = 0; m < 4; ++m) { const size_t off = (size_t)(row0 + ai * HALF + m * 16) * 512 + col0;
#pragma unroll
                for (int bj = 0; bj < 2; ++bj) {
                    const u32x4 vv = *(const u32x4*)(v + off + bj * HALF), ff = *(const u32x4*)(vf + off + bj * HALF);
                    const f32x4 b0 = *(const f32x4*)(v0 + col0 + bj * HALF), b1 = *(const f32x4*)(v0 + col0 + bj * HALF + 4);
                    float o[8];
#pragma unroll
                    for (int i = 0; i < 8; ++i) { const unsigned vw = vv[i >> 1], fw = ff[i >> 1]; const float x = (i & 1) ? bfh(vw) : bfl(vw), f = (i & 1) ? bfh(fw) : bfl(fw);
                        const float z = ((i < 4) ? b0[i & 3] : b1[i & 3]) + acc[ai][bj][m][i >> 2][i & 3]; o[i] = x + (f - x) * sigm(z); }
                    u32x4 w; w.x = cvt_pk_bf16(o[0], o[1]); w.y = cvt_pk_bf16(o[2], o[3]); w.z = cvt_pk_bf16(o[4], o[5]); w.w = cvt_pk_bf16(o[6], o[7]);
                    *(u32x4*)(O + off + bj * HALF) = w; } }
    }
};
template <bool XIN_BF16, bool WRITE_F32> struct EpiResidual {
    static constexpr bool PERM = true, HAS_HOOK = false;
    const float* xin; const bf16_t* xinb; float* xout; bf16_t* xb; float* ssq;
    __device__ __forceinline__ void operator()(const f32x4 (&acc)[2][2][4][2], const Unit& u, int wr, int wc, int fr, int fq) const {
        const int row0 = u.pm * BM + wr * 64 + fr, col0 = u.pn * BM + wc * 32 + 8 * fq;
#pragma unroll
        for (int ai = 0; ai < 2; ++ai) {
            u32x4 xi[4][2]; f32x4 xf[4][2][2];
#pragma unroll
            for (int m = 0; m < 4; ++m)
#pragma unroll
                for (int bj = 0; bj < 2; ++bj) { const size_t o = (size_t)(row0 + ai * HALF + m * 16) * 1024 + col0 + bj * HALF;
                    if constexpr (XIN_BF16) xi[m][bj] = *(const u32x4*)(xinb + o);
                    else { xf[m][bj][0] = *(const f32x4*)(xin + o); xf[m][bj][1] = *(const f32x4*)(xin + o + 4); } }
            asm volatile("" ::: "memory");
#pragma unroll
            for (int m = 0; m < 4; ++m) { const int r = row0 + ai * HALF + m * 16; float s = 0.f;
#pragma unroll
                for (int bj = 0; bj < 2; ++bj) { const size_t o = (size_t)r * 1024 + col0 + bj * HALF;
                    f32x4 x0, x1;
                    if constexpr (XIN_BF16) { const u32x4 wv = xi[m][bj]; x0 = (f32x4){bfl(wv.x), bfh(wv.x), bfl(wv.y), bfh(wv.y)} + acc[ai][bj][m][0]; x1 = (f32x4){bfl(wv.z), bfh(wv.z), bfl(wv.w), bfh(wv.w)} + acc[ai][bj][m][1]; }
                    else { x0 = xf[m][bj][0] + acc[ai][bj][m][0]; x1 = xf[m][bj][1] + acc[ai][bj][m][1]; }
                    if constexpr (WRITE_F32) { *(f32x4*)(xout + o) = x0; *(f32x4*)(xout + o + 4) = x1; }
                    else {
                        s += ((x0[0] * x0[0] + x0[1] * x0[1]) + (x0[2] * x0[2] + x0[3] * x0[3])) + ((x1[0] * x1[0] + x1[1] * x1[1]) + (x1[2] * x1[2] + x1[3] * x1[3]));
                        u32x4 w; w.x = cvt_pk_bf16(x0[0], x0[1]); w.y = cvt_pk_bf16(x0[2], x0[3]); w.z = cvt_pk_bf16(x1[0], x1[1]); w.w = cvt_pk_bf16(x1[2], x1[3]); *(u32x4*)(xb + o) = w; } }
                if constexpr (!WRITE_F32) { s += shfl_xor_t(s, 16); s += shfl_xor_t(s, 32);
                    if (fq == 0) ssq[(size_t)r * 16 + u.pn * 4 + wc] = s; } }
        }
    }
};
__device__ __forceinline__ size_t gate_chunk(int pm, int pnG, int wave, int i, int lane) { return ((((size_t)pm * 12 + pnG) * 8 + wave) * 16 + i) * 512 + (size_t)lane * 8; }
struct EpiGatesFrag {
    static constexpr bool PERM = true, HAS_HOOK = false;
    bf16_t* O; const float* ssq;
    __device__ __forceinline__ void operator()(const f32x4 (&acc)[2][2][4][2], const Unit& u, int wr, int wc, int fr, int fq) const {
        const int row0 = u.pm * BM + wr * 64 + fr, wave = wr * 4 + wc, lane = fq * 16 + fr;
        float rs8[2][4];
        rstd8(ssq, row0, fq, rs8);
#pragma unroll
        for (int ai = 0; ai < 2; ++ai)
#pragma unroll
            for (int m = 0; m < 4; ++m) { const float rs = rs8[ai][m];
#pragma unroll
                for (int bj = 0; bj < 2; ++bj) { f32x4 v0 = acc[ai][bj][m][0] * rs, v1 = acc[ai][bj][m][1] * rs;
#pragma unroll
                    for (int i = 0; i < 4; ++i) { v0[i] = __expf(-fmaxf(v0[i], -60.f)); v1[i] = __expf(-fmaxf(v1[i], -60.f)); }
                    u32x4 w; w.x = cvt_pk_bf16(v0[0], v0[1]); w.y = cvt_pk_bf16(v0[2], v0[3]); w.z = cvt_pk_bf16(v1[0], v1[1]); w.w = cvt_pk_bf16(v1[2], v1[3]);
                    *(u32x4*)(O + gate_chunk(u.pm, u.pn, wave, (ai * 4 + m) * 2 + bj, lane)) = w; } }
    }
};
struct EpiGated {
    static constexpr bool PERM = true, HAS_HOOK = true;
    const bf16_t* gates; bf16_t* O;
    __device__ __forceinline__ void khook(f32x4 (&acc)[2][2][4][2], const Unit& u, int t, int wr, int wc, int fr, int fq) const {
        if (t != 8 && t != 16) return;
        const int b = (t >> 3) - 1, wave = wr * 4 + wc, lane = fq * 16 + fr;
#pragma unroll
        for (int ai = 0; ai < 2; ++ai)
#pragma unroll
            for (int mp = 0; mp < 2; ++mp) {
                u32x4 w0[2][2], w1[2][2];
#pragma unroll
                for (int mm = 0; mm < 2; ++mm)
#pragma unroll
                    for (int bj = 0; bj < 2; ++bj) { const int i = (ai * 4 + 2 * mp + mm) * 2 + bj;
                        w0[mm][bj] = *(const u32x4*)(gates + gate_chunk(u.pm, b * 4 + u.pn, wave, i, lane)); w1[mm][bj] = *(const u32x4*)(gates + gate_chunk(u.pm, (b + 1) * 4 + u.pn, wave, i, lane)); }
                asm volatile("" ::: "memory");
#pragma unroll
                for (int mm = 0; mm < 2; ++mm)
#pragma unroll
                    for (int bj = 0; bj < 2; ++bj) { const int m = 2 * mp + mm;
#pragma unroll
                        for (int n = 0; n < 2; ++n) { const unsigned a0 = n ? w0[mm][bj].z : w0[mm][bj].x, a1 = n ? w0[mm][bj].w : w0[mm][bj].y, c0 = n ? w1[mm][bj].z : w1[mm][bj].x, c1 = n ? w1[mm][bj].w : w1[mm][bj].y;
                            f32x4 r;
                            r[0] = (1.f + bfl(c0)) * __builtin_amdgcn_rcpf(1.f + bfl(a0)); r[1] = (1.f + bfh(c0)) * __builtin_amdgcn_rcpf(1.f + bfh(a0));
                            r[2] = (1.f + bfl(c1)) * __builtin_amdgcn_rcpf(1.f + bfl(a1)); r[3] = (1.f + bfh(c1)) * __builtin_amdgcn_rcpf(1.f + bfh(a1));
                            acc[ai][bj][m][n] *= r; } }
                asm volatile("" ::: "memory");
            }
    }
    __device__ __forceinline__ void operator()(const f32x4 (&acc)[2][2][4][2], const Unit& u, int wr, int wc, int fr, int fq) const {
        const int row0 = u.pm * BM + wr * 64 + fr, col0 = u.pn * BM + wc * 32 + 8 * fq, wave = wr * 4 + wc, lane = fq * 16 + fr;
#pragma unroll
        for (int ai = 0; ai < 2; ++ai) {
            u32x4 w2[4][2];
#pragma unroll
            for (int m = 0; m < 4; ++m)
#pragma unroll
                for (int bj = 0; bj < 2; ++bj) w2[m][bj] = *(const u32x4*)(gates + gate_chunk(u.pm, 8 + u.pn, wave, (ai * 4 + m) * 2 + bj, lane));
            asm volatile("" ::: "memory");
#pragma unroll
            for (int m = 0; m < 4; ++m) { const int r = row0 + ai * HALF + m * 16;
#pragma unroll
                for (int bj = 0; bj < 2; ++bj) { const u32x4 g2 = w2[m][bj];
                    const f32x4 a0 = acc[ai][bj][m][0], a1 = acc[ai][bj][m][1];
                    u32x4 w; w.x = cvt_pk_bf16(a0[0] * __builtin_amdgcn_rcpf(1.f + bfl(g2.x)), a0[1] * __builtin_amdgcn_rcpf(1.f + bfh(g2.x))); w.y = cvt_pk_bf16(a0[2] * __builtin_amdgcn_rcpf(1.f + bfl(g2.y)), a0[3] * __builtin_amdgcn_rcpf(1.f + bfh(g2.y)));
                    w.z = cvt_pk_bf16(a1[0] * __builtin_amdgcn_rcpf(1.f + bfl(g2.z)), a1[1] * __builtin_amdgcn_rcpf(1.f + bfh(g2.z))); w.w = cvt_pk_bf16(a1[2] * __builtin_amdgcn_rcpf(1.f + bfl(g2.w)), a1[3] * __builtin_amdgcn_rcpf(1.f + bfh(g2.w)));
                    *(u32x4*)(O + (size_t)r * 1024 + col0 + bj * HALF) = w; } }
        }
    }
};
template <int N> __device__ __forceinline__ float ror16(float v) { return __builtin_bit_cast(float, __builtin_amdgcn_update_dpp(0, __builtin_bit_cast(int, v), 0x120 + N, 0xf, 0xf, false)); }
__device__ __forceinline__ float silu_mul(float g, float v) { return g * __builtin_amdgcn_rcpf(1.f + __expf(-g)) * v; }
struct EpiConv {
    static constexpr bool PERM = true, HAS_HOOK = false;
    const float* ssq; const float* cw; const float* cb; bf16_t* U; float* side;
    __device__ __forceinline__ void operator()(const f32x4 (&acc)[2][2][4][2], const Unit& u, int wr, int wc, int fr, int fq) const {
        const int ch0 = u.pn * 128 + wc * 32 + 8 * fq;
        float rsa[4], rsb[4];
        rstd4(ssq, u.pm * BM + wr * 64 + fr, fq, rsa); rstd4(ssq, u.pm * BM + HALF + wr * 64 + fr, fq, rsb);
#pragma unroll
        for (int n = 0; n < 2; ++n) {
            const int ch = ch0 + 4 * n;
            const f32x4 g0 = *(const f32x4*)(cw + ch), g1 = *(const f32x4*)(cw + 5632 + ch), g2 = *(const f32x4*)(cw + 2 * 5632 + ch), gb = *(const f32x4*)(cb + ch);
            const f32x4 v0 = *(const f32x4*)(cw + 2816 + ch), v1 = *(const f32x4*)(cw + 5632 + 2816 + ch), v2 = *(const f32x4*)(cw + 2 * 5632 + 2816 + ch), vb = *(const f32x4*)(cb + 2816 + ch);
#pragma unroll
            for (int ai = 0; ai < 2; ++ai) {
                const int cid = u.pm * 4 + ai * 2 + wr;
                f32x4 pg = (f32x4){0.f, 0.f, 0.f, 0.f}, pv = pg;
#pragma unroll
                for (int m = 0; m < 4; ++m) {
                    const float rsm = ai ? rsb[m] : rsa[m];
                    const f32x4 cg = acc[ai][0][m][n] * rsm, cv = acc[ai][1][m][n] * rsm;
                    if ((m == 0 && fr < 2) || (m == 3 && fr >= 14)) { const int rr = (m == 0) ? fr : fr - 12;
                        float* sp = side + (((size_t)cid * 4 + rr) * 2) * 2816 + ch; *(f32x4*)sp = cg; *(f32x4*)(sp + 2816) = cv; }
                    f32x4 G, V;
#pragma unroll
                    for (int i = 0; i < 4; ++i) {
                        const float y1g = (fr == 15) ? pg[i] : cg[i], y2g = (fr >= 14) ? pg[i] : cg[i];
                        const float y1v = (fr == 15) ? pv[i] : cv[i], y2v = (fr >= 14) ? pv[i] : cv[i];
                        const float h1g = ror16<1>(y1g), h2g = ror16<2>(y2g), h1v = ror16<1>(y1v), h2v = ror16<2>(y2v);
                        G[i] = gb[i] + g0[i] * h2g + g1[i] * h1g + g2[i] * cg[i];
                        V[i] = vb[i] + v0[i] * h2v + v1[i] * h1v + v2[i] * cv[i];
                    }
                    u32x2 w; w.x = cvt_pk_bf16(silu_mul(G[0], V[0]), silu_mul(G[1], V[1])); w.y = cvt_pk_bf16(silu_mul(G[2], V[2]), silu_mul(G[3], V[3]));
                    *(u32x2*)(U + (size_t)(u.pm * BM + ai * HALF + wr * 64 + m * 16 + fr) * 2816 + ch) = w;
                    pg = cg; pv = cv;
                }
            }
        }
    }
};
}


#define LAS3 __attribute__((address_space(3)))
typedef float f32x4v __attribute__((ext_vector_type(4)));
typedef float f32x2v __attribute__((ext_vector_type(2)));
typedef unsigned u32x2v __attribute__((ext_vector_type(2)));
typedef unsigned u32x4v __attribute__((ext_vector_type(4)));
template <int CTRL> __device__ __forceinline__ float dppf(float v) { return __builtin_bit_cast(float, __builtin_amdgcn_update_dpp(0, __builtin_bit_cast(int, v), CTRL, 0xf, 0xf, true)); }
__device__ __forceinline__ float allsum16(float v) { v += dppf<0xB1>(v); v += dppf<0x4E>(v); v += dppf<0x141>(v); v += dppf<0x140>(v); return v; }
struct ScanArgs { const bf16* r_s; const bf16* k_s; const bf16* v; const bf16* a; const unsigned short* ld; const float* nrm; const float* k_k; const float* k_a; bf16* y_raw; const float* r_k; float* bonus; };
__device__ __forceinline__ float bf_lo(unsigned w) { return __uint_as_float(w << 16); }
__device__ __forceinline__ float bf_hi(unsigned w) { return __uint_as_float(w & 0xffff0000u); }
__device__ __forceinline__ float h_lo(unsigned w) { return (float)__builtin_bit_cast(_Float16, (unsigned short)(w & 0xffffu)); }
__device__ __forceinline__ float h_hi(unsigned w) { return (float)__builtin_bit_cast(_Float16, (unsigned short)(w >> 16)); }

typedef short bf16x8s __attribute__((ext_vector_type(8)));
typedef float f32x4c __attribute__((ext_vector_type(4)));
constexpr int CS_ROW = 144;
constexpr int CS_TR = 40;
constexpr int RC_P = 0, RC_RT = RC_P + 16 * CS_ROW, RC_KB = RC_RT + 16 * CS_ROW, RC_SM = RC_KB + 64 * 80, RC_GC = RC_SM + 16 * CS_ROW, RC_BYTES = RC_GC + 256;
static_assert(RC_BYTES == 12288, "record size");
__device__ __forceinline__ int rc_pos(int key) { return (key & 32) + 8 * ((key >> 2) & 3) + 4 * ((key >> 4) & 1) + (key & 3); }
constexpr int PS_KT = 0, PS_RT = PS_KT + 16 * CS_ROW, PS_KH = PS_RT + 16 * CS_ROW, PS_BH = PS_KH + 16 * CS_ROW, PS_KTT = PS_BH + 16 * CS_ROW, PS_AB = PS_KTT + 64 * CS_TR, PS_TM = PS_AB + 1024, PS_R2 = PS_TM + 16 * CS_TR, PS_BYTES = PS_R2 + 16 * CS_ROW;
static_assert(PS_BYTES % 16 == 0 && 8 * PS_BYTES <= 147456 - 64, "producer scratch");
constexpr int SL_VT = RC_BYTES, SL_BYTES = SL_VT + 64 * CS_TR, CS_GRP = 2, CS_RING = 4 * CS_GRP;
static_assert(SL_BYTES % 16 == 0 && CS_RING * SL_BYTES <= 147456 - 64, "consumer ring");
constexpr int CS_NCHUNK = SEQ / 16, CS_NITEM = 64 * CS_NCHUNK;
constexpr int CS_NA = (int)((64u << 20) / RC_BYTES);
struct CsRec { unsigned char* a; unsigned char* b; unsigned char* c; };
__device__ __forceinline__ unsigned char* cs_rec(const CsRec& R, int item) {
    constexpr int NB = (int)((32u << 20) / RC_BYTES);
    return item < CS_NA ? R.a + (size_t)item * RC_BYTES : (item < CS_NA + NB ? R.b + (size_t)(item - CS_NA) * RC_BYTES : R.c + (size_t)(item - CS_NA - NB) * RC_BYTES);
}
static_assert(CS_NA + (int)((32u << 20) / RC_BYTES) + (int)((16u << 20) / RC_BYTES) >= CS_NITEM, "record space");

typedef short bf16x4s __attribute__((ext_vector_type(4)));
__device__ __forceinline__ bf16x4s frag4(const LAS3 unsigned char* p) { return __builtin_bit_cast(bf16x4s, *(const LAS3 u32x2v*)p); }
__device__ __forceinline__ bf16x8s frag_2x4(const LAS3 unsigned char* p0, const LAS3 unsigned char* p1) {
    const u32x2v a = *(const LAS3 u32x2v*)p0, b = *(const LAS3 u32x2v*)p1; const u32x4v f = {a[0], a[1], b[0], b[1]}; return __builtin_bit_cast(bf16x8s, f); }
__device__ __forceinline__ bf16x4s pack4(const f32x4c& x) { const u32x2v f = {pg8::cvt_pk_bf16(x[0], x[1]), pg8::cvt_pk_bf16(x[2], x[3])}; return __builtin_bit_cast(bf16x4s, f); }
__device__ __forceinline__ f32x4c zero4_opaque() { int zi = 0; asm volatile("" : "+s"(zi)); const float zf = __builtin_bit_cast(float, zi); f32x4c z = {zf, zf, zf, zf}; asm volatile("" : "+v"(z)); return z; }
__device__ __forceinline__ bf16x8s pad8(bf16x4s a) { const u32x2v w = __builtin_bit_cast(u32x2v, a); const u32x4v f = {w[0], w[1], 0u, 0u}; return __builtin_bit_cast(bf16x8s, f); }
#define MFMA16K(a, b, c) __builtin_amdgcn_mfma_f32_16x16x32_bf16(pad8(a), pad8(b), c, 0, 0, 0)
#define MFMA16(a, b, c) __builtin_amdgcn_mfma_f32_16x16x32_bf16(a, b, c, 0, 0, 0)

__device__ __forceinline__ void cscan_produce(LAS3 unsigned char* sc, const ScanArgs& A, const CsRec& R, int gw_, int NGW_) {
    const int lane = opaque_tid() & 63, li = lane & 15, lq = lane >> 4;
    unsigned wrk[16]; unsigned short wa_[16], wl_[16]; float rnv;
    auto load_raw = [&](int item_v) {
        const int item = __builtin_amdgcn_readfirstlane(item_v);
        const int bh = item >> 7, c = item & 127, b = bh >> 3, h = bh & 7;
        const size_t row0 = (size_t)b * SEQ + (size_t)c * 16;
        const unsigned* prk = (const unsigned*)A.r_s + row0 * 512 + h * 64 + lane; const bf16* pa = A.a + row0 * 512 + h * 64 + lane;
        const unsigned short* pl = A.ld + row0 * 512 + h * 64 + lane; const float* pn = A.nrm + row0 * 8 + h;
#pragma unroll
        for (int s = 0; s < 16; ++s) { wrk[s] = prk[s * 512]; wa_[s] = pa[s * 512]; wl_[s] = pl[s * 512]; }
        rnv = pn[(lane & 15) * 8];
    };
    if (gw_ < CS_NITEM) load_raw(gw_);
    for (int item_v = gw_; item_v < CS_NITEM; item_v += NGW_) {
        const int item = __builtin_amdgcn_readfirstlane(item_v);
        const int h = (item >> 7) & 7;
        const float kkc = A.k_k[h * 64 + lane], kac = A.k_a[h * 64 + lane], rkc = A.r_k[h * 64 + lane];
        unsigned char* rec = cs_rec(R, item);
        float g = 1.f, kh4[4], bh4[4];
        const int lp2 = 2 * rc_pos(lane);
        unsigned ktw[8];
#pragma unroll
        for (int s = 0; s < 16; ++s) {
            const float r = __uint_as_float(wrk[s] << 16), k = __uint_as_float(wrk[s] & 0xffff0000u), aa = __uint_as_float((unsigned)wa_[s] << 16);
            const float dec = __expf((float)__builtin_bit_cast(_Float16, wl_[s]));
            const float gm1 = g; g *= dec;
            const float ig = __builtin_amdgcn_rcpf(g);
            const float rns = __builtin_bit_cast(float, __builtin_amdgcn_readlane(__builtin_bit_cast(int, rnv), s));
            const float kk = k * kkc * rns, bb = kk * aa, kt = k * (1.f + (aa - 1.f) * kac);
            const float ktil = kk * gm1, khs = kt * ig, bhs = bb * ig; kh4[s & 3] = khs; bh4[s & 3] = -bhs;
            const unsigned w0 = pg8::cvt_pk_bf16(ktil, khs), w1 = pg8::cvt_pk_bf16(bhs, r * g);
            *(LAS3 unsigned short*)(sc + PS_R2 + s * CS_ROW + lp2) = (unsigned short)(pg8::cvt_pk_bf16(r * g * rkc, 0.f) & 0xffffu);
            *(LAS3 unsigned short*)(sc + PS_KT + s * CS_ROW + lp2) = (unsigned short)(w0 & 0xffffu);
            *(LAS3 unsigned short*)(sc + PS_KH + s * CS_ROW + lp2) = (unsigned short)(w0 >> 16);
            *(LAS3 unsigned short*)(sc + PS_BH + s * CS_ROW + lp2) = (unsigned short)(w1 & 0xffffu);
            *(LAS3 unsigned short*)(sc + PS_RT + s * CS_ROW + lp2) = (unsigned short)(w1 >> 16);
            if (s & 1) ktw[s >> 1] |= (w0 & 0xffffu) << 16; else ktw[s >> 1] = w0 & 0xffffu;
            if ((s & 3) == 3) { const int q4 = s >> 2;
                *(u32x4v*)(rec + RC_KB + lane * 80 + 16 * q4) = (u32x4v){pg8::cvt_pk_bf16(kh4[0], kh4[1]), pg8::cvt_pk_bf16(kh4[2], kh4[3]), pg8::cvt_pk_bf16(bh4[0], bh4[1]), pg8::cvt_pk_bf16(bh4[2], bh4[3])}; }
        }
        *(float*)(rec + RC_GC + 4 * lane) = g;
#pragma unroll
        for (int q4 = 0; q4 < 4; ++q4) *(LAS3 u32x2v*)(sc + PS_KTT + lane * CS_TR + 8 * q4) = (u32x2v){ktw[2 * q4], ktw[2 * q4 + 1]};
        if (item + NGW_ < CS_NITEM) load_raw(item + NGW_);
        asm volatile("s_waitcnt lgkmcnt(0)" ::: "memory");
        f32x4c ak = zero4_opaque(), ab = zero4_opaque(), bk = zero4_opaque(), bb4 = zero4_opaque(), bd = zero4_opaque();
#pragma unroll
        for (int st = 0; st < 2; ++st) {
            const bf16x8s fkt = *(const LAS3 bf16x8s*)(sc + PS_KT + li * CS_ROW + 64 * st + 16 * lq), frt = *(const LAS3 bf16x8s*)(sc + PS_RT + li * CS_ROW + 64 * st + 16 * lq);
            const bf16x8s fkh = *(const LAS3 bf16x8s*)(sc + PS_KH + li * CS_ROW + 64 * st + 16 * lq), fbh = *(const LAS3 bf16x8s*)(sc + PS_BH + li * CS_ROW + 64 * st + 16 * lq);
            ak = MFMA16(fkt, fkh, ak); ab = MFMA16(fkt, fbh, ab); bk = MFMA16(frt, fkh, bk); bb4 = MFMA16(frt, fbh, bb4);
            bd = MFMA16(*(const LAS3 bf16x8s*)(sc + PS_R2 + li * CS_ROW + 64 * st + 16 * lq), fkh, bd);
        }
        if ((li >> 2) == lq) { const int c_ = li & 3; const float bv = c_ == 0 ? bd[0] : (c_ == 1 ? bd[1] : (c_ == 2 ? bd[2] : bd[3]));
            A.bonus[((size_t)(item >> 10) * SEQ + (size_t)(item & 127) * 16 + li) * 8 + h] = bv; }
        {
            float akm[4], bkm[4], bbm[4];
#pragma unroll
            for (int c = 0; c < 4; ++c) { const int so = 4 * lq + c; const bool strict = li < so, incl = li <= so;
                akm[c] = strict ? ak[c] : 0.f; bkm[c] = incl ? bk[c] : 0.f; bbm[c] = incl ? -bb4[c] : 0.f;
                *(LAS3 float*)(sc + PS_AB + (so * 16 + li) * 4) = strict ? ab[c] : 0.f; }
#pragma unroll
            for (int c = 0; c < 4; c += 2) { const unsigned wa = pg8::cvt_pk_bf16(akm[c], akm[c + 1]), wb = pg8::cvt_pk_bf16(bkm[c], bkm[c + 1]), wn = pg8::cvt_pk_bf16(bbm[c], bbm[c + 1]);
                LAS3 unsigned char* r0 = sc + PS_KH + (4 * lq + c) * CS_ROW + 32 * (li >> 2) + 2 * (li & 3); LAS3 unsigned char* r1 = r0 + CS_ROW;
                *(LAS3 unsigned short*)(r0) = (unsigned short)(wa & 0xffffu); *(LAS3 unsigned short*)(r1) = (unsigned short)(wa >> 16);
                *(LAS3 unsigned short*)(r0 + 16) = (unsigned short)(wb & 0xffffu); *(LAS3 unsigned short*)(r1 + 16) = (unsigned short)(wb >> 16);
                *(LAS3 unsigned short*)(r0 + 24) = (unsigned short)(wn & 0xffffu); *(LAS3 unsigned short*)(r1 + 24) = (unsigned short)(wn >> 16); }
        }
        asm volatile("s_waitcnt lgkmcnt(0)" ::: "memory");
        {
            float x[16];
            int lio = li; asm volatile("" : "+v"(lio));
#pragma unroll
            for (int s = 0; s < 16; ++s) {
                float acc0 = (s == lio) ? 1.f : 0.f, acc1 = 0.f;
#pragma unroll
                for (int q4 = 0; q4 < (s + 3) / 4; ++q4) { const f32x4c nrow = *(const LAS3 f32x4c*)(sc + PS_AB + (s * 16 + 4 * q4) * 4);
#pragma unroll
                    for (int e = 0; e < 4; ++e) if (4 * q4 + e < s) { if (e & 1) acc1 = fmaf(-nrow[e], x[4 * q4 + e], acc1); else acc0 = fmaf(-nrow[e], x[4 * q4 + e], acc0); } }
                x[s] = acc0 + acc1;
            }
            if (lq == 0) {
#pragma unroll
                for (int s = 0; s < 16; s += 2) { const unsigned wt = pg8::cvt_pk_bf16(x[s], x[s + 1]);
                    *(LAS3 unsigned short*)(sc + PS_TM + s * CS_TR + 2 * li) = (unsigned short)(wt & 0xffffu); *(LAS3 unsigned short*)(sc + PS_TM + (s + 1) * CS_TR + 2 * li) = (unsigned short)(wt >> 16);
                    *(LAS3 unsigned short*)(sc + PS_KH + s * CS_ROW + 32 * (li >> 2) + 8 + 2 * (li & 3)) = (unsigned short)(wt & 0xffffu); *(LAS3 unsigned short*)(sc + PS_KH + (s + 1) * CS_ROW + 32 * (li >> 2) + 8 + 2 * (li & 3)) = (unsigned short)(wt >> 16); }
            }
        }
        asm volatile("s_waitcnt lgkmcnt(0)" ::: "memory");
        const bf16x4s ftm = frag4(sc + PS_TM + li * CS_TR + 8 * lq);
#pragma unroll
        for (int tk = 0; tk < 4; ++tk) {
            const f32x4c pt = MFMA16K(ftm, frag4(sc + PS_KTT + (16 * tk + li) * CS_TR + 8 * lq), zero4_opaque());
#pragma unroll
            for (int c = 0; c < 4; c += 2) { const unsigned wp = pg8::cvt_pk_bf16(pt[c], pt[c + 1]);
                *(LAS3 unsigned short*)(sc + PS_KT + (4 * lq + c) * CS_ROW + 2 * rc_pos(16 * tk + li)) = (unsigned short)(wp & 0xffffu); *(LAS3 unsigned short*)(sc + PS_KT + (4 * lq + c + 1) * CS_ROW + 2 * rc_pos(16 * tk + li)) = (unsigned short)(wp >> 16); }
        }
        static_assert(PS_KT == 0 && PS_RT == 2304 && PS_KH == 4608 && RC_P == 0 && RC_RT == 2304, "staging order");
#pragma unroll
        for (int i = 0; i < 7; ++i) { const int pi = lane + 64 * i;
            if (i < 6 || pi < 432) { const u32x4v d = *(const LAS3 u32x4v*)(sc + 16 * pi); *(u32x4v*)(rec + (pi < 288 ? 16 * pi : RC_SM + 16 * (pi - 288))) = d; } }
        asm volatile("s_waitcnt lgkmcnt(0)" ::: "memory");
    }
}

struct CsOps { u32x2v fv; u32x4v sm0, sm1, p0, p1, r0, r1, kb[4]; f32x4c gc[4]; };
__device__ __forceinline__ void cs_load_ops(CsOps& o, const LAS3 unsigned char* sl, int w, int li, int lq) {
    o.fv = *(const LAS3 u32x2v*)(sl + SL_VT + (16 * w + li) * CS_TR + 8 * lq);
    o.sm0 = *(const LAS3 u32x4v*)(sl + RC_SM + li * CS_ROW + 32 * lq); o.sm1 = *(const LAS3 u32x4v*)(sl + RC_SM + li * CS_ROW + 32 * lq + 16);
    o.p0 = *(const LAS3 u32x4v*)(sl + RC_P + li * CS_ROW + 16 * lq); o.p1 = *(const LAS3 u32x4v*)(sl + RC_P + li * CS_ROW + 64 + 16 * lq);
    o.r0 = *(const LAS3 u32x4v*)(sl + RC_RT + li * CS_ROW + 16 * lq); o.r1 = *(const LAS3 u32x4v*)(sl + RC_RT + li * CS_ROW + 64 + 16 * lq);
#pragma unroll
    for (int tk = 0; tk < 4; ++tk) { o.kb[tk] = *(const LAS3 u32x4v*)(sl + RC_KB + (16 * tk + li) * 80 + 16 * lq); o.gc[tk] = *(const LAS3 f32x4c*)(sl + RC_GC + (16 * tk + 4 * lq) * 4); }
}
#define CS_B8(x) __builtin_bit_cast(bf16x8s, x)
__device__ __forceinline__ void cs_chunk(const CsOps& o, f32x4c (&H)[4], const f32x4c& Z, bf16* yp) {
    const u32x4v fvp = {o.fv[0], o.fv[1], 0u, 0u};
    const f32x4c akv = MFMA16(CS_B8(((u32x4v){o.sm0[0], o.sm0[1], 0u, 0u})), CS_B8(fvp), Z);
    u32x4v hb0 = {pg8::cvt_pk_bf16(H[0][0], H[0][1]), pg8::cvt_pk_bf16(H[0][2], H[0][3]), pg8::cvt_pk_bf16(H[1][0], H[1][1]), pg8::cvt_pk_bf16(H[1][2], H[1][3])};
    u32x4v hb1 = {pg8::cvt_pk_bf16(H[2][0], H[2][1]), pg8::cvt_pk_bf16(H[2][2], H[2][3]), pg8::cvt_pk_bf16(H[3][0], H[3][1]), pg8::cvt_pk_bf16(H[3][2], H[3][3])};
    f32x4c Y = MFMA16(CS_B8(o.r0), CS_B8(hb0), Z);
    Y = MFMA16(CS_B8(o.r1), CS_B8(hb1), Y);
    f32x4c U = MFMA16(CS_B8(((u32x4v){o.sm0[2], o.sm0[3], 0u, 0u})), CS_B8(((u32x4v){pg8::cvt_pk_bf16(akv[0], akv[1]), pg8::cvt_pk_bf16(akv[2], akv[3]), 0u, 0u})), Z);
    U = MFMA16(CS_B8(o.p0), CS_B8(hb0), U);
    U = MFMA16(CS_B8(o.p1), CS_B8(hb1), U);
    const u32x4v vu = {o.fv[0], o.fv[1], pg8::cvt_pk_bf16(U[0], U[1]), pg8::cvt_pk_bf16(U[2], U[3])};
    Y = MFMA16(CS_B8(o.sm1), CS_B8(vu), Y);
#pragma unroll
    for (int e = 0; e < 4; e += 2) { const unsigned wy = pg8::cvt_pk_bf16(Y[e], Y[e + 1]); yp[(size_t)e * 512] = (bf16)(wy & 0xffffu); yp[(size_t)(e + 1) * 512] = (bf16)(wy >> 16); }
#pragma unroll
    for (int tk = 0; tk < 4; ++tk) H[tk] = MFMA16(CS_B8(o.kb[tk]), CS_B8(vu), H[tk]) * o.gc[tk];
}
__device__ __forceinline__ void cscan_consume(LAS3 unsigned char* lds, const ScanArgs& A, const CsRec& R, int bh) {
    const int tid = opaque_tid(), lane = tid & 63, wave = __builtin_amdgcn_readfirstlane(tid >> 6), li = lane & 15, lq = lane >> 4;
    const int b = bh >> 3, h = bh & 7;
    const size_t rowbase = (size_t)b * SEQ;
    constexpr int NROUND = CS_NCHUNK / CS_GRP;
    if (wave >= 4) {
        const int lt = tid - 256;
        u32x4v rg[4][CS_GRP][3]; u32x2v vg[4][CS_GRP];
#define CS_LD(g_, S_) do { _Pragma("unroll") for (int k = 0; k < CS_GRP; ++k) { const int c_ = CS_GRP * (g_) + k; const unsigned char* rec_ = cs_rec(R, bh * CS_NCHUNK + c_); \
            _Pragma("unroll") for (int i = 0; i < 3; ++i) rg[S_][k][i] = *(const u32x4v*)(rec_ + (lt + 256 * i) * 16); \
            vg[S_][k] = *(const u32x2v*)(A.v + (rowbase + (size_t)c_ * 16 + (lt >> 4)) * 512 + h * 64 + 4 * (lt & 15)); } } while (0)
#define CS_ST(S_) do { _Pragma("unroll") for (int k = 0; k < CS_GRP; ++k) { LAS3 unsigned char* sl_ = lds + ((S_) * CS_GRP + k) * SL_BYTES; \
            _Pragma("unroll") for (int i = 0; i < 3; ++i) *(LAS3 u32x4v*)(sl_ + (lt + 256 * i) * 16) = rg[S_][k][i]; \
            const int s_ = lt >> 4, ch_ = 4 * (lt & 15); \
            *(LAS3 unsigned short*)(sl_ + SL_VT + (ch_ + 0) * CS_TR + 2 * s_) = (unsigned short)(vg[S_][k][0] & 0xffffu); *(LAS3 unsigned short*)(sl_ + SL_VT + (ch_ + 1) * CS_TR + 2 * s_) = (unsigned short)(vg[S_][k][0] >> 16); \
            *(LAS3 unsigned short*)(sl_ + SL_VT + (ch_ + 2) * CS_TR + 2 * s_) = (unsigned short)(vg[S_][k][1] & 0xffffu); *(LAS3 unsigned short*)(sl_ + SL_VT + (ch_ + 3) * CS_TR + 2 * s_) = (unsigned short)(vg[S_][k][1] >> 16); } } while (0)
        CS_LD(0, 0); CS_LD(1, 1); CS_LD(2, 2); CS_LD(3, 3); CS_ST(0); CS_ST(1); CS_LD(4, 0); CS_LD(5, 1);
        __syncthreads();
        for (int g0 = 0; g0 < NROUND; g0 += 4) {
#pragma unroll
            for (int par = 0; par < 4; ++par) {
                const int g = g0 + par;
                if (g + 2 < NROUND) CS_ST((par + 2) & 3);
                if (g + 6 < NROUND) CS_LD(g + 6, (par + 2) & 3);
                __syncthreads();
            }
        }
#undef CS_LD
#undef CS_ST
    } else {
        const int w = wave;
        f32x4c H[4];
#pragma unroll
        for (int tk = 0; tk < 4; ++tk) H[tk] = zero4_opaque();
        const f32x4c Z = zero4_opaque();
        bf16* yp = A.y_raw + (rowbase + 4 * lq) * 512 + h * 64 + 16 * w + li;
        CsOps oa, ob;
        __syncthreads();
        cs_load_ops(oa, lds, w, li, lq);
#pragma unroll 1
        for (int g = 0; g < NROUND; ++g) {
            const LAS3 unsigned char* sl1 = lds + ((g & 3) * CS_GRP + 1) * SL_BYTES;
            const LAS3 unsigned char* sln = lds + (((g + 1) & 3) * CS_GRP) * SL_BYTES;
            __builtin_amdgcn_s_waitcnt(0xC07F);
            cs_load_ops(ob, sl1, w, li, lq);
            cs_chunk(oa, H, Z, yp);
            __builtin_amdgcn_s_waitcnt(0xC07F);
            cs_load_ops(oa, sln, w, li, lq);
            cs_chunk(ob, H, Z, yp + (size_t)16 * 512);
            yp += (size_t)32 * 512;
            __syncthreads();
        }
    }
}
#undef CS_B8

typedef float f32x16v __attribute__((ext_vector_type(16)));
typedef short bf16x8v __attribute__((ext_vector_type(8)));
typedef short bf16x4v __attribute__((ext_vector_type(4)));
constexpr int SB_KSTR = 144, SB_VSTR = 136;
constexpr int SB_KOFF = 0, SB_VOFF = 64 * SB_KSTR, SB_LDS = SB_VOFF + 64 * SB_VSTR;
typedef float f32x2c __attribute__((ext_vector_type(2))); typedef __bf16 bf16x2c __attribute__((ext_vector_type(2)));
__device__ __forceinline__ unsigned cvtpk_c(float lo, float hi) { f32x2c v = {lo, hi}; bf16x2c b = __builtin_convertvector(v, bf16x2c); return __builtin_bit_cast(unsigned, b); }
struct SbArgs { const bf16* proj_sm; const float* qg; const float* kg; bf16* y_b; };

__device__ __forceinline__ void sb_unit(LAS3 unsigned char* lds, const SbArgs& A, int bh, int u) {
    const int tid = opaque_tid(), lane = tid & 63, wave = __builtin_amdgcn_readfirstlane(tid >> 6), r32 = lane & 31, hh = lane >> 5;
    const int b = bh >> 3, h = bh & 7;
    const size_t rowbase = (size_t)b * SEQ;
    const int qrow = 256 * u + 32 * wave + r32;
    bf16x8v qf[4];
    {
        const bf16* qp = A.proj_sm + (rowbase + qrow) * 2048 + h * 64 + 8 * hh;
        u32x4v raw[4]; float x[4][8]; float ss = 0.f;
#pragma unroll
        for (int d0 = 0; d0 < 4; ++d0) { raw[d0] = *(const u32x4v*)(qp + 16 * d0);
#pragma unroll
            for (int j = 0; j < 8; ++j) { const unsigned w = raw[d0][j >> 1]; x[d0][j] = (j & 1) ? __uint_as_float(w & 0xffff0000u) : __uint_as_float(w << 16); ss += x[d0][j] * x[d0][j]; } }
        { auto rr = __builtin_amdgcn_permlane32_swap(__float_as_uint(ss), __float_as_uint(ss), false, false); ss = __uint_as_float(rr[0]) + __uint_as_float(rr[1]); }
        const float sc = rsqrtf(ss * (1.f / 64.f) + NORM_EPS) * (0.125f * 1.4426950408889634f);
#pragma unroll
        for (int d0 = 0; d0 < 4; ++d0) { const f32x4v g0 = *(const f32x4v*)(A.qg + 16 * d0 + 8 * hh), g1 = *(const f32x4v*)(A.qg + 16 * d0 + 8 * hh + 4);
            u32x4v w; w[0] = cvtpk_c(x[d0][0] * sc * g0[0], x[d0][1] * sc * g0[1]); w[1] = cvtpk_c(x[d0][2] * sc * g0[2], x[d0][3] * sc * g0[3]);
            w[2] = cvtpk_c(x[d0][4] * sc * g1[0], x[d0][5] * sc * g1[1]); w[3] = cvtpk_c(x[d0][6] * sc * g1[2], x[d0][7] * sc * g1[3]);
            qf[d0] = __builtin_bit_cast(bf16x8v, w); }
    }
    const int skv = tid >> 3, sc8 = tid & 7;
    const f32x4v kg0 = *(const f32x4v*)(A.kg + 8 * sc8), kg1 = *(const f32x4v*)(A.kg + 8 * sc8 + 4);
    u32x4v gK, gV;
    auto stage_load = [&](int kt) { const bf16* kp = A.proj_sm + (rowbase + kt * 64 + skv) * 2048 + 512 + h * 64 + 8 * sc8; gK = *(const u32x4v*)kp; gV = *(const u32x4v*)(kp + 512); };
    auto stage_store = [&]() {
        float x[8]; float ss = 0.f;
#pragma unroll
        for (int j = 0; j < 8; ++j) { const unsigned w = gK[j >> 1]; x[j] = (j & 1) ? __uint_as_float(w & 0xffff0000u) : __uint_as_float(w << 16); ss += x[j] * x[j]; }
        ss += shfl_xor_t(ss, 1); ss += shfl_xor_t(ss, 2); ss += shfl_xor_t(ss, 4);
        const float sc = rsqrtf(ss * (1.f / 64.f) + NORM_EPS);
        u32x4v w; w[0] = cvtpk_c(x[0] * sc * kg0[0], x[1] * sc * kg0[1]); w[1] = cvtpk_c(x[2] * sc * kg0[2], x[3] * sc * kg0[3]);
        w[2] = cvtpk_c(x[4] * sc * kg1[0], x[5] * sc * kg1[1]); w[3] = cvtpk_c(x[6] * sc * kg1[2], x[7] * sc * kg1[3]);
        *(LAS3 u32x4v*)(lds + SB_KOFF + skv * SB_KSTR + 16 * sc8) = w;
#pragma unroll
        for (int j = 0; j < 8; ++j) { const unsigned wv = gV[j >> 1]; const unsigned short e = (j & 1) ? (unsigned short)(wv >> 16) : (unsigned short)(wv & 0xffffu);
            *(LAS3 unsigned short*)(lds + SB_VOFF + (8 * sc8 + j) * SB_VSTR + 2 * skv) = e; }
    };
    f32x16v o0, o1;
#pragma unroll
    for (int i = 0; i < 16; ++i) { o0[i] = 0.f; o1[i] = 0.f; }
    float R = 1.f;
    const int kt0 = 4 * u + 3;
    const int qmin = 256 * u + 32 * wave;
    stage_load(kt0);
    for (int kt = kt0; kt >= 0; --kt) {
        const bool mine = __all(R == 0.f);
        {
            LAS3 unsigned* flagw = (LAS3 unsigned*)(lds + SB_LDS);
            if (tid == 0) flagw[0] = 0u;
            __syncthreads();
            if (!mine && lane == 0) flagw[0] = 1u;
            __syncthreads();
            if (flagw[0] == 0u) break;
        }
        stage_store();
        if (kt > 0) stage_load(kt - 1);
        __syncthreads();
        if (kt * 64 <= qmin + 31 && !mine) {
        f32x16v p0, p1;
        {
            const int kb0 = kt * 64 + 4 * hh;
#pragma unroll
            for (int r = 0; r < 16; ++r) { const int kv = kb0 + (r & 3) + 8 * (r >> 2); p0[r] = (kv >= qrow) ? -1e30f : 0.f; p1[r] = (kv + 32 >= qrow) ? -1e30f : 0.f; }
        }
        asm volatile("" : "+v"(p0), "+v"(p1));
        const LAS3 unsigned char* kb = lds + SB_KOFF + r32 * SB_KSTR + 16 * hh;
        const LAS3 unsigned char* vb = lds + SB_VOFF + r32 * SB_VSTR + 8 * hh;
        {
            bf16x8v kf0[4], kf1[4];
#pragma unroll
            for (int d0 = 0; d0 < 4; ++d0) { kf0[d0] = *(const LAS3 bf16x8v*)(kb + 32 * d0); kf1[d0] = *(const LAS3 bf16x8v*)(kb + 32 * SB_KSTR + 32 * d0); }
            asm volatile("" ::: "memory");
#pragma unroll
            for (int d0 = 0; d0 < 4; ++d0) {
                p0 = __builtin_amdgcn_mfma_f32_32x32x16_bf16(kf0[d0], qf[d0], p0, 0, 0, 0);
                p1 = __builtin_amdgcn_mfma_f32_32x32x16_bf16(kf1[d0], qf[d0], p1, 0, 0, 0);
            }
        }
        bf16x4v va[4][2], vc[4][2];
#pragma unroll
        for (int hs = 0; hs < 4; ++hs) { const int kvo = 2 * (32 * (hs >> 1) + 16 * (hs & 1));
            va[hs][0] = *(const LAS3 bf16x4v*)(vb + kvo); va[hs][1] = *(const LAS3 bf16x4v*)(vb + kvo + 16);
            vc[hs][0] = *(const LAS3 bf16x4v*)(vb + 32 * SB_VSTR + kvo); vc[hs][1] = *(const LAS3 bf16x4v*)(vb + 32 * SB_VSTR + kvo + 16); }
        asm volatile("" ::: "memory");
        float bs[8];
#pragma unroll
        for (int g = 0; g < 8; ++g) {
            float run = 1.f;
#pragma unroll
            for (int i = 3; i >= 0; --i) { const float z = (g < 4) ? p0[4 * g + i] : p1[4 * (g - 4) + i];
                const float rn = run * __builtin_amdgcn_rcpf(1.f + __builtin_amdgcn_exp2f(z));
                if (g < 4) p0[4 * g + i] = run - rn; else p1[4 * (g - 4) + i] = run - rn;
                run = rn; }
            bs[g] = run;
        }
        float T = 1.f, off[8];
#pragma unroll
        for (int g = 7; g >= 0; --g) {
            auto rr = __builtin_amdgcn_permlane32_swap(__float_as_uint(bs[g]), __float_as_uint(bs[g]), false, false);
            const float bE = __uint_as_float(rr[0]), bO = __uint_as_float(rr[1]);
            off[g] = R * T * (hh ? 1.f : bO);
            T *= bE * bO;
        }
#pragma unroll
        for (int g = 0; g < 8; ++g)
#pragma unroll
            for (int i = 0; i < 4; ++i) { if (g < 4) p0[4 * g + i] *= off[g]; else p1[4 * (g - 4) + i] *= off[g]; }
        R *= T;
#pragma unroll
        for (int half = 0; half < 2; ++half)
#pragma unroll
            for (int s2 = 0; s2 < 2; ++s2) {
                u32x4v pw;
#pragma unroll
                for (int j = 0; j < 4; ++j) { const float x0 = half ? p1[8 * s2 + 2 * j] : p0[8 * s2 + 2 * j], x1 = half ? p1[8 * s2 + 2 * j + 1] : p0[8 * s2 + 2 * j + 1]; pw[j] = cvtpk_c(x0, x1); }
                const bf16x8v pa = __builtin_bit_cast(bf16x8v, pw);
                const bf16x4v a0 = va[2 * half + s2][0], a1 = va[2 * half + s2][1], c0 = vc[2 * half + s2][0], c1 = vc[2 * half + s2][1];
                const bf16x8v vf0 = (bf16x8v){a0[0], a0[1], a0[2], a0[3], a1[0], a1[1], a1[2], a1[3]};
                const bf16x8v vf1 = (bf16x8v){c0[0], c0[1], c0[2], c0[3], c1[0], c1[1], c1[2], c1[3]};
                o0 = __builtin_amdgcn_mfma_f32_32x32x16_bf16(pa, vf0, o0, 0, 0, 0);
                o1 = __builtin_amdgcn_mfma_f32_32x32x16_bf16(pa, vf1, o1, 0, 0, 0);
            }
        }
    }
    bf16* op = A.y_b + (rowbase + 256 * u + 32 * wave) * 512 + h * 64 + r32;
#pragma unroll
    for (int r = 0; r < 16; ++r) { const int qq = (r & 3) + 8 * (r >> 2) + 4 * hh; op[(size_t)qq * 512] = f2bf(o0[r]); op[(size_t)qq * 512 + 32] = f2bf(o1[r]); }
}

__device__ __forceinline__ void wt_item(const float* __restrict__ src, int ldsrc, const float* __restrict__ scale, bf16* __restrict__ dst, int lddst, int koff, int N, int mode, LAS3 float* scr, int item, int lane) {
    const int nblk = N / 32, kb = item / nblk, nb = item % nblk, k0 = 64 * kb, n0 = 32 * nb;
    int sc0 = n0;
    if (mode == 1) { const int pn = n0 >> 8, j0 = n0 & 255; sc0 = (j0 < 128) ? (128 * pn + j0) : (DFF + 128 * pn + (j0 - 128)); }
    {
        const float* sp = src + (size_t)(k0 + (lane >> 5)) * ldsrc + sc0 + (lane & 31);
#pragma unroll
        for (int i0 = 0; i0 < 32; i0 += 8) { float v[8], sv[8];
#pragma unroll
            for (int i = 0; i < 8; ++i) { v[i] = sp[(size_t)(2 * (i0 + i)) * ldsrc]; sv[i] = scale ? scale[k0 + 2 * (i0 + i) + (lane >> 5)] : 1.f; }
            asm volatile("" ::: "memory");
#pragma unroll
            for (int i = 0; i < 8; ++i) scr[(2 * (i0 + i) + (lane >> 5)) * 33 + (lane & 31)] = v[i] * sv[i]; }
    }
    asm volatile("s_waitcnt lgkmcnt(0)" ::: "memory");
    const int c = lane & 7;
#pragma unroll
    for (int j = 0; j < 4; ++j) { const int n = (lane >> 3) + 8 * j; const LAS3 float* s = scr + (8 * c) * 33 + n;
        pg8::u32x4 o; o.x = pg8::cvt_pk_bf16(s[0 * 33], s[1 * 33]); o.y = pg8::cvt_pk_bf16(s[2 * 33], s[3 * 33]); o.z = pg8::cvt_pk_bf16(s[4 * 33], s[5 * 33]); o.w = pg8::cvt_pk_bf16(s[6 * 33], s[7 * 33]);
        *(pg8::u32x4*)(dst + (size_t)(n0 + n) * lddst + koff + k0 + 8 * c) = o; }
    asm volatile("s_waitcnt lgkmcnt(0)" ::: "memory");
}
__device__ __forceinline__ void wt_job(const float* src, const float* scale, bf16* dst, int ldsrc, int lddst, int koff, int K, int N, int mode, LAS3 float* scr, int gw, int NGW, int lane, int rot) {
    const int ni = (K / 64) * (N / 32);
    int first = gw - (rot % NGW); if (first < 0) first += NGW;
    for (int it = first; it < ni; it += NGW) wt_item(src, ldsrc, scale, dst, lddst, koff, N, mode, scr, it, lane);
}
__device__ __forceinline__ void x_to_xb_rows(const float* __restrict__ x, bf16* __restrict__ xb, float* __restrict__ ssq, int rows, int gw, int NGW, int lane) {
    for (int row0 = gw; row0 < rows; row0 += 2 * NGW) {
        float4 v[2][4];
#pragma unroll
        for (int b = 0; b < 2; ++b) { const int row = (row0 + b * NGW < rows) ? row0 + b * NGW : row0;
#pragma unroll
            for (int q = 0; q < 4; ++q) v[b][q] = *(const float4*)(x + (size_t)row * D + q * 256 + lane * 4); }
        asm volatile("" ::: "memory");
#pragma unroll
        for (int b = 0; b < 2; ++b) { const int row = row0 + b * NGW;
            if (row < rows) {
#pragma unroll
                for (int q = 0; q < 4; ++q) { const float4 w = v[b][q];
                    float s = (w.x * w.x + w.y * w.y) + (w.z * w.z + w.w * w.w);
                    s += shfl_xor_t(s, 1); s += shfl_xor_t(s, 2); s += shfl_xor_t(s, 4); s += shfl_xor_t(s, 8);
                    if ((lane & 15) == 0) ssq[(size_t)row * 16 + q * 4 + (lane >> 4)] = s;
                    pg8::u32x2 o; o.x = pg8::cvt_pk_bf16(w.x, w.y); o.y = pg8::cvt_pk_bf16(w.z, w.w);
                    *(pg8::u32x2*)(xb + (size_t)row * D + q * 256 + lane * 4) = o; } } }
    }
}
__device__ __forceinline__ void memk_norm_rows(bf16* __restrict__ kv, const float* __restrict__ kg, int gw, int NGW, int lane) {
    for (int it = gw; it < MEM_ROWS * 4; it += NGW) {
        bf16* p = kv + (size_t)(it >> 2) * 1024 + (it & 3) * 128 + lane * 2;
        const unsigned w = *(const unsigned*)p; const float a = __uint_as_float(w << 16), b = __uint_as_float(w & 0xffff0000u);
        const float ss = wave_sum(a * a + b * b), rs = rsqrtf(ss * (1.f / 128.f) + NORM_EPS);
        *(unsigned*)p = pg8::cvt_pk_bf16(a * rs * kg[lane * 2], b * rs * kg[lane * 2 + 1]);
    }
}
struct ShiftArgs { const bf16* proj_r; const float* mu; const float* k_k; bf16* r_s; bf16* k_s; bf16* v_s; bf16* lora_in; float* nrm; };
__device__ __forceinline__ float tanh_fast(float x) { const float e = __expf(-2.f * fabsf(x)); const float t = (1.f - e) * __builtin_amdgcn_rcpf(1.f + e); return x < 0.f ? -t : t; }
__device__ __forceinline__ void shift_rows(const ShiftArgs& A, int gw_, int NGW_) {
    const int lane = opaque_tid() & 63;
    f32x4v mu[7];
#pragma unroll
    for (int i = 0; i < 7; ++i) mu[i] = *(const f32x4v*)(A.mu + 4 * (lane + 64 * i));
    const f32x4v kk0 = *(const f32x4v*)(A.k_k + 4 * lane), kk1 = *(const f32x4v*)(A.k_k + 256 + 4 * lane);
    for (int row = gw_; row < M; row += NGW_) {
        const bool has_prev = (row % SEQ) != 0;
        const bf16* cur = A.proj_r + (size_t)row * RWKV_COLS + 4 * lane;
        u32x2v c[7], pv[7];
#pragma unroll
        for (int i = 0; i < 7; ++i) { c[i] = *(const u32x2v*)(cur + 256 * i); pv[i] = has_prev ? *(const u32x2v*)(cur + 256 * i - RWKV_COLS) : (u32x2v){0u, 0u}; }
        float ssq_[2]; f32x4v xr[2];
#pragma unroll
        for (int i = 0; i < 7; ++i) {
            f32x4v x;
            { const float c0 = __uint_as_float(c[i][0] << 16), c1 = __uint_as_float(c[i][0] & 0xffff0000u), c2 = __uint_as_float(c[i][1] << 16), c3 = __uint_as_float(c[i][1] & 0xffff0000u);
              const float p0 = __uint_as_float(pv[i][0] << 16), p1 = __uint_as_float(pv[i][0] & 0xffff0000u), p2 = __uint_as_float(pv[i][1] << 16), p3 = __uint_as_float(pv[i][1] & 0xffff0000u);
              x[0] = c0 + (p0 - c0) * mu[i][0]; x[1] = c1 + (p1 - c1) * mu[i][1]; x[2] = c2 + (p2 - c2) * mu[i][2]; x[3] = c3 + (p3 - c3) * mu[i][3]; }
            if (i == 2 || i == 3) { const f32x4v kk = (i == 2) ? kk0 : kk1; float q = 0.f;
#pragma unroll
                for (int e = 0; e < 4; ++e) { const float t = x[e] * kk[e]; q += t * t; }
                q += shfl_xor_t(q, 1); q += shfl_xor_t(q, 2); q += shfl_xor_t(q, 4); q += shfl_xor_t(q, 8); ssq_[i - 2] = q; }
            if (i == 6) {
                if (lane < 16) {
#pragma unroll
                    for (int e = 0; e < 4; ++e) x[e] = tanh_fast(x[e]);
                } else if (lane >= 32) {
#pragma unroll
                    for (int e = 0; e < 4; ++e) x[e] = sigmoidf_(x[e]);
                }
            }
            if (i < 2) xr[i] = x;
            else if (i < 4) {
                const f32x4v r_ = xr[i - 2]; u32x4v w4 = {pg8::cvt_pk_bf16(r_[0], x[0]), pg8::cvt_pk_bf16(r_[1], x[1]), pg8::cvt_pk_bf16(r_[2], x[2]), pg8::cvt_pk_bf16(r_[3], x[3])};
                *(u32x4v*)((unsigned*)A.r_s + (size_t)row * 512 + 256 * (i - 2) + 4 * lane) = w4;
            } else {
                u32x2v w; w[0] = pg8::cvt_pk_bf16(x[0], x[1]); w[1] = pg8::cvt_pk_bf16(x[2], x[3]);
                bf16* dst = (i < 6) ? A.v_s + (size_t)row * 512 + 256 * (i - 4) : A.lora_in + (size_t)row * 256;
                *(u32x2v*)(dst + 4 * lane) = w; }
        }
        if ((lane & 15) == 0) { A.nrm[(size_t)row * 8 + (lane >> 4)] = 1.f / fmaxf(sqrtf(ssq_[0]), 1e-12f); A.nrm[(size_t)row * 8 + 4 + (lane >> 4)] = 1.f / fmaxf(sqrtf(ssq_[1]), 1e-12f); }
    }
}
struct PostArgs { const bf16* y_raw; const bf16* v; const bf16* g; const float* bonus; const float* lnx_g; const float* lnx_b; bf16* y_a; };
__device__ __forceinline__ void unpack8(float (&o)[8], const u32x4v& w) {
#pragma unroll
    for (int j = 0; j < 4; ++j) { o[2 * j] = __uint_as_float(w[j] << 16); o[2 * j + 1] = __uint_as_float(w[j] & 0xffff0000u); } }
__device__ __forceinline__ float sum8lanes(float v) { v += shfl_xor_t(v, 1); v += shfl_xor_t(v, 2); v += shfl_xor_t(v, 4); return v; }
__device__ __forceinline__ void post_rows(const PostArgs& A, int gw_, int NGW_) {
    const int lane = opaque_tid() & 63, col = 8 * lane;
    float lg[8], lb[8];
#pragma unroll
    for (int e = 0; e < 8; ++e) { lg[e] = A.lnx_g[col + e]; lb[e] = A.lnx_b[col + e]; }
    for (int row = gw_; row < M; row += NGW_) {
        const size_t idx = (size_t)row * 512 + col;
        const u32x4v wy = *(const u32x4v*)(A.y_raw + idx), wv = *(const u32x4v*)(A.v + idx), wg = *(const u32x4v*)(A.g + idx);
        const float bonus = A.bonus[(size_t)row * 8 + (lane >> 3)];
        float y[8], v[8], g[8];
        unpack8(y, wy); unpack8(v, wv); unpack8(g, wg);
        float s = 0.f;
#pragma unroll
        for (int e = 0; e < 8; ++e) s += y[e];
        const float mean = sum8lanes(s) * (1.f / 64.f);
        float q = 0.f;
#pragma unroll
        for (int e = 0; e < 8; ++e) { y[e] -= mean; q += y[e] * y[e]; }
        const float rstd = rsqrtf(sum8lanes(q) * (1.f / 64.f) + LNX_EPS);
        u32x4v w;
#pragma unroll
        for (int j = 0; j < 4; ++j) { const float o0 = (y[2 * j] * rstd * lg[2 * j] + lb[2 * j] + bonus * v[2 * j]) * g[2 * j], o1 = (y[2 * j + 1] * rstd * lg[2 * j + 1] + lb[2 * j + 1] + bonus * v[2 * j + 1]) * g[2 * j + 1];
            w[j] = pg8::cvt_pk_bf16(o0, o1); }
        *(u32x4v*)(A.y_a + idx) = w;
    }
}
struct MemArgs { const bf16* proj_sm; const bf16* kv; const float* qg; bf16* y_m; };

constexpr int MA_KSTR = 272, MA_VSTR = 520;
constexpr int MA_KOFF = 0, MA_VOFF = 256 * MA_KSTR, MA_LDS = MA_VOFF + 128 * MA_VSTR;
__device__ __forceinline__ void mem_unit(LAS3 unsigned char* lds, const MemArgs& A, int b, int h, int u) {
    const int tid = opaque_tid(), lane = tid & 63, wave = __builtin_amdgcn_readfirstlane(tid >> 6), r32 = lane & 31, hh = lane >> 5;
    {
        const bf16* kvb = A.kv + (size_t)(b * MEM_LEN) * 1024 + h * 128;
#pragma unroll
        for (int i = 0; i < 8; ++i) { const int c = tid + 512 * i, row = c >> 4, c16 = c & 15;
            const u32x4v kw = *(const u32x4v*)(kvb + (size_t)row * 1024 + 8 * c16), vw = *(const u32x4v*)(kvb + (size_t)row * 1024 + 512 + 8 * c16);
            *(LAS3 u32x4v*)(lds + MA_KOFF + row * MA_KSTR + 16 * c16) = kw;
#pragma unroll
            for (int j = 0; j < 8; ++j) { const unsigned wv = vw[j >> 1]; const unsigned short e = (j & 1) ? (unsigned short)(wv >> 16) : (unsigned short)(wv & 0xffffu);
                *(LAS3 unsigned short*)(lds + MA_VOFF + (8 * c16 + j) * MA_VSTR + 2 * row) = e; } }
    }
    const size_t qrow = (size_t)b * SEQ + 256 * u + 32 * wave + r32;
    bf16x8v qf[8];
    {
        const bf16* qp = A.proj_sm + qrow * 2048 + 1536 + h * 128 + 8 * hh;
        u32x4v raw[8]; float ss = 0.f;
#pragma unroll
        for (int d0 = 0; d0 < 8; ++d0) { raw[d0] = *(const u32x4v*)(qp + 16 * d0);
#pragma unroll
            for (int j = 0; j < 4; ++j) { const float lo = __uint_as_float(raw[d0][j] << 16), hi = __uint_as_float(raw[d0][j] & 0xffff0000u); ss += lo * lo + hi * hi; } }
        { auto rr = __builtin_amdgcn_permlane32_swap(__float_as_uint(ss), __float_as_uint(ss), false, false); ss = __uint_as_float(rr[0]) + __uint_as_float(rr[1]); }
        const float sc = rsqrtf(ss * (1.f / 128.f) + NORM_EPS) * (0.08838834764831845f * 1.4426950408889634f);
#pragma unroll
        for (int d0 = 0; d0 < 8; ++d0) { const f32x4v g0 = *(const f32x4v*)(A.qg + 16 * d0 + 8 * hh), g1 = *(const f32x4v*)(A.qg + 16 * d0 + 8 * hh + 4);
            u32x4v w;
#pragma unroll
            for (int j = 0; j < 4; ++j) { const float lo = __uint_as_float(raw[d0][j] << 16), hi = __uint_as_float(raw[d0][j] & 0xffff0000u);
                const float gl = (j < 2) ? g0[2 * j] : g1[2 * j - 4], gh = (j < 2) ? g0[2 * j + 1] : g1[2 * j - 3]; w[j] = cvtpk_c(lo * sc * gl, hi * sc * gh); }
            qf[d0] = __builtin_bit_cast(bf16x8v, w); }
    }
    __syncthreads();
    f32x16v p[8];
#pragma unroll
    for (int t = 0; t < 8; ++t) {
#pragma unroll
        for (int i = 0; i < 16; ++i) p[t][i] = 0.f;
        asm volatile("" : "+v"(p[t]));
        const LAS3 unsigned char* kb = lds + MA_KOFF + (32 * t + r32) * MA_KSTR + 16 * hh;
#pragma unroll
        for (int d0 = 0; d0 < 8; ++d0) { const bf16x8v kf = *(const LAS3 bf16x8v*)(kb + 32 * d0); p[t] = __builtin_amdgcn_mfma_f32_32x32x16_bf16(kf, qf[d0], p[t], 0, 0, 0); }
    }
    float mx = -1e30f;
#pragma unroll
    for (int t = 0; t < 8; ++t)
#pragma unroll
        for (int i = 0; i < 16; ++i) mx = fmaxf(mx, p[t][i]);
    { auto rr = __builtin_amdgcn_permlane32_swap(__float_as_uint(mx), __float_as_uint(mx), false, false); mx = fmaxf(__uint_as_float(rr[0]), __uint_as_float(rr[1])); }
    float sm = 0.f;
#pragma unroll
    for (int t = 0; t < 8; ++t)
#pragma unroll
        for (int i = 0; i < 16; ++i) { const float e = __builtin_amdgcn_exp2f(p[t][i] - mx); p[t][i] = e; sm += e; }
    { auto rr = __builtin_amdgcn_permlane32_swap(__float_as_uint(sm), __float_as_uint(sm), false, false); sm = __uint_as_float(rr[0]) + __uint_as_float(rr[1]); }
    const float inv = 1.f / sm;
    f32x16v o[4];
#pragma unroll
    for (int db = 0; db < 4; ++db) {
#pragma unroll
        for (int i = 0; i < 16; ++i) o[db][i] = 0.f;
        asm volatile("" : "+v"(o[db])); }
    const LAS3 unsigned char* vb = lds + MA_VOFF + r32 * MA_VSTR + 8 * hh;
#pragma unroll
    for (int t = 0; t < 8; ++t)
#pragma unroll
        for (int s2 = 0; s2 < 2; ++s2) {
            u32x4v pw;
#pragma unroll
            for (int j = 0; j < 4; ++j) pw[j] = cvtpk_c(p[t][8 * s2 + 2 * j] * inv, p[t][8 * s2 + 2 * j + 1] * inv);
            const bf16x8v pa = __builtin_bit_cast(bf16x8v, pw);
            const int kvo = 2 * (32 * t + 16 * s2);
#pragma unroll
            for (int db = 0; db < 4; ++db) {
                const bf16x4v a0 = *(const LAS3 bf16x4v*)(vb + 32 * db * MA_VSTR + kvo), a1 = *(const LAS3 bf16x4v*)(vb + 32 * db * MA_VSTR + kvo + 16);
                const bf16x8v vf = (bf16x8v){a0[0], a0[1], a0[2], a0[3], a1[0], a1[1], a1[2], a1[3]};
                o[db] = __builtin_amdgcn_mfma_f32_32x32x16_bf16(pa, vf, o[db], 0, 0, 0);
            }
        }
    bf16* op = A.y_m + ((size_t)b * SEQ + 256 * u + 32 * wave) * 512 + h * 128 + r32;
#pragma unroll
    for (int r = 0; r < 16; ++r) { const int qq = (r & 3) + 8 * (r >> 2) + 4 * hh;
#pragma unroll
        for (int db = 0; db < 4; ++db) op[(size_t)qq * 512 + 32 * db] = f2bf(o[db][r]); }
}

__device__ __forceinline__ void ffn_fixup_chunks(const float* __restrict__ side, const float* __restrict__ cw, const float* __restrict__ cb, bf16* __restrict__ u, int vb, int G) {
    const int tidf = opaque_tid();
    for (int cid = vb; cid < M / 64; cid += G) {
        const bool first = ((cid * 64) % SEQ) == 0;
        for (int idx = tidf; idx < 2 * DFF; idx += 512) {
            const int rr = idx / DFF, ch = idx % DFF;
            float Gv = cb[ch], V = cb[DFF + ch];
#pragma unroll
            for (int i = 0; i < 3; ++i) {
                const int dt = 2 - i, q = rr - dt;
                float hg = 0.f, hv = 0.f;
                if (q >= 0) { const float* sp = side + (((size_t)cid * 4 + q) * 2) * DFF + ch; hg = sp[0]; hv = sp[DFF]; }
                else if (!first) { const float* sp = side + (((size_t)(cid - 1) * 4 + (4 + q)) * 2) * DFF + ch; hg = sp[0]; hv = sp[DFF]; }
                Gv += cw[i * DFF2 + ch] * hg; V += cw[i * DFF2 + DFF + ch] * hv;
            }
            u[(size_t)(cid * 64 + rr) * DFF + ch] = f2bf(Gv * sigmoidf_(Gv) * V);
        }
    }
}


#define XB_TMO      128
#define XB_XCNT(j)  (256  + 64 * (j))
#define XB_XSUB(j)  (1280 + 64 * (j))
#define XB_XGEN(j)  (2304 + 64 * (j))
#define XB_TOP      3328
#define XB_TOPGEN   3392
#define XCD_BAR_WORDS 3456
#define XB_SPIN_CAP (1u << 22)
__device__ __forceinline__ unsigned xb_ld(unsigned* p)              { return __hip_atomic_load(p, __ATOMIC_RELAXED, __HIP_MEMORY_SCOPE_AGENT); }
__device__ __forceinline__ unsigned xb_add(unsigned* p, unsigned v) { return __hip_atomic_fetch_add(p, v, __ATOMIC_RELAXED, __HIP_MEMORY_SCOPE_AGENT); }
__device__ __forceinline__ unsigned xb_xcc_id() { return (unsigned)__builtin_amdgcn_s_getreg((3 << 11) | 20) & 0xFu; }
#define XB_SPIN(cond, bar) do { unsigned _sp = 0; while (cond) { __builtin_amdgcn_s_sleep(1); \
    if ((++_sp & 255u) == 0u) { if (xb_ld(&(bar)[XB_TMO])) break; if (_sp > XB_SPIN_CAP) { atomicAdd(&(bar)[XB_TMO], 1u); break; } } } } while (0)
struct XcdBarrier { unsigned* bar; unsigned x; volatile LAS3 unsigned* st; };
__device__ __forceinline__ XcdBarrier xcd_barrier_post(unsigned* bar, volatile LAS3 unsigned* st) {
    XcdBarrier b; b.bar = bar; b.x = xb_xcc_id(); b.st = st;
    if (threadIdx.x == 0) (void)xb_add(&bar[XB_XCNT(b.x)], 1u);
    return b;
}
__device__ __forceinline__ void xcd_barrier_complete(unsigned* bar, unsigned x, unsigned& nloc, unsigned& nx) {
    const unsigned G = gridDim.x * gridDim.y * gridDim.z;
    unsigned sum, cnt, mine, sp = 0u;
    for (;;) {
        sum = 0u; cnt = 0u; mine = 0u;
#pragma unroll
        for (unsigned j = 0; j < 16; ++j) { const unsigned c = xb_ld(&bar[XB_XCNT(j)]); sum += c; cnt += (c > 0u) ? 1u : 0u; mine = (j == x) ? c : mine; }
        if (sum == G) break;
        __builtin_amdgcn_s_sleep(1);
        if ((++sp & 255u) == 0u) { if (xb_ld(&bar[XB_TMO])) break; if (sp > XB_SPIN_CAP) { atomicAdd(&bar[XB_TMO], 1u); break; } }
    }
    nloc = mine > 0u ? mine : 1u; nx = cnt > 0u ? cnt : 1u;
}
__device__ __forceinline__ void xcd_barrier(const XcdBarrier& b) {
    asm volatile("s_waitcnt vmcnt(0)" ::: "memory");
    __syncthreads();
    if (threadIdx.x == 0) {
        unsigned* bar = b.bar;
        __builtin_amdgcn_s_waitcnt(0);
        unsigned nloc = b.st[0], nx = b.st[1];
        if (nloc == 0u) { xcd_barrier_complete(bar, b.x, nloc, nx); b.st[0] = nloc; b.st[1] = nx; }
        const unsigned old = xb_add(&bar[XB_XSUB(b.x)], 1u);
        const unsigned gen = old / nloc;
        if (old + 1u == (gen + 1u) * nloc) {
            __builtin_amdgcn_fence(__ATOMIC_RELEASE, "agent");
            asm volatile("s_waitcnt vmcnt(0)" ::: "memory");
            const unsigned og = xb_add(&bar[XB_TOP], 1u);
            const unsigned target = (og / nx + 1u) * nx;
            if (og + 1u != target) XB_SPIN(xb_ld(&bar[XB_TOP]) < target, bar);
            __builtin_amdgcn_fence(__ATOMIC_ACQUIRE, "agent");
            asm volatile("s_waitcnt vmcnt(0)" ::: "memory");
            xb_add(&bar[XB_XGEN(b.x)], 1u);
            asm volatile("s_waitcnt vmcnt(0)" ::: "memory");
        } else {
            XB_SPIN(xb_ld(&bar[XB_XGEN(b.x)]) == gen, bar);
            asm volatile("buffer_inv sc0\n\ts_waitcnt vmcnt(0)" ::: "memory");
        }
    }
    __syncthreads();
}

constexpr int MEGA_LDS = 147456;
struct Params { const float* in[31]; float* out; unsigned char* wsp; int ph_lo, ph_hi; };
enum { PH_P0 = 0, PH_GEMMA, PH_SHIFT, PH_LORA, PH_VRES2, PH_SCAN, PH_SCAN2, PH_POST, PH_GEMMB, PH_ATTN, PH_GEMMC, PH_BRANCH, PH_WOUT, PH_UP, PH_FIX, PH_DOWN, PH_NCODES };
struct PhaseDesc { int code, layer; };
__device__ __constant__ const int kPhaseCode[28] = { PH_P0,
    PH_GEMMA, PH_SHIFT, PH_LORA, PH_SCAN, PH_SCAN2, PH_GEMMB, PH_ATTN, PH_GEMMC, PH_BRANCH, PH_WOUT, PH_UP, PH_FIX, PH_DOWN,
    PH_GEMMA, PH_SHIFT, PH_LORA, PH_VRES2, PH_SCAN, PH_SCAN2, PH_GEMMB, PH_ATTN, PH_GEMMC, PH_BRANCH, PH_WOUT, PH_UP, PH_FIX, PH_DOWN };
constexpr int N_PHASES = 28, L1_FIRST = 14;

#define WTJ(src, scale, dst, ldsrc, lddst, koff, K, N, mode) do { wt_job(src, scale, dst, ldsrc, lddst, koff, K, N, mode, (LAS3 float*)(lds + wave * 16384), vb * 8 + wave, G * 8, lane, rot_); rot_ += ((K) / 64) * ((N) / 32); } while (0)
#define WTJI(src, scale, dst, ldsrc, lddst, koff, K, N, mode) do { wt_job(src, scale, dst, ldsrc, lddst, koff, K, N, mode, (LAS3 float*)(lds + wave * 16384), (vb - 64) * 8 + wave, 192 * 8, lane, rot_); rot_ += ((K) / 64) * ((N) / 32); } while (0)
#define WTJX(b0, nb, src, scale, dst, ldsrc, lddst, koff, K, N, mode) do { wt_job(src, scale, dst, ldsrc, lddst, koff, K, N, mode, (LAS3 float*)(lds + wave * 16384), (vb - (b0)) * 8 + wave, (nb) * 8, lane, rot_); rot_ += ((K) / 64) * ((N) / 32); } while (0)
#define P_PROJ_R ((bf16*)(ws + RS(0)))
#define P_R_S ((bf16*)(ws + RS(4)))
#define P_BONUS ((float*)(ws))
#define P_K_S ((bf16*)(ws + RS(5)))
#define P_V_S ((l == 0) ? (bf16*)(ws + WS_VFIRST) : (bf16*)(ws + RS(6)))
#define P_LORA_IN ((bf16*)(ws + RS(7)))
#define P_LD ((unsigned short*)(ws + RS(0)))
#define P_A ((bf16*)(ws + RS(1)))
#define P_G ((bf16*)(ws + RS(2)))
#define P_T1 ((bf16*)(ws + RS(3)))
#define P_VP ((bf16*)(ws + RS(8)))
#define P_VUSE ((l == 0) ? (bf16*)(ws + WS_VFIRST) : (bf16*)(ws + RS(8)))
#define P_Y_RAW ((bf16*)(ws + RS(9)))
#define P_Y_A ((bf16*)(ws + RS(0)))
#define P_Y_B ((bf16*)(ws + RS(1)))
#define P_Y_M ((bf16*)(ws + RS(2)))
#define P_PROJ_SM ((bf16*)(ws + RS(3)))
#define P_GATES ((bf16*)(ws + RS(3)))
#define P_MERGED ((bf16*)xout)
#define P_XB2 ((bf16*)(ws + RS(0)))
#define P_U ((bf16*)(ws + RS(2)))
#define P_SIDE ((float*)(ws + RS(2) + 88 * MiB))
#define P_XIN ((l == 0) ? in[0] : (const float*)xout)
#define WinT ((bf16*)(ws + WS_WINT))
#define WupT ((bf16*)(ws + WS_WUPT))
#define WdnT ((bf16*)(ws + WS_WDNT))
#define WbrT ((bf16*)(ws + WS_WBRT))
#define WoutT ((bf16*)(ws + WS_WOUTT))
#define Wlora ((bf16*)(ws + WS_WLORA))
#define V1T ((bf16*)(ws + WS_V1T))
#define V2T ((bf16*)(ws + WS_V2T))
#define xbA ((bf16*)(ws + WS_XBA))
#define kvmem ((bf16*)(ws + WS_KVMEM))
#define ssq ((float*)(ws + WS_SSQ))
#define nrm ((float*)(ws + WS_NRM))
#define ssqm ((float*)(ws + WS_SSQM))
#define memb ((bf16*)(ws + RS(8)))
#define WkvT ((bf16*)(ws + RS(9)))
#define xout (P.out)
#define in (P.in + z0)
#define ws (P.wsp + z0)
#define gw (vb * 8 + wave)
#define lane (opaque_tid() & 63)
#define NGW (G * 8)
__global__ void __launch_bounds__(512, 2) mega(Params P) {
    extern __shared__ __attribute__((aligned(16))) unsigned char lds_dyn[];
    cooperative_groups::grid_group grid = cooperative_groups::this_grid();
    LAS3 unsigned char* lds = (LAS3 unsigned char*)lds_dyn;
    volatile LAS3 unsigned* bst = (volatile LAS3 unsigned*)(lds + MEGA_LDS - 16);
    if (threadIdx.x < 4) bst[threadIdx.x] = 0u;
    __syncthreads();
    (void)xcd_barrier_post((unsigned*)(P.wsp + WS_CTL), bst);
    for (int ph = P.ph_lo; ph < P.ph_hi; ++ph) {
        const int wave = __builtin_amdgcn_readfirstlane(opaque_tid() >> 6);
        int vb = blockIdx.x; asm volatile("" : "+s"(vb));
        int z0 = 0; asm volatile("" : "+s"(z0));
        constexpr int G = 256;
        const int code = kPhaseCode[ph], l = (ph >= L1_FIRST) ? 1 : 0;
#ifdef ONLY_PHASE
        if (code != ONLY_PHASE) continue;
#endif
        switch (code) {
#if !defined(ONLY_PHASE) || ONLY_PHASE == 0
        case PH_P0: {
            int rot_ = 0;
            WTJ(in[3], in[2], WinT, IN_COLS, D, 0, D, RWKV_COLS, 0);
            WTJ(in[6], nullptr, Wlora, 512, 256, 0, 64, 512, 0); WTJ(in[8], nullptr, Wlora + 512 * 256, 512, 256, 64, 64, 512, 0); WTJ(in[9], nullptr, Wlora + 1024 * 256, 512, 256, 128, 128, 512, 0);
            WTJ(in[21], in[20], WkvT, 1024, D, 0, D, 1024, 0); WTJ(in[21] + (size_t)D * 1024, in[20] + D, WkvT + (size_t)1024 * D, 1024, D, 0, D, 1024, 0);
            x_to_xb_rows(in[1], memb, ssqm, MEM_ROWS, gw, NGW, lane);
            x_to_xb_rows(in[0], xbA, ssq, M, gw, NGW, lane);
        } break;
#endif
#if !defined(ONLY_PHASE) || ONLY_PHASE == 1
        case PH_GEMMA: {
            pg8::gemm_phase<pg8::EpiRowScale, true, M, RWKV_COLS, D, D, D / 64>(lds, pg8::Gemm{xbA, xbA, xbA, WinT}, G, vb, pg8::EpiRowScale{P_PROJ_R, ssq, RWKV_COLS, 0});
            if (l == 1 && vb >= 192) {
                __syncthreads();
                int rot_ = 0;
                WTJX(192, 64, in[25] + (size_t)D * D, nullptr, WoutT, D, D, 0, D, D, 0);
            }
            if (l == 0) {
#pragma unroll 1
                for (int ll = 0; ll < 2; ++ll) { const int cc = (vb >= 192 + 32 * ll && vb < 224 + 32 * ll) ? vb - 192 - 32 * ll : -1;
                    pg8::gemm_phase<pg8::EpiRowScale, true, MEM_ROWS, 1024, D, D, D / 64>(lds, pg8::Gemm{memb, memb, memb, WkvT + (size_t)ll * 1024 * D}, 32, cc,
                                                           pg8::EpiRowScale{kvmem + (size_t)ll * MEM_ROWS * 1024, ssqm, 1024, 0}); }
            }
        } break;
#endif
#if !defined(ONLY_PHASE) || ONLY_PHASE == 2
        case PH_SHIFT: {
            shift_rows(ShiftArgs{P_PROJ_R, in[4] + l * RWKV_COLS, in[10] + l * 512, P_R_S, P_K_S, P_V_S, P_LORA_IN, nrm}, gw, NGW);
            if (l == 0) { memk_norm_rows(kvmem, in[23], gw, NGW, lane); memk_norm_rows(kvmem + (size_t)MEM_ROWS * 1024, in[23] + 128, gw, NGW, lane); }
        } break;
#endif
#if !defined(ONLY_PHASE) || ONLY_PHASE == 3
        case PH_LORA: {
            pg8::gemm_phase<pg8::EpiLora, true, M, 1536, 256, 256, 4>(lds, pg8::Gemm{P_LORA_IN, P_LORA_IN, P_LORA_IN, Wlora}, G, vb, pg8::EpiLora{P_LD, in[5] + l * 512, in[7] + l * 512});
            if (l == 0 && vb >= 128) {
                __syncthreads();
                int rot_ = 0;
                WTJX(128, 128, in[24], nullptr, WbrT, D, 1536, 0, 512, D, 0); WTJX(128, 128, in[24] + (size_t)512 * D, nullptr, WbrT, D, 1536, 512, 512, D, 0); WTJX(128, 128, in[24] + (size_t)2 * 512 * D, nullptr, WbrT, D, 1536, 1024, 512, D, 0);
            }
            if (l == 1) {
                pg8::gemm_phase<pg8::EpiRowScale, true, M, 256, 512, 512, 8>(lds, pg8::Gemm{P_V_S, P_V_S, P_V_S, V1T}, G, (vb + 128) % G, pg8::EpiRowScale{P_T1, nullptr, 256, 0}); }
        } break;
#endif
#if !defined(ONLY_PHASE) || ONLY_PHASE == 4
        case PH_VRES2: {
            pg8::gemm_phase<pg8::EpiVres, true, M, 512, 256, 256, 4>(lds, pg8::Gemm{P_T1, P_T1, P_T1, V2T}, G, vb, pg8::EpiVres{P_V_S, ((bf16*)(ws + WS_VFIRST)), in[15], P_VP});
        } break;
#endif
#if !defined(ONLY_PHASE) || ONLY_PHASE == 5
        case PH_SCAN: {
            cscan_produce(lds + wave * PS_BYTES, ScanArgs{P_R_S, P_K_S, P_VUSE, P_A, P_LD, nrm, in[10] + l * 512, in[11] + l * 512, P_Y_RAW, in[12] + l * 512, P_BONUS}, CsRec{(unsigned char*)xout, ws + RS(6), ws + RS(3)}, gw, NGW);
        } break;
#endif
#if !defined(ONLY_PHASE) || ONLY_PHASE == 15
        case PH_SCAN2: {
            if (vb < 64) cscan_consume(lds, ScanArgs{P_R_S, P_K_S, P_VUSE, P_A, P_LD, nrm, in[10] + l * 512, in[11] + l * 512, P_Y_RAW, in[12] + l * 512, P_BONUS}, CsRec{(unsigned char*)xout, ws + RS(6), ws + RS(3)}, vb);
            else {
                int rot_ = 0;
                WTJI(in[27] + (size_t)l * D * DFF2, in[26] + l * D, WupT, DFF2, D, 0, D, DFF2, 1);
                if (l == 0) WTJI(in[25], nullptr, WoutT, D, D, 0, D, D, 0);
                if (l == 0) {
                    WTJI(in[3] + RWKV_COLS, in[2], WinT + (size_t)RWKV_COLS * D, IN_COLS, D, 0, D, IN_COLS - RWKV_COLS, 0);
                    WTJI(in[3] + (size_t)D * IN_COLS, in[2] + D, WinT, IN_COLS, D, 0, D, RWKV_COLS, 0);
                    WTJI(in[6] + 64 * 512, nullptr, Wlora, 512, 256, 0, 64, 512, 0); WTJI(in[8] + 64 * 512, nullptr, Wlora + 512 * 256, 512, 256, 64, 64, 512, 0); WTJI(in[9] + 128 * 512, nullptr, Wlora + 1024 * 256, 512, 256, 128, 128, 512, 0);
                    WTJI(in[16], nullptr, V1T, 32, 512, 0, 512, 32, 0);
                    for (int idx = ((vb - 64) * 8 + wave) * 64 + lane; idx < 512 * 32; idx += 192 * 8 * 64) { const int n = idx >> 5, k = idx & 31; V2T[(size_t)n * 256 + k] = f2bf(in[17][(size_t)k * 512 + n]); }
                } else {
                    WTJI(in[3] + (size_t)D * IN_COLS + RWKV_COLS, in[2] + D, WinT + (size_t)RWKV_COLS * D, IN_COLS, D, 0, D, IN_COLS - RWKV_COLS, 0);
                }
            }
        } break;
#endif
#if !defined(ONLY_PHASE) || ONLY_PHASE == 6
        case PH_POST: {
            post_rows(PostArgs{P_Y_RAW, P_VUSE, P_G, P_BONUS, in[13] + l * 512, in[14] + l * 512, P_Y_A}, gw, NGW);
        } break;
#endif
#if !defined(ONLY_PHASE) || ONLY_PHASE == 7
        case PH_GEMMB: {
            post_rows(PostArgs{P_Y_RAW, P_VUSE, P_G, P_BONUS, in[13] + l * 512, in[14] + l * 512, P_Y_A}, gw, NGW);
            pg8::gemm_phase<pg8::EpiRowScale, true, M, 2048, D, D, D / 64>(lds, pg8::Gemm{xbA, xbA, xbA, WinT + (size_t)RWKV_COLS * D}, G, vb, pg8::EpiRowScale{P_PROJ_SM, ssq, 2048, 0});
        } break;
#endif
#if !defined(ONLY_PHASE) || ONLY_PHASE == 8
        case PH_ATTN: {
            const SbArgs sa{P_PROJ_SM, in[18] + l * 64, in[19] + l * 64, P_Y_B};
            const int bh = vb >> 2, pr = vb & 3;
            sb_unit(lds, sa, bh, 7 - pr);
            __syncthreads();
            sb_unit(lds, sa, bh, pr);
            __syncthreads();
            { const int pair = vb >> 3; mem_unit(lds, MemArgs{P_PROJ_SM, kvmem + (size_t)l * MEM_ROWS * 1024, in[22] + l * 128, P_Y_M}, pair >> 2, pair & 3, vb & 7); }
        } break;
#endif
#if !defined(ONLY_PHASE) || ONLY_PHASE == 9
        case PH_GEMMC: {
            pg8::gemm_phase<pg8::EpiGatesFrag, true, M, 3072, D, D, D / 64>(lds, pg8::Gemm{xbA, xbA, xbA, WinT + (size_t)3840 * D}, G, vb, pg8::EpiGatesFrag{P_GATES, ssq});
        } break;
#endif
#if !defined(ONLY_PHASE) || ONLY_PHASE == 10
        case PH_BRANCH: {
            pg8::gemm_phase<pg8::EpiGated, true, M, D, 1536, 512, 8>(lds, pg8::Gemm{P_Y_A, P_Y_B, P_Y_M, WbrT}, G, vb, pg8::EpiGated{P_GATES, P_MERGED});
        } break;
#endif
#if !defined(ONLY_PHASE) || ONLY_PHASE == 11
        case PH_WOUT: {
            pg8::gemm_phase<pg8::EpiResidual<true, false>, true, M, D, D, D, D / 64>(lds, pg8::Gemm{P_MERGED, P_MERGED, P_MERGED, WoutT}, G, vb, pg8::EpiResidual<true, false>{nullptr, xbA, nullptr, P_XB2, ssq});
        } break;
#endif
#if !defined(ONLY_PHASE) || ONLY_PHASE == 12
        case PH_UP: {
            pg8::gemm_phase<pg8::EpiConv, true, M, DFF2, D, D, D / 64>(lds, pg8::Gemm{P_XB2, P_XB2, P_XB2, WupT}, G, vb, pg8::EpiConv{ssq, in[28] + (size_t)l * 3 * DFF2, in[29] + (size_t)l * DFF2, P_U, P_SIDE});
            if (vb >= 128) {
                __syncthreads();
                int rot_ = 0;
                WTJX(128, 128, in[30] + (size_t)l * DFF * D, nullptr, WdnT, D, DFF, 0, DFF, D, 0);
                if (l == 0) {
                    WTJX(128, 128, in[24] + (size_t)3 * 512 * D, nullptr, WbrT, D, 1536, 0, 512, D, 0); WTJX(128, 128, in[24] + (size_t)4 * 512 * D, nullptr, WbrT, D, 1536, 512, 512, D, 0); WTJX(128, 128, in[24] + (size_t)5 * 512 * D, nullptr, WbrT, D, 1536, 1024, 512, D, 0); }
            }
        } break;
#endif
#if !defined(ONLY_PHASE) || ONLY_PHASE == 13
        case PH_FIX: {
            ffn_fixup_chunks(P_SIDE, in[28] + (size_t)l * 3 * DFF2, in[29] + (size_t)l * DFF2, P_U, vb, G);
        } break;
#endif
#if !defined(ONLY_PHASE) || ONLY_PHASE == 14
        case PH_DOWN: {
            if (l == 0) pg8::gemm_phase<pg8::EpiResidual<true, false>, true, M, D, DFF, DFF, DFF / 64>(lds, pg8::Gemm{P_U, P_U, P_U, WdnT}, G, vb, pg8::EpiResidual<true, false>{nullptr, P_XB2, nullptr, xbA, ssq});
            else        pg8::gemm_phase<pg8::EpiResidual<true, true>, true, M, D, DFF, DFF, DFF / 64>(lds, pg8::Gemm{P_U, P_U, P_U, WdnT}, G, vb, pg8::EpiResidual<true, true>{nullptr, P_XB2, xout, xbA, ssq});
        } break;
#endif
        default: break;
        }
        if (ph + 1 < P.ph_hi) { if (P.ph_hi > N_PHASES) grid.sync(); else { XcdBarrier xb_; xb_.bar = (unsigned*)(ws + WS_CTL); xb_.x = xb_xcc_id(); xb_.st = (volatile LAS3 unsigned*)(lds + MEGA_LDS - 16); xcd_barrier(xb_); } }
    }
}

#undef lane
#undef WinT
#undef WupT
#undef WdnT
#undef WbrT
#undef WoutT
#undef Wlora
#undef V1T
#undef V2T
#undef xbA
#undef kvmem
#undef ssq
#undef nrm
#undef ssqm
#undef memb
#undef WkvT
#undef xout
#undef in
#undef ws
#undef gw
#undef NGW
#ifndef MK_SPLIT
#define MK_SPLIT 0
#endif
extern "C" void kernel_launch(void* const* d_in, const int* in_sizes, int n_in, void* d_out, int out_size, void* d_ws, size_t ws_size, hipStream_t stream) {
    static int grid_blocks = 0;
    if (!grid_blocks) {
        if (n_in != 31 || ws_size < 256 * MiB) { fprintf(stderr, "kernel_launch: unexpected n_in %d / ws %zu\n", n_in, ws_size); grid_blocks = -1; return; }
        int dev = 0, cus = 0, per_cu = 0;
        (void)hipGetDevice(&dev); (void)hipDeviceGetAttribute(&cus, hipDeviceAttributeMultiprocessorCount, dev);
        (void)hipFuncSetAttribute((const void*)mega, hipFuncAttributeMaxDynamicSharedMemorySize, MEGA_LDS);
        (void)hipOccupancyMaxActiveBlocksPerMultiprocessor(&per_cu, (const void*)mega, 512, MEGA_LDS);
        grid_blocks = (per_cu >= 1 && cus >= 256) ? 256 : -1;
        if (grid_blocks != 256) fprintf(stderr, "kernel_launch: %d CUs, %d blocks/CU: this kernel needs a 256-CU device; nothing launched\n", cus, per_cu);
    }
    if (grid_blocks < 0) return;
    unsigned char* ws = (unsigned char*)d_ws;
    (void)hipMemsetAsync(ws + WS_WLORA, 0, 3 * MiB / 4 + MiB / 2 + 65536, stream);
    Params p{};
    for (int i = 0; i < 31; ++i) p.in[i] = (const float*)d_in[i];
    p.out = (float*)d_out; p.wsp = ws;
#if MK_SPLIT
    for (int ph = 0; ph < N_PHASES; ++ph) { p.ph_lo = ph; p.ph_hi = ph + 1; void* args[] = {(void*)&p};
        hipError_t e = hipLaunchCooperativeKernel((const void*)mega, dim3(grid_blocks), dim3(512), args, MEGA_LDS, stream);
        if (e != hipSuccess) { fprintf(stderr, "cooperative launch failed: %s\n", hipGetErrorString(e)); return; } }
#else
    p.ph_lo = 0; p.ph_hi = N_PHASES; void* args[] = {(void*)&p};
    hipError_t e = hipLaunchCooperativeKernel((const void*)mega, dim3(grid_blocks), dim3(512), args, MEGA_LDS, stream);
    if (e != hipSuccess) fprintf(stderr, "cooperative launch failed: %s (grid %d)\n", hipGetErrorString(e), grid_blocks);
#endif
}
```

```cpp
#include <hip/hip_runtime.h>
#include <hip/hip_cooperative_groups.h>
#include <cstdint>
#include <cstdio>

typedef unsigned short bf16;
typedef _Float16 f16;

constexpr int BATCH = 8, SEQ = 2048, D = 1024, M = BATCH * SEQ;
constexpr int RW = 512, NH = 8, HD = 64;
constexpr int RWKV_COLS = 1792, IN_COLS = 6912;
constexpr int MEM_LEN = 256, MEM_ROWS = BATCH * MEM_LEN;
constexpr int DFF = 2816, DFF2 = 5632;
constexpr float NORM_EPS = 1e-6f, LNX_EPS = 64e-5f;

constexpr size_t MiB = 1u << 20;
constexpr size_t WS_CTL = 37 * MiB + MiB / 4;
constexpr size_t WS_WINT = 1 * MiB;
constexpr size_t WS_WUPT = WS_WINT + 13 * MiB + MiB / 2;
constexpr size_t WS_WDNT = WS_WUPT + 11 * MiB;
constexpr size_t WS_WBRT = WS_WDNT + 5 * MiB + MiB / 2;
constexpr size_t WS_WOUTT = WS_WBRT + 3 * MiB;
constexpr size_t WS_WLORA = WS_WOUTT + 2 * MiB;
constexpr size_t WS_V1T = WS_WLORA + 3 * MiB / 4;
constexpr size_t WS_V2T = WS_V1T + MiB / 4;
constexpr size_t WS_VFIRST = 38 * MiB;
constexpr size_t WS_XBA = 54 * MiB;
constexpr size_t WS_KVMEM = 86 * MiB;
constexpr size_t WS_SSQ = 94 * MiB;
constexpr size_t WS_NRM = 95 * MiB;
constexpr size_t WS_SSQM = WS_NRM + MiB / 2;
constexpr size_t WS_R = 96 * MiB;
constexpr size_t SLOT = 16 * MiB;
#define RS(i) (WS_R + (size_t)(i) * SLOT)
static_assert(WS_V2T + MiB / 4 == WS_CTL && WS_CTL + 65536 <= WS_VFIRST, "weights region");
static_assert(RS(10) <= 256 * MiB, "ws");

__device__ __forceinline__ int opaque_tid() { int t = threadIdx.x; asm volatile("" : "+v"(t)); return t; }
__device__ __forceinline__ float bf2f(bf16 v) { return __uint_as_float((unsigned)v << 16); }
__device__ __forceinline__ bf16 f2bf(float f) { unsigned u = __float_as_uint(f); return (bf16)((u + 0x7fffu + ((u >> 16) & 1u)) >> 16); }
__device__ __forceinline__ float sigmoidf_(float x) { return 1.f / (1.f + __expf(-x)); }
__device__ __forceinline__ float softplusf_(float x) { return fmaxf(x, 0.f) + log1pf(__expf(-fabsf(x))); }
__device__ __forceinline__ float shfl_xor_t(float v, int m) { return __builtin_bit_cast(float, __builtin_amdgcn_ds_bpermute((int)(((threadIdx.x & 63u) ^ (unsigned)m) << 2), __builtin_bit_cast(int, v))); }
__device__ __forceinline__ float wave_sum(float v) {
#pragma unroll
    for (int o = 1; o < 64; o <<= 1) v += shfl_xor_t(v, o);
    return v;
}
__device__ __forceinline__ float wave_max(float v) {
#pragma unroll
    for (int o = 1; o < 64; o <<= 1) v = fmaxf(v, shfl_xor_t(v, o));
    return v;
}
__device__ __forceinline__ float rstd_of(const float* ssq, int r) {
    const float4* p = (const float4*)(ssq + 16 * (size_t)r);
    const float4 a = p[0], b = p[1], c = p[2], d = p[3];
    const float s = (((a.x + a.y) + (a.z + a.w)) + ((b.x + b.y) + (b.z + b.w))) + (((c.x + c.y) + (c.z + c.w)) + ((d.x + d.y) + (d.z + d.w)));
    return rsqrtf(s * (1.f / 1024.f) + NORM_EPS);
}

namespace pg8 {
#define PG8_LAS __attribute__((address_space(3)))
typedef unsigned short bf16_t;
typedef short bf16x8 __attribute__((ext_vector_type(8)));
typedef float f32x4 __attribute__((ext_vector_type(4)));
typedef unsigned u32x4 __attribute__((ext_vector_type(4)));
typedef unsigned u32x2 __attribute__((ext_vector_type(2)));
constexpr int BM = 256, BK = 64, HALF = 128, HTB = HALF * BK * 2, STAGE_BYTES = 8 * HTB, NXCD = 8, WGM = 8;

__host__ __device__ __forceinline__ int lds_byte(int r, int c) { const int st = (r >> 4) * 2 + (c >> 5), rr = r & 15, cc = c & 31, ob = rr * 64 + cc * 2; return st * 1024 + (ob ^ (((ob >> 9) & 1) << 5)); }
__host__ __device__ __forceinline__ void stage_rc(int b, int& R, int& C) { const int st = b / 1024, sb = b % 1024, swz = sb ^ (((sb >> 9) & 1) << 5); R = (st >> 1) * 16 + swz / 64; C = (st & 1) * 32 + (swz % 64) / 2; }
__host__ __device__ __forceinline__ int perm32(int rho) { const int n = rho >> 4, i = rho & 15; return 8 * (i >> 2) + 4 * n + (i & 3); }

struct Unit { int pm, pn; };
struct Gemm { const bf16_t* A; const bf16_t* A1; const bf16_t* A2; const bf16_t* Bt; };

template <int NM, int NN> struct StaticOrderT {
    int G, c;
    __device__ __forceinline__ bool next(int i, Unit& u) const {
        constexpr int nwg = NM * NN;
        const int L = i * G + c; if (c < 0 || L >= nwg) return false;
        int wgid = L; { constexpr int q = nwg / NXCD, r = nwg % NXCD; const int xcd = wgid % NXCD, off = wgid / NXCD; wgid = (xcd < r ? xcd * (q + 1) : r * (q + 1) + (xcd - r) * q) + off; }
        constexpr int nig = WGM * NN; const int gid = wgid / nig, fm = gid * WGM, gsz = (NM - fm) < WGM ? (NM - fm) : WGM;
        u.pm = fm + ((wgid % nig) % gsz); u.pn = (wgid % nig) / gsz; return true;
    }
};

typedef float f32x2k __attribute__((ext_vector_type(2))); typedef __bf16 bf16x2k __attribute__((ext_vector_type(2)));
__device__ __forceinline__ unsigned cvt_pk_bf16(float lo, float hi) { f32x2k v = {lo, hi}; bf16x2k b = __builtin_convertvector(v, bf16x2k); return __builtin_bit_cast(unsigned, b); }

template <class Epi, bool ALIGN_EPI, int M_, int N_, int K_, int LDA_, int SEGT_>
__device__ __forceinline__ void gemm_phase(PG8_LAS unsigned char* lds, const Gemm g, int G_, int c_, const Epi& E) {
    const StaticOrderT<M_ / BM, N_ / BM> S{G_, c_};
    const int tid = opaque_tid(), wid = __builtin_amdgcn_readfirstlane(tid >> 6), lane = tid & 63, wr = wid >> 2, wc = wid & 3, fr = lane & 15, fq = lane >> 4;
    constexpr int K = K_, nt = K / BK, lda = LDA_, segt = SEGT_;
    unsigned voffA[2], voffB[2];
#pragma unroll
    for (int i = 0; i < 2; ++i) { int R, C; stage_rc(tid * 16 + i * 8192, R, C); const int Rb = Epi::PERM ? ((R & ~31) + perm32(R & 31)) : R;
        voffA[i] = (unsigned)(R * lda + C) * 2u; voffB[i] = (unsigned)(Rb * K + C) * 2u; }
    constexpr size_t kstep = (size_t)(BK * 2);
    constexpr size_t hstepA = (size_t)HALF * lda * 2, hstepB = (size_t)HALF * K * 2;
    constexpr size_t tstepA = 2 * hstepA, tstepB = 2 * hstepB;
    const unsigned ldsw = (unsigned)wid * 1024u;
    const int aoff = lds_byte(wr * 64 + fr, fq * 8), boff = lds_byte(wc * 32 + fr, fq * 8);
    auto atile = [&](int pm, int t) -> const char* { if constexpr (segt >= nt) { return (const char*)g.A + (size_t)pm * tstepA + (size_t)t * kstep; }
        else { const int s = t / segt; const bf16_t* b = (s == 0) ? g.A : ((s == 1) ? g.A1 : g.A2); return (const char*)b + (size_t)pm * tstepA + (size_t)(t - s * segt) * kstep; } };
#define PG8_SA(b, h) (((b) * 2 + (h)) * HTB)
#define PG8_SB(b, h) ((4 + (b) * 2 + (h)) * HTB)
#define PG8_STAGE(bufoff, gbase, voff) do { _Pragma("unroll") for (int _i = 0; _i < 2; ++_i) \
        __builtin_amdgcn_global_load_lds((const unsigned*)((const char*)(gbase) + (voff)[_i]), (PG8_LAS unsigned*)(lds + (bufoff) + ldsw + _i * 8192), 16, 0, 0); } while (0)
#define PG8_LDA(dst, b, h) do { _Pragma("unroll") for (int m = 0; m < 4; ++m) _Pragma("unroll") for (int k = 0; k < 2; ++k) dst[m][k] = *(const PG8_LAS bf16x8*)(lds + PG8_SA(b, h) + aoff + m * 2048 + k * 1024); } while (0)
#define PG8_LDB(dst, b, h) do { _Pragma("unroll") for (int n = 0; n < 2; ++n) _Pragma("unroll") for (int k = 0; k < 2; ++k) dst[n][k] = *(const PG8_LAS bf16x8*)(lds + PG8_SB(b, h) + boff + n * 2048 + k * 1024); } while (0)
#define PG8_MMA(ai, bj, At, Bt) do { __builtin_amdgcn_s_setprio(1); _Pragma("unroll") for (int m = 0; m < 4; ++m) _Pragma("unroll") for (int n = 0; n < 2; ++n) _Pragma("unroll") for (int k = 0; k < 2; ++k) \
        acc[ai][bj][m][n] = __builtin_amdgcn_mfma_f32_16x16x32_bf16(Bt[n][k], At[m][k], acc[ai][bj][m][n], 0, 0, 0); __builtin_amdgcn_s_setprio(0); } while (0)
#define PG8_WAIT_V(n) asm volatile("s_waitcnt vmcnt(" #n ")" ::: "memory")
#define PG8_WAIT_L(n) asm volatile("s_waitcnt lgkmcnt(" #n ")" ::: "memory")
#define PG8_BAR __builtin_amdgcn_s_barrier()
#define PG8_SCHED __builtin_amdgcn_sched_barrier(0)
    Unit cur, nxt; int ui = 0;
    if (!S.next(0, cur)) return;
    f32x4 acc[2][2][4][2];
#pragma unroll
    for (int a = 0; a < 2; ++a)
#pragma unroll
        for (int b = 0; b < 2; ++b)
#pragma unroll
            for (int m = 0; m < 4; ++m)
#pragma unroll
                for (int n = 0; n < 2; ++n) acc[a][b][m][n] = (f32x4){0.f, 0.f, 0.f, 0.f};
    bf16x8 At[4][2], B0[2][2], B1[2][2];
    const char* cB = (const char*)g.Bt + (size_t)cur.pn * tstepB;
    {
        const char* cA0 = atile(cur.pm, 0); const char* cA1 = atile(cur.pm, 1);
        PG8_STAGE(PG8_SB(0, 0), cB, voffB); PG8_STAGE(PG8_SB(0, 1), cB + hstepB, voffB); PG8_STAGE(PG8_SA(0, 0), cA0, voffA); PG8_STAGE(PG8_SA(0, 1), cA0 + hstepA, voffA);
        if (wr == 1) PG8_BAR;
        PG8_WAIT_V(2); PG8_BAR;
        PG8_STAGE(PG8_SB(1, 0), cB + kstep, voffB); PG8_STAGE(PG8_SA(1, 0), cA1, voffA); PG8_STAGE(PG8_SB(1, 1), cB + hstepB + kstep, voffB);
        PG8_WAIT_V(6); PG8_BAR;
    }
    for (;;) {
        const bool has_next = S.next(ui + 1, nxt);
        const int npm = has_next ? nxt.pm : cur.pm;
        const char* nB = has_next ? (const char*)g.Bt + (size_t)nxt.pn * tstepB : cB;
#pragma unroll 1
        for (int t = 0; t < nt; t += 2) {
            const bool last = (t == nt - 2);
            if constexpr (Epi::HAS_HOOK) E.khook(acc, cur, t, wr, wc, fr, fq);
            const char* a1 = atile(cur.pm, t + 1);
            const char* a2 = last ? atile(npm, 0) : atile(cur.pm, t + 2); const char* b2 = last ? nB : cB + (size_t)(t + 2) * kstep;
            const char* a3 = last ? atile(npm, 1) : atile(cur.pm, t + 3); const char* b3 = b2 + kstep;
            PG8_LDB(B0, 0, 0); PG8_LDB(B1, 0, 1); PG8_SCHED; PG8_LDA(At, 0, 0); PG8_STAGE(PG8_SA(1, 1), a1 + hstepA, voffA);
            PG8_WAIT_V(8); PG8_WAIT_L(0); PG8_BAR; PG8_MMA(0, 0, At, B0); PG8_MMA(0, 1, At, B1); PG8_BAR; PG8_SCHED;
            PG8_LDA(At, 0, 1); PG8_STAGE(PG8_SB(0, 0), b2, voffB); PG8_STAGE(PG8_SB(0, 1), b2 + hstepB, voffB); PG8_STAGE(PG8_SA(0, 0), a2, voffA);
            PG8_WAIT_V(8); PG8_WAIT_L(0); PG8_BAR; PG8_MMA(1, 0, At, B0); PG8_MMA(1, 1, At, B1); PG8_BAR; PG8_SCHED;
            PG8_LDB(B0, 1, 0); PG8_LDB(B1, 1, 1); PG8_SCHED; PG8_LDA(At, 1, 0); PG8_STAGE(PG8_SA(0, 1), a2 + hstepA, voffA);
            PG8_WAIT_V(8); PG8_WAIT_L(0); PG8_BAR; PG8_MMA(0, 0, At, B0); PG8_MMA(0, 1, At, B1); PG8_BAR; PG8_SCHED;
            PG8_LDA(At, 1, 1); PG8_STAGE(PG8_SB(1, 0), b3, voffB); PG8_STAGE(PG8_SB(1, 1), b3 + hstepB, voffB); PG8_STAGE(PG8_SA(1, 0), a3, voffA);
            PG8_WAIT_V(8); PG8_WAIT_L(0); PG8_BAR; PG8_MMA(1, 0, At, B0); PG8_MMA(1, 1, At, B1); PG8_BAR; PG8_SCHED;
        }
        if constexpr (ALIGN_EPI) { if (wr == 0) PG8_BAR; }
        E(acc, cur, wr, wc, fr, fq);
        if (!has_next) break;
#pragma unroll
        for (int a = 0; a < 2; ++a)
#pragma unroll
            for (int b = 0; b < 2; ++b)
#pragma unroll
                for (int m = 0; m < 4; ++m)
#pragma unroll
                    for (int n = 0; n < 2; ++n) acc[a][b][m][n] = (f32x4){0.f, 0.f, 0.f, 0.f};
        cur = nxt; cB = nB; ++ui;
        if constexpr (ALIGN_EPI) { if (wr == 1) PG8_BAR; }
    }
    PG8_WAIT_V(0);
    if constexpr (!ALIGN_EPI) { if (wr == 0) PG8_BAR; }
    PG8_BAR;
#undef PG8_SA
#undef PG8_SB
#undef PG8_STAGE
#undef PG8_LDA
#undef PG8_LDB
#undef PG8_MMA
#undef PG8_WAIT_V
#undef PG8_WAIT_L
#undef PG8_BAR
#undef PG8_SCHED
}

__device__ __forceinline__ void rstd8(const float* ssq, int row0, int fq, float (&rs)[2][4]) {
    f32x4 p[2][4];
#pragma unroll
    for (int ai = 0; ai < 2; ++ai)
#pragma unroll
        for (int m = 0; m < 4; ++m) p[ai][m] = *(const f32x4*)(ssq + 16 * (size_t)(row0 + ai * HALF + m * 16) + 4 * fq);
#pragma unroll
    for (int ai = 0; ai < 2; ++ai)
#pragma unroll
        for (int m = 0; m < 4; ++m) { float t = (p[ai][m][0] + p[ai][m][1]) + (p[ai][m][2] + p[ai][m][3]); t += shfl_xor_t(t, 16); t += shfl_xor_t(t, 32); rs[ai][m] = rsqrtf(t * (1.f / 1024.f) + 1e-6f); }
    asm volatile("" ::: "memory");
}
__device__ __forceinline__ void rstd4(const float* ssq, int row0, int fq, float (&rs)[4]) {
    f32x4 p[4];
#pragma unroll
    for (int m = 0; m < 4; ++m) p[m] = *(const f32x4*)(ssq + 16 * (size_t)(row0 + m * 16) + 4 * fq);
#pragma unroll
    for (int m = 0; m < 4; ++m) { float t = (p[m][0] + p[m][1]) + (p[m][2] + p[m][3]); t += shfl_xor_t(t, 16); t += shfl_xor_t(t, 32); rs[m] = rsqrtf(t * (1.f / 1024.f) + 1e-6f); }
    asm volatile("" ::: "memory");
}
__device__ __forceinline__ float rstd16(const float* ssq, int r) {
    const f32x4* p = (const f32x4*)(ssq + 16 * (size_t)r);
    const f32x4 a = p[0], b = p[1], c = p[2], d = p[3];
    const float s = (((a[0] + a[1]) + (a[2] + a[3])) + ((b[0] + b[1]) + (b[2] + b[3]))) + (((c[0] + c[1]) + (c[2] + c[3])) + ((d[0] + d[1]) + (d[2] + d[3])));
    return rsqrtf(s * (1.f / 1024.f) + 1e-6f);
}
__device__ __forceinline__ float bfl(unsigned w) { return __uint_as_float(w << 16); }
__device__ __forceinline__ float bfh(unsigned w) { return __uint_as_float(w & 0xffff0000u); }
__device__ __forceinline__ float sigm(float x) { return __builtin_amdgcn_rcpf(1.f + __expf(-x)); }

struct EpiRowScale {
    static constexpr bool PERM = true, HAS_HOOK = false;
    bf16_t* O; const float* ssq; int ldc; int act;
    __device__ __forceinline__ void operator()(const f32x4 (&acc)[2][2][4][2], const Unit& u, int wr, int wc, int fr, int fq) const {
        const int row0 = u.pm * BM + wr * 64 + fr, col0 = u.pn * BM + wc * 32 + 8 * fq;
        float rs8[2][4];
        if (ssq) rstd8(ssq, row0, fq, rs8);
#pragma unroll
        for (int ai = 0; ai < 2; ++ai)
#pragma unroll
            for (int m = 0; m < 4; ++m) { const int r = row0 + ai * HALF + m * 16; const float rs = ssq ? rs8[ai][m] : 1.f; bf16_t* rowp = O + (size_t)r * ldc + col0;
#pragma unroll
                for (int bj = 0; bj < 2; ++bj) { f32x4 v0 = acc[ai][bj][m][0] * rs, v1 = acc[ai][bj][m][1] * rs;
                    if (act == 1) {
#pragma unroll
                        for (int i = 0; i < 4; ++i) { v0[i] = sigm(v0[i]); v1[i] = sigm(v1[i]); } }
                    u32x4 w; w.x = cvt_pk_bf16(v0[0], v0[1]); w.y = cvt_pk_bf16(v0[2], v0[3]); w.z = cvt_pk_bf16(v1[0], v1[1]); w.w = cvt_pk_bf16(v1[2], v1[3]);
                    *(u32x4*)(rowp + bj * HALF) = w; } }
    }
};
__device__ __forceinline__ unsigned pk_f16(float lo, float hi) { const _Float16 a = (_Float16)lo, b = (_Float16)hi; return (unsigned)__builtin_bit_cast(unsigned short, a) | ((unsigned)__builtin_bit_cast(unsigned short, b) << 16); }
struct EpiLora {
    static constexpr bool PERM = true, HAS_HOOK = false;
    unsigned short* base; const float* w0; const float* a0; int k0;
    __device__ __forceinline__ void operator()(const f32x4 (&acc)[2][2][4][2], const Unit& u, int wr, int wc, int fr, int fq) const {
        const int kind = k0 + (u.pn >> 1);
        const int row0 = u.pm * BM + wr * 64 + fr, col0 = (u.pn & 1) * BM + wc * 32 + 8 * fq;
        unsigned short* O = base + (size_t)kind * ((size_t)16384 * 512);
        f32x4 bv[2][2];
#pragma unroll
        for (int bj = 0; bj < 2; ++bj)
#pragma unroll
            for (int n = 0; n < 2; ++n) { const f32x4 b0 = *(const f32x4*)(w0 + col0 + bj * HALF + 4 * n), b1 = *(const f32x4*)(a0 + col0 + bj * HALF + 4 * n);
                bv[bj][n] = (kind == 0) ? b0 : ((kind == 1) ? b1 : (f32x4){0.f, 0.f, 0.f, 0.f}); }
#pragma unroll
        for (int ai = 0; ai < 2; ++ai)
#pragma unroll
            for (int m = 0; m < 4; ++m) { unsigned short* rowp = O + (size_t)(row0 + ai * HALF + m * 16) * 512 + col0;
#pragma unroll
                for (int bj = 0; bj < 2; ++bj) { float o[8];
#pragma unroll
                    for (int i = 0; i < 8; ++i) o[i] = acc[ai][bj][m][i >> 2][i & 3] + bv[bj][i >> 2][i & 3];
                    u32x4 w;
                    if (kind == 0) {
#pragma unroll
                        for (int i = 0; i < 8; ++i) o[i] = -0.60653066f * __builtin_amdgcn_rcpf(1.f + __expf(-o[i]));
                        w.x = pk_f16(o[0], o[1]); w.y = pk_f16(o[2], o[3]); w.z = pk_f16(o[4], o[5]); w.w = pk_f16(o[6], o[7]);
                    } else {
                        if (kind == 1) {
#pragma unroll
                            for (int i = 0; i < 8; ++i) o[i] = sigm(o[i]); }
                        w.x = cvt_pk_bf16(o[0], o[1]); w.y = cvt_pk_bf16(o[2], o[3]); w.z = cvt_pk_bf16(o[4], o[5]); w.w = cvt_pk_bf16(o[6], o[7]);
                    }
                    *(u32x4*)(rowp + bj * HALF) = w; } }
    }
};
struct EpiVres {
    static constexpr bool PERM = true, HAS_HOOK = false;
    const bf16_t* v; const bf16_t* vf; const float* v0; bf16_t* O;
    __device__ __forceinline__ void operator()(const f32x4 (&acc)[2][2][4][2], const Unit& u, int wr, int wc, int fr, int fq) const {
        const int row0 = u.pm * BM + wr * 64 + fr, col0 = u.pn * BM + wc * 32 + 8 * fq;
#pragma unroll
        for (int ai = 0; ai < 2; ++ai)
#pragma unroll
            for (int m = 0; m < 4; ++m) { const size_t off = (size_t)(row0 + ai * HALF + m * 16) * 512 + col0;
#pragma unroll
                for (int bj = 0; bj < 2; ++bj) {
                    const u32x4 vv = *(const u32x4*)(v + off + bj * HALF), ff = *(const u32x4*)(vf + off + bj * HALF);
                    const f32x4 b0 = *(const f32x4*)(v0 + col0 + bj * HALF), b1 = *(const f32x4*)(v0 + col0 + bj * HALF + 4);
                    float o[8];
#pragma unroll
                    for (int i = 0; i < 8; ++i) { const unsigned vw = vv[i >> 1], fw = ff[i >> 1]; const float x = (i & 1) ? bfh(vw) : bfl(vw), f = (i & 1) ? bfh(fw) : bfl(fw);
                        const float z = ((i < 4) ? b0[i & 3] : b1[i & 3]) + acc[ai][bj][m][i >> 2][i & 3]; o[i] = x + (f - x) * sigm(z); }
                    u32x4 w; w.x = cvt_pk_bf16(o[0], o[1]); w.y = cvt_pk_bf16(o[2], o[3]); w.z = cvt_pk_bf16(o[4], o[5]); w.w = cvt_pk_bf16(o[6], o[7]);
                    *(u32x4*)(O + off + bj * HALF) = w; } }
    }
};
template <bool XIN_BF16, bool WRITE_F32> struct EpiResidual {
    static constexpr bool PERM = true, HAS_HOOK = false;
    const float* xin; const bf16_t* xinb; float* xout; bf16_t* xb; float* ssq;
    __device__ __forceinline__ void operator()(const f32x4 (&acc)[2][2][4][2], const Unit& u, int wr, int wc, int fr, int fq) const {
        const int row0 = u.pm * BM + wr * 64 + fr, col0 = u.pn * BM + wc * 32 + 8 * fq;
#pragma unroll
        for (int ai = 0; ai < 2; ++ai) {
            u32x4 xi[4][2]; f32x4 xf[4][2][2];
#pragma unroll
            for (int m = 0; m < 4; ++m)
#pragma unroll
                for (int bj = 0; bj < 2; ++bj) { const size_t o = (size_t)(row0 + ai * HALF + m * 16) * 1024 + col0 + bj * HALF;
                    if constexpr (XIN_BF16) xi[m][bj] = *(const u32x4*)(xinb + o);
                    else { xf[m][bj][0] = *(const f32x4*)(xin + o); xf[m][bj][1] = *(const f32x4*)(xin + o + 4); } }
            asm volatile("" ::: "memory");
#pragma unroll
            for (int m = 0; m < 4; ++m) { const int r = row0 + ai * HALF + m * 16; float s = 0.f;
#pragma unroll
                for (int bj = 0; bj < 2; ++bj) { const size_t o = (size_t)r * 1024 + col0 + bj * HALF;
                    f32x4 x0, x1;
                    if constexpr (XIN_BF16) { const u32x4 wv = xi[m][bj]; x0 = (f32x4){bfl(wv.x), bfh(wv.x), bfl(wv.y), bfh(wv.y)} + acc[ai][bj][m][0]; x1 = (f32x4){bfl(wv.z), bfh(wv.z), bfl(wv.w), bfh(wv.w)} + acc[ai][bj][m][1]; }
                    else { x0 = xf[m][bj][0] + acc[ai][bj][m][0]; x1 = xf[m][bj][1] + acc[ai][bj][m][1]; }
                    if constexpr (WRITE_F32) { __builtin_nontemporal_store(x0, (f32x4*)(xout + o)); __builtin_nontemporal_store(x1, (f32x4*)(xout + o + 4)); }
                    else {
                        s += ((x0[0] * x0[0] + x0[1] * x0[1]) + (x0[2] * x0[2] + x0[3] * x0[3])) + ((x1[0] * x1[0] + x1[1] * x1[1]) + (x1[2] * x1[2] + x1[3] * x1[3]));
                        u32x4 w; w.x = cvt_pk_bf16(x0[0], x0[1]); w.y = cvt_pk_bf16(x0[2], x0[3]); w.z = cvt_pk_bf16(x1[0], x1[1]); w.w = cvt_pk_bf16(x1[2], x1[3]); *(u32x4*)(xb + o) = w; } }
                if constexpr (!WRITE_F32) { s += shfl_xor_t(s, 16); s += shfl_xor_t(s, 32);
                    if (fq == 0) ssq[(size_t)r * 16 + u.pn * 4 + wc] = s; } }
        }
    }
};
__device__ __forceinline__ size_t gate_chunk(int pm, int pnG, int wave, int i, int lane) { return ((((size_t)pm * 12 + pnG) * 8 + wave) * 16 + i) * 512 + (size_t)lane * 8; }
struct EpiGatesFrag {
    static constexpr bool PERM = true, HAS_HOOK = false;
    bf16_t* O; const float* ssq;
    __device__ __forceinline__ void operator()(const f32x4 (&acc)[2][2][4][2], const Unit& u, int wr, int wc, int fr, int fq) const {
        const int row0 = u.pm * BM + wr * 64 + fr, wave = wr * 4 + wc, lane = fq * 16 + fr;
        float rs8[2][4];
        rstd8(ssq, row0, fq, rs8);
#pragma unroll
        for (int ai = 0; ai < 2; ++ai)
#pragma unroll
            for (int m = 0; m < 4; ++m) { const float rs = rs8[ai][m];
#pragma unroll
                for (int bj = 0; bj < 2; ++bj) { f32x4 v0 = acc[ai][bj][m][0] * rs, v1 = acc[ai][bj][m][1] * rs;
#pragma unroll
                    for (int i = 0; i < 4; ++i) { v0[i] = __expf(-fmaxf(v0[i], -60.f)); v1[i] = __expf(-fmaxf(v1[i], -60.f)); }
                    u32x4 w; w.x = cvt_pk_bf16(v0[0], v0[1]); w.y = cvt_pk_bf16(v0[2], v0[3]); w.z = cvt_pk_bf16(v1[0], v1[1]); w.w = cvt_pk_bf16(v1[2], v1[3]);
                    *(u32x4*)(O + gate_chunk(u.pm, u.pn, wave, (ai * 4 + m) * 2 + bj, lane)) = w; } }
    }
};
struct EpiGated {
    static constexpr bool PERM = true, HAS_HOOK = true;
    const bf16_t* gates; bf16_t* O;
    __device__ __forceinline__ void khook(f32x4 (&acc)[2][2][4][2], const Unit& u, int t, int wr, int wc, int fr, int fq) const {
        if (t != 8 && t != 16) return;
        const int b = (t >> 3) - 1, wave = wr * 4 + wc, lane = fq * 16 + fr;
#pragma unroll
        for (int ai = 0; ai < 2; ++ai)
#pragma unroll
            for (int mp = 0; mp < 2; ++mp) {
                u32x4 w0[2][2], w1[2][2];
#pragma unroll
                for (int mm = 0; mm < 2; ++mm)
#pragma unroll
                    for (int bj = 0; bj < 2; ++bj) { const int i = (ai * 4 + 2 * mp + mm) * 2 + bj;
                        w0[mm][bj] = *(const u32x4*)(gates + gate_chunk(u.pm, b * 4 + u.pn, wave, i, lane)); w1[mm][bj] = *(const u32x4*)(gates + gate_chunk(u.pm, (b + 1) * 4 + u.pn, wave, i, lane)); }
                asm volatile("" ::: "memory");
#pragma unroll
                for (int mm = 0; mm < 2; ++mm)
#pragma unroll
                    for (int bj = 0; bj < 2; ++bj) { const int m = 2 * mp + mm;
#pragma unroll
                        for (int n = 0; n < 2; ++n) { const unsigned a0 = n ? w0[mm][bj].z : w0[mm][bj].x, a1 = n ? w0[mm][bj].w : w0[mm][bj].y, c0 = n ? w1[mm][bj].z : w1[mm][bj].x, c1 = n ? w1[mm][bj].w : w1[mm][bj].y;
                            f32x4 r;
                            r[0] = (1.f + bfl(c0)) * __builtin_amdgcn_rcpf(1.f + bfl(a0)); r[1] = (1.f + bfh(c0)) * __builtin_amdgcn_rcpf(1.f + bfh(a0));
                            r[2] = (1.f + bfl(c1)) * __builtin_amdgcn_rcpf(1.f + bfl(a1)); r[3] = (1.f + bfh(c1)) * __builtin_amdgcn_rcpf(1.f + bfh(a1));
                            acc[ai][bj][m][n] *= r; } }
                asm volatile("" ::: "memory");
            }
    }
    __device__ __forceinline__ void operator()(const f32x4 (&acc)[2][2][4][2], const Unit& u, int wr, int wc, int fr, int fq) const {
        const int row0 = u.pm * BM + wr * 64 + fr, col0 = u.pn * BM + wc * 32 + 8 * fq, wave = wr * 4 + wc, lane = fq * 16 + fr;
#pragma unroll
        for (int ai = 0; ai < 2; ++ai) {
            u32x4 w2[4][2];
#pragma unroll
            for (int m = 0; m < 4; ++m)
#pragma unroll
                for (int bj = 0; bj < 2; ++bj) w2[m][bj] = *(const u32x4*)(gates + gate_chunk(u.pm, 8 + u.pn, wave, (ai * 4 + m) * 2 + bj, lane));
            asm volatile("" ::: "memory");
#pragma unroll
            for (int m = 0; m < 4; ++m) { const int r = row0 + ai * HALF + m * 16;
#pragma unroll
                for (int bj = 0; bj < 2; ++bj) { const u32x4 g2 = w2[m][bj];
                    const f32x4 a0 = acc[ai][bj][m][0], a1 = acc[ai][bj][m][1];
                    u32x4 w; w.x = cvt_pk_bf16(a0[0] * __builtin_amdgcn_rcpf(1.f + bfl(g2.x)), a0[1] * __builtin_amdgcn_rcpf(1.f + bfh(g2.x))); w.y = cvt_pk_bf16(a0[2] * __builtin_amdgcn_rcpf(1.f + bfl(g2.y)), a0[3] * __builtin_amdgcn_rcpf(1.f + bfh(g2.y)));
                    w.z = cvt_pk_bf16(a1[0] * __builtin_amdgcn_rcpf(1.f + bfl(g2.z)), a1[1] * __builtin_amdgcn_rcpf(1.f + bfh(g2.z))); w.w = cvt_pk_bf16(a1[2] * __builtin_amdgcn_rcpf(1.f + bfl(g2.w)), a1[3] * __builtin_amdgcn_rcpf(1.f + bfh(g2.w)));
                    *(u32x4*)(O + (size_t)r * 1024 + col0 + bj * HALF) = w; } }
        }
    }
};
template <int N> __device__ __forceinline__ float ror16(float v) { return __builtin_bit_cast(float, __builtin_amdgcn_update_dpp(0, __builtin_bit_cast(int, v), 0x120 + N, 0xf, 0xf, false)); }
__device__ __forceinline__ float silu_mul(float g, float v) { return g * __builtin_amdgcn_rcpf(1.f + __expf(-g)) * v; }
struct EpiConv {
    static constexpr bool PERM = true, HAS_HOOK = false;
    const float* ssq; const float* cw; const float* cb; bf16_t* U; float* side;
    __device__ __forceinline__ void operator()(const f32x4 (&acc)[2][2][4][2], const Unit& u, int wr, int wc, int fr, int fq) const {
        const int ch0 = u.pn * 128 + wc * 32 + 8 * fq;
        float rsa[4], rsb[4];
        rstd4(ssq, u.pm * BM + wr * 64 + fr, fq, rsa); rstd4(ssq, u.pm * BM + HALF + wr * 64 + fr, fq, rsb);
#pragma unroll
        for (int n = 0; n < 2; ++n) {
            const int ch = ch0 + 4 * n;
            const f32x4 g0 = *(const f32x4*)(cw + ch), g1 = *(const f32x4*)(cw + 5632 + ch), g2 = *(const f32x4*)(cw + 2 * 5632 + ch), gb = *(const f32x4*)(cb + ch);
            const f32x4 v0 = *(const f32x4*)(cw + 2816 + ch), v1 = *(const f32x4*)(cw + 5632 + 2816 + ch), v2 = *(const f32x4*)(cw + 2 * 5632 + 2816 + ch), vb = *(const f32x4*)(cb + 2816 + ch);
#pragma unroll
            for (int ai = 0; ai < 2; ++ai) {
                const int cid = u.pm * 4 + ai * 2 + wr;
                f32x4 pg = (f32x4){0.f, 0.f, 0.f, 0.f}, pv = pg;
#pragma unroll
                for (int m = 0; m < 4; ++m) {
                    const float rsm = ai ? rsb[m] : rsa[m];
                    const f32x4 cg = acc[ai][0][m][n] * rsm, cv = acc[ai][1][m][n] * rsm;
                    if ((m == 0 && fr < 2) || (m == 3 && fr >= 14)) { const int rr = (m == 0) ? fr : fr - 12;
                        float* sp = side + (((size_t)cid * 4 + rr) * 2) * 2816 + ch; *(f32x4*)sp = cg; *(f32x4*)(sp + 2816) = cv; }
                    f32x4 G, V;
#pragma unroll
                    for (int i = 0; i < 4; ++i) {
                        const float y1g = (fr == 15) ? pg[i] : cg[i], y2g = (fr >= 14) ? pg[i] : cg[i];
                        const float y1v = (fr == 15) ? pv[i] : cv[i], y2v = (fr >= 14) ? pv[i] : cv[i];
                        const float h1g = ror16<1>(y1g), h2g = ror16<2>(y2g), h1v = ror16<1>(y1v), h2v = ror16<2>(y2v);
                        G[i] = gb[i] + g0[i] * h2g + g1[i] * h1g + g2[i] * cg[i];
                        V[i] = vb[i] + v0[i] * h2v + v1[i] * h1v + v2[i] * cv[i];
                    }
                    u32x2 w; w.x = cvt_pk_bf16(silu_mul(G[0], V[0]), silu_mul(G[1], V[1])); w.y = cvt_pk_bf16(silu_mul(G[2], V[2]), silu_mul(G[3], V[3]));
                    *(u32x2*)(U + (size_t)(u.pm * BM + ai * HALF + wr * 64 + m * 16 + fr) * 2816 + ch) = w;
                    pg = cg; pv = cv;
                }
            }
        }
    }
};
}


#define LAS3 __attribute__((address_space(3)))
typedef float f32x4v __attribute__((ext_vector_type(4)));
typedef float f32x2v __attribute__((ext_vector_type(2)));
typedef unsigned u32x2v __attribute__((ext_vector_type(2)));
typedef unsigned u32x4v __attribute__((ext_vector_type(4)));
template <int CTRL> __device__ __forceinline__ float dppf(float v) { return __builtin_bit_cast(float, __builtin_amdgcn_update_dpp(0, __builtin_bit_cast(int, v), CTRL, 0xf, 0xf, true)); }
__device__ __forceinline__ float allsum16(float v) { v += dppf<0xB1>(v); v += dppf<0x4E>(v); v += dppf<0x141>(v); v += dppf<0x140>(v); return v; }
struct ScanArgs { const bf16* r_s; const bf16* k_s; const bf16* v; const bf16* a; const unsigned short* ld; const float* nrm; const float* k_k; const float* k_a; bf16* y_raw; const float* r_k; float* bonus; };
__device__ __forceinline__ float bf_lo(unsigned w) { return __uint_as_float(w << 16); }
__device__ __forceinline__ float bf_hi(unsigned w) { return __uint_as_float(w & 0xffff0000u); }
__device__ __forceinline__ float h_lo(unsigned w) { return (float)__builtin_bit_cast(_Float16, (unsigned short)(w & 0xffffu)); }
__device__ __forceinline__ float h_hi(unsigned w) { return (float)__builtin_bit_cast(_Float16, (unsigned short)(w >> 16)); }

typedef short bf16x8s __attribute__((ext_vector_type(8)));
typedef float f32x4c __attribute__((ext_vector_type(4)));
constexpr int CS_ROW = 144;
constexpr int CS_TR = 40;
constexpr int RC_P = 0, RC_RT = RC_P + 16 * CS_ROW, RC_KB = RC_RT + 16 * CS_ROW, RC_SM = RC_KB + 64 * 80, RC_GC = RC_SM + 16 * CS_ROW, RC_BYTES = RC_GC + 256;
static_assert(RC_BYTES == 12288, "record size");
__device__ __forceinline__ int rc_pos(int key) { return (key & 32) + 8 * ((key >> 2) & 3) + 4 * ((key >> 4) & 1) + (key & 3); }
constexpr int PS_KT = 0, PS_RT = PS_KT + 16 * CS_ROW, PS_KH = PS_RT + 16 * CS_ROW, PS_BH = PS_KH + 16 * CS_ROW, PS_KTT = PS_BH + 16 * CS_ROW, PS_AB = PS_KTT + 64 * CS_TR, PS_TM = PS_AB + 1024, PS_R2 = PS_TM + 16 * CS_TR, PS_BYTES = PS_R2 + 16 * CS_ROW;
static_assert(PS_BYTES % 16 == 0 && 8 * PS_BYTES <= 147456 - 64, "producer scratch");
constexpr int SL_VT = RC_BYTES, SL_BYTES = SL_VT + 64 * CS_TR, CS_GRP = 2, CS_RING = 4 * CS_GRP;
static_assert(SL_BYTES % 16 == 0 && CS_RING * SL_BYTES <= 147456 - 64, "consumer ring");
constexpr int CS_NCHUNK = SEQ / 16, CS_NITEM = 64 * CS_NCHUNK;
constexpr int CS_NA = (int)((64u << 20) / RC_BYTES);
struct CsRec { unsigned char* a; unsigned char* b; unsigned char* c; };
__device__ __forceinline__ unsigned char* cs_rec(const CsRec& R, int item) {
    constexpr int NB = (int)((32u << 20) / RC_BYTES);
    return item < CS_NA ? R.a + (size_t)item * RC_BYTES : (item < CS_NA + NB ? R.b + (size_t)(item - CS_NA) * RC_BYTES : R.c + (size_t)(item - CS_NA - NB) * RC_BYTES);
}
static_assert(CS_NA + (int)((32u << 20) / RC_BYTES) + (int)((16u << 20) / RC_BYTES) >= CS_NITEM, "record space");

typedef short bf16x4s __attribute__((ext_vector_type(4)));
__device__ __forceinline__ bf16x4s frag4(const LAS3 unsigned char* p) { return __builtin_bit_cast(bf16x4s, *(const LAS3 u32x2v*)p); }
__device__ __forceinline__ bf16x8s frag_2x4(const LAS3 unsigned char* p0, const LAS3 unsigned char* p1) {
    const u32x2v a = *(const LAS3 u32x2v*)p0, b = *(const LAS3 u32x2v*)p1; const u32x4v f = {a[0], a[1], b[0], b[1]}; return __builtin_bit_cast(bf16x8s, f); }
__device__ __forceinline__ bf16x4s pack4(const f32x4c& x) { const u32x2v f = {pg8::cvt_pk_bf16(x[0], x[1]), pg8::cvt_pk_bf16(x[2], x[3])}; return __builtin_bit_cast(bf16x4s, f); }
__device__ __forceinline__ f32x4c zero4_opaque() { int zi = 0; asm volatile("" : "+s"(zi)); const float zf = __builtin_bit_cast(float, zi); f32x4c z = {zf, zf, zf, zf}; asm volatile("" : "+v"(z)); return z; }
__device__ __forceinline__ bf16x8s pad8(bf16x4s a) { const u32x2v w = __builtin_bit_cast(u32x2v, a); const u32x4v f = {w[0], w[1], 0u, 0u}; return __builtin_bit_cast(bf16x8s, f); }
#define MFMA16K(a, b, c) __builtin_amdgcn_mfma_f32_16x16x32_bf16(pad8(a), pad8(b), c, 0, 0, 0)
#define MFMA16(a, b, c) __builtin_amdgcn_mfma_f32_16x16x32_bf16(a, b, c, 0, 0, 0)

__device__ __forceinline__ void cscan_produce(LAS3 unsigned char* sc, const ScanArgs& A, const CsRec& R, int gw_, int NGW_) {
    const int lane = opaque_tid() & 63, li = lane & 15, lq = lane >> 4;
    unsigned wrk[16]; unsigned short wa_[16], wl_[16]; float rnv;
    auto load_raw = [&](int item_v) {
        const int item = __builtin_amdgcn_readfirstlane(item_v);
        const int bh = item >> 7, c = item & 127, b = bh >> 3, h = bh & 7;
        const size_t row0 = (size_t)b * SEQ + (size_t)c * 16;
        const unsigned* prk = (const unsigned*)A.r_s + row0 * 512 + h * 64 + lane; const bf16* pa = A.a + row0 * 512 + h * 64 + lane;
        const unsigned short* pl = A.ld + row0 * 512 + h * 64 + lane; const float* pn = A.nrm + row0 * 8 + h;
#pragma unroll
        for (int s = 0; s < 16; ++s) { wrk[s] = __builtin_nontemporal_load(prk + s * 512); wa_[s] = __builtin_nontemporal_load(pa + s * 512); wl_[s] = __builtin_nontemporal_load(pl + s * 512); }
        rnv = pn[(lane & 15) * 8];
    };
    if (gw_ < CS_NITEM) load_raw(gw_);
    for (int item_v = gw_; item_v < CS_NITEM; item_v += NGW_) {
        const int item = __builtin_amdgcn_readfirstlane(item_v);
        const int h = (item >> 7) & 7;
        const float kkc = A.k_k[h * 64 + lane], kac = A.k_a[h * 64 + lane], rkc = A.r_k[h * 64 + lane];
        unsigned char* rec = cs_rec(R, item);
        float g = 1.f, kh4[4], bh4[4];
        const int lp2 = 2 * rc_pos(lane);
        unsigned ktw[8];
#pragma unroll
        for (int s = 0; s < 16; ++s) {
            const float r = __uint_as_float(wrk[s] << 16), k = __uint_as_float(wrk[s] & 0xffff0000u), aa = __uint_as_float((unsigned)wa_[s] << 16);
            const float dec = __expf((float)__builtin_bit_cast(_Float16, wl_[s]));
            const float gm1 = g; g *= dec;
            const float ig = __builtin_amdgcn_rcpf(g);
            const float rns = __builtin_bit_cast(float, __builtin_amdgcn_readlane(__builtin_bit_cast(int, rnv), s));
            const float kk = k * kkc * rns, bb = kk * aa, kt = k * (1.f + (aa - 1.f) * kac);
            const float ktil = kk * gm1, khs = kt * ig, bhs = bb * ig; kh4[s & 3] = khs; bh4[s & 3] = -bhs;
            const unsigned w0 = pg8::cvt_pk_bf16(ktil, khs), w1 = pg8::cvt_pk_bf16(bhs, r * g);
            *(LAS3 unsigned short*)(sc + PS_R2 + s * CS_ROW + lp2) = (unsigned short)(pg8::cvt_pk_bf16(r * g * rkc, 0.f) & 0xffffu);
            *(LAS3 unsigned short*)(sc + PS_KT + s * CS_ROW + lp2) = (unsigned short)(w0 & 0xffffu);
            *(LAS3 unsigned short*)(sc + PS_KH + s * CS_ROW + lp2) = (unsigned short)(w0 >> 16);
            *(LAS3 unsigned short*)(sc + PS_BH + s * CS_ROW + lp2) = (unsigned short)(w1 & 0xffffu);
            *(LAS3 unsigned short*)(sc + PS_RT + s * CS_ROW + lp2) = (unsigned short)(w1 >> 16);
            if (s & 1) ktw[s >> 1] |= (w0 & 0xffffu) << 16; else ktw[s >> 1] = w0 & 0xffffu;
            if ((s & 3) == 3) { const int q4 = s >> 2;
                *(u32x4v*)(rec + RC_KB + lane * 80 + 16 * q4) = (u32x4v){pg8::cvt_pk_bf16(kh4[0], kh4[1]), pg8::cvt_pk_bf16(kh4[2], kh4[3]), pg8::cvt_pk_bf16(bh4[0], bh4[1]), pg8::cvt_pk_bf16(bh4[2], bh4[3])}; }
        }
        *(float*)(rec + RC_GC + 4 * lane) = g;
#pragma unroll
        for (int q4 = 0; q4 < 4; ++q4) *(LAS3 u32x2v*)(sc + PS_KTT + lane * CS_TR + 8 * q4) = (u32x2v){ktw[2 * q4], ktw[2 * q4 + 1]};
        if (item + NGW_ < CS_NITEM) load_raw(item + NGW_);
        asm volatile("s_waitcnt lgkmcnt(0)" ::: "memory");
        f32x4c ak = zero4_opaque(), ab = zero4_opaque(), bk = zero4_opaque(), bb4 = zero4_opaque(), bd = zero4_opaque();
#pragma unroll
        for (int st = 0; st < 2; ++st) {
            const bf16x8s fkt = *(const LAS3 bf16x8s*)(sc + PS_KT + li * CS_ROW + 64 * st + 16 * lq), frt = *(const LAS3 bf16x8s*)(sc + PS_RT + li * CS_ROW + 64 * st + 16 * lq);
            const bf16x8s fkh = *(const LAS3 bf16x8s*)(sc + PS_KH + li * CS_ROW + 64 * st + 16 * lq), fbh = *(const LAS3 bf16x8s*)(sc + PS_BH + li * CS_ROW + 64 * st + 16 * lq);
            ak = MFMA16(fkt, fkh, ak); ab = MFMA16(fkt, fbh, ab); bk = MFMA16(frt, fkh, bk); bb4 = MFMA16(frt, fbh, bb4);
            bd = MFMA16(*(const LAS3 bf16x8s*)(sc + PS_R2 + li * CS_ROW + 64 * st + 16 * lq), fkh, bd);
        }
        if ((li >> 2) == lq) { const int c_ = li & 3; const float bv = c_ == 0 ? bd[0] : (c_ == 1 ? bd[1] : (c_ == 2 ? bd[2] : bd[3]));
            A.bonus[((size_t)(item >> 10) * SEQ + (size_t)(item & 127) * 16 + li) * 8 + h] = bv; }
        {
            float akm[4], bkm[4], bbm[4];
#pragma unroll
            for (int c = 0; c < 4; ++c) { const int so = 4 * lq + c; const bool strict = li < so, incl = li <= so;
                akm[c] = strict ? ak[c] : 0.f; bkm[c] = incl ? bk[c] : 0.f; bbm[c] = incl ? -bb4[c] : 0.f;
                *(LAS3 float*)(sc + PS_AB + (so * 16 + li) * 4) = strict ? ab[c] : 0.f; }
#pragma unroll
            for (int c = 0; c < 4; c += 2) { const unsigned wa = pg8::cvt_pk_bf16(akm[c], akm[c + 1]), wb = pg8::cvt_pk_bf16(bkm[c], bkm[c + 1]), wn = pg8::cvt_pk_bf16(bbm[c], bbm[c + 1]);
                LAS3 unsigned char* r0 = sc + PS_KH + (4 * lq + c) * CS_ROW + 32 * (li >> 2) + 2 * (li & 3); LAS3 unsigned char* r1 = r0 + CS_ROW;
                *(LAS3 unsigned short*)(r0) = (unsigned short)(wa & 0xffffu); *(LAS3 unsigned short*)(r1) = (unsigned short)(wa >> 16);
                *(LAS3 unsigned short*)(r0 + 16) = (unsigned short)(wb & 0xffffu); *(LAS3 unsigned short*)(r1 + 16) = (unsigned short)(wb >> 16);
                *(LAS3 unsigned short*)(r0 + 24) = (unsigned short)(wn & 0xffffu); *(LAS3 unsigned short*)(r1 + 24) = (unsigned short)(wn >> 16); }
        }
        asm volatile("s_waitcnt lgkmcnt(0)" ::: "memory");
        {
            float x[16];
            int lio = li; asm volatile("" : "+v"(lio));
#pragma unroll
            for (int s = 0; s < 16; ++s) {
                float acc0 = (s == lio) ? 1.f : 0.f, acc1 = 0.f;
#pragma unroll
                for (int q4 = 0; q4 < (s + 3) / 4; ++q4) { const f32x4c nrow = *(const LAS3 f32x4c*)(sc + PS_AB + (s * 16 + 4 * q4) * 4);
#pragma unroll
                    for (int e = 0; e < 4; ++e) if (4 * q4 + e < s) { if (e & 1) acc1 = fmaf(-nrow[e], x[4 * q4 + e], acc1); else acc0 = fmaf(-nrow[e], x[4 * q4 + e], acc0); } }
                x[s] = acc0 + acc1;
            }
            if (lq == 0) {
#pragma unroll
                for (int s = 0; s < 16; s += 2) { const unsigned wt = pg8::cvt_pk_bf16(x[s], x[s + 1]);
                    *(LAS3 unsigned short*)(sc + PS_TM + s * CS_TR + 2 * li) = (unsigned short)(wt & 0xffffu); *(LAS3 unsigned short*)(sc + PS_TM + (s + 1) * CS_TR + 2 * li) = (unsigned short)(wt >> 16);
                    *(LAS3 unsigned short*)(sc + PS_KH + s * CS_ROW + 32 * (li >> 2) + 8 + 2 * (li & 3)) = (unsigned short)(wt & 0xffffu); *(LAS3 unsigned short*)(sc + PS_KH + (s + 1) * CS_ROW + 32 * (li >> 2) + 8 + 2 * (li & 3)) = (unsigned short)(wt >> 16); }
            }
        }
        asm volatile("s_waitcnt lgkmcnt(0)" ::: "memory");
        const bf16x4s ftm = frag4(sc + PS_TM + li * CS_TR + 8 * lq);
#pragma unroll
        for (int tk = 0; tk < 4; ++tk) {
            const f32x4c pt = MFMA16K(ftm, frag4(sc + PS_KTT + (16 * tk + li) * CS_TR + 8 * lq), zero4_opaque());
#pragma unroll
            for (int c = 0; c < 4; c += 2) { const unsigned wp = pg8::cvt_pk_bf16(pt[c], pt[c + 1]);
                *(LAS3 unsigned short*)(sc + PS_KT + (4 * lq + c) * CS_ROW + 2 * rc_pos(16 * tk + li)) = (unsigned short)(wp & 0xffffu); *(LAS3 unsigned short*)(sc + PS_KT + (4 * lq + c + 1) * CS_ROW + 2 * rc_pos(16 * tk + li)) = (unsigned short)(wp >> 16); }
        }
        static_assert(PS_KT == 0 && PS_RT == 2304 && PS_KH == 4608 && RC_P == 0 && RC_RT == 2304, "staging order");
#pragma unroll
        for (int i = 0; i < 7; ++i) { const int pi = lane + 64 * i;
            if (i < 6 || pi < 432) { const u32x4v d = *(const LAS3 u32x4v*)(sc + 16 * pi); *(u32x4v*)(rec + (pi < 288 ? 16 * pi : RC_SM + 16 * (pi - 288))) = d; } }
        asm volatile("s_waitcnt lgkmcnt(0)" ::: "memory");
    }
}

struct CsOps { u32x2v fv; u32x4v sm0, sm1, p0, p1, r0, r1, kb[4]; f32x4c gc[4]; };
__device__ __forceinline__ void cs_load_ops(CsOps& o, const LAS3 unsigned char* sl, int w, int li, int lq) {
    o.fv = *(const LAS3 u32x2v*)(sl + SL_VT + (16 * w + li) * CS_TR + 8 * lq);
    o.sm0 = *(const LAS3 u32x4v*)(sl + RC_SM + li * CS_ROW + 32 * lq); o.sm1 = *(const LAS3 u32x4v*)(sl + RC_SM + li * CS_ROW + 32 * lq + 16);
    o.p0 = *(const LAS3 u32x4v*)(sl + RC_P + li * CS_ROW + 16 * lq); o.p1 = *(const LAS3 u32x4v*)(sl + RC_P + li * CS_ROW + 64 + 16 * lq);
    o.r0 = *(const LAS3 u32x4v*)(sl + RC_RT + li * CS_ROW + 16 * lq); o.r1 = *(const LAS3 u32x4v*)(sl + RC_RT + li * CS_ROW + 64 + 16 * lq);
#pragma unroll
    for (int tk = 0; tk < 4; ++tk) { o.kb[tk] = *(const LAS3 u32x4v*)(sl + RC_KB + (16 * tk + li) * 80 + 16 * lq); o.gc[tk] = *(const LAS3 f32x4c*)(sl + RC_GC + (16 * tk + 4 * lq) * 4); }
}
#define CS_B8(x) __builtin_bit_cast(bf16x8s, x)
__device__ __forceinline__ void cs_chunk(const CsOps& o, f32x4c (&H)[4], const f32x4c& Z, bf16* yp) {
    const u32x4v fvp = {o.fv[0], o.fv[1], 0u, 0u};
    const f32x4c akv = MFMA16(CS_B8(((u32x4v){o.sm0[0], o.sm0[1], 0u, 0u})), CS_B8(fvp), Z);
    u32x4v hb0 = {pg8::cvt_pk_bf16(H[0][0], H[0][1]), pg8::cvt_pk_bf16(H[0][2], H[0][3]), pg8::cvt_pk_bf16(H[1][0], H[1][1]), pg8::cvt_pk_bf16(H[1][2], H[1][3])};
    u32x4v hb1 = {pg8::cvt_pk_bf16(H[2][0], H[2][1]), pg8::cvt_pk_bf16(H[2][2], H[2][3]), pg8::cvt_pk_bf16(H[3][0], H[3][1]), pg8::cvt_pk_bf16(H[3][2], H[3][3])};
    f32x4c Y = MFMA16(CS_B8(o.r0), CS_B8(hb0), Z);
    Y = MFMA16(CS_B8(o.r1), CS_B8(hb1), Y);
    f32x4c U = MFMA16(CS_B8(((u32x4v){o.sm0[2], o.sm0[3], 0u, 0u})), CS_B8(((u32x4v){pg8::cvt_pk_bf16(akv[0], akv[1]), pg8::cvt_pk_bf16(akv[2], akv[3]), 0u, 0u})), Z);
    U = MFMA16(CS_B8(o.p0), CS_B8(hb0), U);
    U = MFMA16(CS_B8(o.p1), CS_B8(hb1), U);
    const u32x4v vu = {o.fv[0], o.fv[1], pg8::cvt_pk_bf16(U[0], U[1]), pg8::cvt_pk_bf16(U[2], U[3])};
    Y = MFMA16(CS_B8(o.sm1), CS_B8(vu), Y);
#pragma unroll
    for (int e = 0; e < 4; e += 2) { const unsigned wy = pg8::cvt_pk_bf16(Y[e], Y[e + 1]); yp[(size_t)e * 512] = (bf16)(wy & 0xffffu); yp[(size_t)(e + 1) * 512] = (bf16)(wy >> 16); }
#pragma unroll
    for (int tk = 0; tk < 4; ++tk) H[tk] = MFMA16(CS_B8(o.kb[tk]), CS_B8(vu), H[tk]) * o.gc[tk];
}
__device__ __forceinline__ void cscan_consume(LAS3 unsigned char* lds, const ScanArgs& A, const CsRec& R, int bh) {
    const int tid = opaque_tid(), lane = tid & 63, wave = __builtin_amdgcn_readfirstlane(tid >> 6), li = lane & 15, lq = lane >> 4;
    const int b = bh >> 3, h = bh & 7;
    const size_t rowbase = (size_t)b * SEQ;
    constexpr int NROUND = CS_NCHUNK / CS_GRP;
    if (wave >= 4) {
        const int lt = tid - 256;
        u32x4v rg[4][CS_GRP][3]; u32x2v vg[4][CS_GRP];
#define CS_LD(g_, S_) do { _Pragma("unroll") for (int k = 0; k < CS_GRP; ++k) { const int c_ = CS_GRP * (g_) + k; const unsigned char* rec_ = cs_rec(R, bh * CS_NCHUNK + c_); \
            _Pragma("unroll") for (int i = 0; i < 3; ++i) rg[S_][k][i] = __builtin_nontemporal_load((const u32x4v*)(rec_ + (lt + 256 * i) * 16)); \
            vg[S_][k] = __builtin_nontemporal_load((const u32x2v*)(A.v + (rowbase + (size_t)c_ * 16 + (lt >> 4)) * 512 + h * 64 + 4 * (lt & 15))); } } while (0)
#define CS_ST(S_) do { _Pragma("unroll") for (int k = 0; k < CS_GRP; ++k) { LAS3 unsigned char* sl_ = lds + ((S_) * CS_GRP + k) * SL_BYTES; \
            _Pragma("unroll") for (int i = 0; i < 3; ++i) *(LAS3 u32x4v*)(sl_ + (lt + 256 * i) * 16) = rg[S_][k][i]; \
            const int s_ = lt >> 4, ch_ = 4 * (lt & 15); \
            *(LAS3 unsigned short*)(sl_ + SL_VT + (ch_ + 0) * CS_TR + 2 * s_) = (unsigned short)(vg[S_][k][0] & 0xffffu); *(LAS3 unsigned short*)(sl_ + SL_VT + (ch_ + 1) * CS_TR + 2 * s_) = (unsigned short)(vg[S_][k][0] >> 16); \
            *(LAS3 unsigned short*)(sl_ + SL_VT + (ch_ + 2) * CS_TR + 2 * s_) = (unsigned short)(vg[S_][k][1] & 0xffffu); *(LAS3 unsigned short*)(sl_ + SL_VT + (ch_ + 3) * CS_TR + 2 * s_) = (unsigned short)(vg[S_][k][1] >> 16); } } while (0)
        CS_LD(0, 0); CS_LD(1, 1); CS_LD(2, 2); CS_LD(3, 3); CS_ST(0); CS_ST(1); CS_LD(4, 0); CS_LD(5, 1);
        __syncthreads();
        for (int g0 = 0; g0 < NROUND; g0 += 4) {
#pragma unroll
            for (int par = 0; par < 4; ++par) {
                const int g = g0 + par;
                if (g + 2 < NROUND) CS_ST((par + 2) & 3);
                if (g + 6 < NROUND) CS_LD(g + 6, (par + 2) & 3);
                __syncthreads();
            }
        }
#undef CS_LD
#undef CS_ST
    } else {
        const int w = wave;
        f32x4c H[4];
#pragma unroll
        for (int tk = 0; tk < 4; ++tk) H[tk] = zero4_opaque();
        const f32x4c Z = zero4_opaque();
        bf16* yp = A.y_raw + (rowbase + 4 * lq) * 512 + h * 64 + 16 * w + li;
        CsOps oa, ob;
        __syncthreads();
        cs_load_ops(oa, lds, w, li, lq);
#pragma unroll 1
        for (int g = 0; g < NROUND; ++g) {
            const LAS3 unsigned char* sl1 = lds + ((g & 3) * CS_GRP + 1) * SL_BYTES;
            const LAS3 unsigned char* sln = lds + (((g + 1) & 3) * CS_GRP) * SL_BYTES;
            __builtin_amdgcn_s_waitcnt(0xC07F);
            cs_load_ops(ob, sl1, w, li, lq);
            cs_chunk(oa, H, Z, yp);
            __builtin_amdgcn_s_waitcnt(0xC07F);
            cs_load_ops(oa, sln, w, li, lq);
            cs_chunk(ob, H, Z, yp + (size_t)16 * 512);
            yp += (size_t)32 * 512;
            __syncthreads();
        }
    }
}
#undef CS_B8

typedef float f32x16v __attribute__((ext_vector_type(16)));
typedef short bf16x8v __attribute__((ext_vector_type(8)));
typedef short bf16x4v __attribute__((ext_vector_type(4)));
constexpr int SB_KSTR = 144, SB_VSTR = 136;
constexpr int SB_KOFF = 0, SB_VOFF = 64 * SB_KSTR, SB_LDS = SB_VOFF + 64 * SB_VSTR, SB_BUF = 18432, SB_FLAG = 2 * SB_BUF;
static_assert(SB_BUF >= SB_LDS && SB_BUF % 256 == 0, "sb buffers");
typedef float f32x2c __attribute__((ext_vector_type(2))); typedef __bf16 bf16x2c __attribute__((ext_vector_type(2)));
__device__ __forceinline__ unsigned cvtpk_c(float lo, float hi) { f32x2c v = {lo, hi}; bf16x2c b = __builtin_convertvector(v, bf16x2c); return __builtin_bit_cast(unsigned, b); }
struct SbArgs { const bf16* proj_sm; const float* qg; const float* kg; bf16* y_b; };

__device__ __forceinline__ void sb_unit(LAS3 unsigned char* lds, const SbArgs& A, int bh, int u) {
    const int tid = opaque_tid(), lane = tid & 63, wave = __builtin_amdgcn_readfirstlane(tid >> 6), r32 = lane & 31, hh = lane >> 5;
    const int b = bh >> 3, h = bh & 7;
    const size_t rowbase = (size_t)b * SEQ;
    const int qrow = 256 * u + 32 * wave + r32;
    bf16x8v qf[4];
    {
        const bf16* qp = A.proj_sm + (rowbase + qrow) * 2048 + h * 64 + 8 * hh;
        u32x4v raw[4]; float x[4][8]; float ss = 0.f;
#pragma unroll
        for (int d0 = 0; d0 < 4; ++d0) { raw[d0] = *(const u32x4v*)(qp + 16 * d0);
#pragma unroll
            for (int j = 0; j < 8; ++j) { const unsigned w = raw[d0][j >> 1]; x[d0][j] = (j & 1) ? __uint_as_float(w & 0xffff0000u) : __uint_as_float(w << 16); ss += x[d0][j] * x[d0][j]; } }
        { auto rr = __builtin_amdgcn_permlane32_swap(__float_as_uint(ss), __float_as_uint(ss), false, false); ss = __uint_as_float(rr[0]) + __uint_as_float(rr[1]); }
        const float sc = rsqrtf(ss * (1.f / 64.f) + NORM_EPS) * (0.125f * 1.4426950408889634f);
#pragma unroll
        for (int d0 = 0; d0 < 4; ++d0) { const f32x4v g0 = *(const f32x4v*)(A.qg + 16 * d0 + 8 * hh), g1 = *(const f32x4v*)(A.qg + 16 * d0 + 8 * hh + 4);
            u32x4v w; w[0] = cvtpk_c(x[d0][0] * sc * g0[0], x[d0][1] * sc * g0[1]); w[1] = cvtpk_c(x[d0][2] * sc * g0[2], x[d0][3] * sc * g0[3]);
            w[2] = cvtpk_c(x[d0][4] * sc * g1[0], x[d0][5] * sc * g1[1]); w[3] = cvtpk_c(x[d0][6] * sc * g1[2], x[d0][7] * sc * g1[3]);
            qf[d0] = __builtin_bit_cast(bf16x8v, w); }
    }
    const int skv = tid >> 3, sc8 = tid & 7;
    const f32x4v kg0 = *(const f32x4v*)(A.kg + 8 * sc8), kg1 = *(const f32x4v*)(A.kg + 8 * sc8 + 4);
    u32x4v gK, gV;
    auto stage_load = [&](int kt) { const bf16* kp = A.proj_sm + (rowbase + kt * 64 + skv) * 2048 + 512 + h * 64 + 8 * sc8; gK = *(const u32x4v*)kp; gV = *(const u32x4v*)(kp + 512); };
    auto stage_store = [&](int bo) {
        float x[8]; float ss = 0.f;
#pragma unroll
        for (int j = 0; j < 8; ++j) { const unsigned w = gK[j >> 1]; x[j] = (j & 1) ? __uint_as_float(w & 0xffff0000u) : __uint_as_float(w << 16); ss += x[j] * x[j]; }
        ss += shfl_xor_t(ss, 1); ss += shfl_xor_t(ss, 2); ss += shfl_xor_t(ss, 4);
        const float sc = rsqrtf(ss * (1.f / 64.f) + NORM_EPS);
        u32x4v w; w[0] = cvtpk_c(x[0] * sc * kg0[0], x[1] * sc * kg0[1]); w[1] = cvtpk_c(x[2] * sc * kg0[2], x[3] * sc * kg0[3]);
        w[2] = cvtpk_c(x[4] * sc * kg1[0], x[5] * sc * kg1[1]); w[3] = cvtpk_c(x[6] * sc * kg1[2], x[7] * sc * kg1[3]);
        *(LAS3 u32x4v*)(lds + bo + SB_KOFF + skv * SB_KSTR + 16 * sc8) = w;
#pragma unroll
        for (int j = 0; j < 8; ++j) { const unsigned wv = gV[j >> 1]; const unsigned short e = (j & 1) ? (unsigned short)(wv >> 16) : (unsigned short)(wv & 0xffffu);
            *(LAS3 unsigned short*)(lds + bo + SB_VOFF + (8 * sc8 + j) * SB_VSTR + 2 * skv) = e; }
    };
    f32x16v o0, o1;
#pragma unroll
    for (int i = 0; i < 16; ++i) { o0[i] = 0.f; o1[i] = 0.f; }
    float R = 1.f;
    const int kt0 = 4 * u + 3;
    const int qmin = 256 * u + 32 * wave;
    LAS3 unsigned* flagw = (LAS3 unsigned*)(lds + SB_FLAG);
    if (tid < 3) flagw[tid] = (tid == kt0 % 3) ? 1u : 0u;
    stage_load(kt0);
    bool mine = false;
    for (int kt = kt0; kt >= 0; --kt) {
        const int bo = (kt & 1) * SB_BUF;
        stage_store(bo);
        if (kt > 0) stage_load(kt - 1);
        __syncthreads();
        if (flagw[kt % 3] == 0u) break;
        if (tid == 0) flagw[(kt + 1) % 3] = 0u;
        if (kt * 64 <= qmin + 31 && !mine) {
        f32x16v p0, p1;
        {
            const int kb0 = kt * 64 + 4 * hh;
#pragma unroll
            for (int r = 0; r < 16; ++r) { const int kv = kb0 + (r & 3) + 8 * (r >> 2); p0[r] = (kv >= qrow) ? -1e30f : 0.f; p1[r] = (kv + 32 >= qrow) ? -1e30f : 0.f; }
        }
        asm volatile("" : "+v"(p0), "+v"(p1));
        const LAS3 unsigned char* kb = lds + bo + SB_KOFF + r32 * SB_KSTR + 16 * hh;
        const LAS3 unsigned char* vb = lds + bo + SB_VOFF + r32 * SB_VSTR + 8 * hh;
        {
            bf16x8v kf0[4], kf1[4];
#pragma unroll
            for (int d0 = 0; d0 < 4; ++d0) { kf0[d0] = *(const LAS3 bf16x8v*)(kb + 32 * d0); kf1[d0] = *(const LAS3 bf16x8v*)(kb + 32 * SB_KSTR + 32 * d0); }
            asm volatile("" ::: "memory");
#pragma unroll
            for (int d0 = 0; d0 < 4; ++d0) {
                p0 = __builtin_amdgcn_mfma_f32_32x32x16_bf16(kf0[d0], qf[d0], p0, 0, 0, 0);
                p1 = __builtin_amdgcn_mfma_f32_32x32x16_bf16(kf1[d0], qf[d0], p1, 0, 0, 0);
            }
        }
        bf16x4v va[4][2], vc[4][2];
#pragma unroll
        for (int hs = 0; hs < 4; ++hs) { const int kvo = 2 * (32 * (hs >> 1) + 16 * (hs & 1));
            va[hs][0] = *(const LAS3 bf16x4v*)(vb + kvo); va[hs][1] = *(const LAS3 bf16x4v*)(vb + kvo + 16);
            vc[hs][0] = *(const LAS3 bf16x4v*)(vb + 32 * SB_VSTR + kvo); vc[hs][1] = *(const LAS3 bf16x4v*)(vb + 32 * SB_VSTR + kvo + 16); }
        asm volatile("" ::: "memory");
        float bs[8];
#pragma unroll
        for (int g = 0; g < 8; ++g) {
            float run = 1.f;
#pragma unroll
            for (int i = 3; i >= 0; --i) { const float z = (g < 4) ? p0[4 * g + i] : p1[4 * (g - 4) + i];
                const float rn = run * __builtin_amdgcn_rcpf(1.f + __builtin_amdgcn_exp2f(z));
                if (g < 4) p0[4 * g + i] = run - rn; else p1[4 * (g - 4) + i] = run - rn;
                run = rn; }
            bs[g] = run;
        }
        float T = 1.f, off[8];
#pragma unroll
        for (int g = 7; g >= 0; --g) {
            auto rr = __builtin_amdgcn_permlane32_swap(__float_as_uint(bs[g]), __float_as_uint(bs[g]), false, false);
            const float bE = __uint_as_float(rr[0]), bO = __uint_as_float(rr[1]);
            off[g] = R * T * (hh ? 1.f : bO);
            T *= bE * bO;
        }
#pragma unroll
        for (int g = 0; g < 8; ++g)
#pragma unroll
            for (int i = 0; i < 4; ++i) { if (g < 4) p0[4 * g + i] *= off[g]; else p1[4 * (g - 4) + i] *= off[g]; }
        R *= T;
#pragma unroll
        for (int half = 0; half < 2; ++half)
#pragma unroll
            for (int s2 = 0; s2 < 2; ++s2) {
                u32x4v pw;
#pragma unroll
                for (int j = 0; j < 4; ++j) { const float x0 = half ? p1[8 * s2 + 2 * j] : p0[8 * s2 + 2 * j], x1 = half ? p1[8 * s2 + 2 * j + 1] : p0[8 * s2 + 2 * j + 1]; pw[j] = cvtpk_c(x0, x1); }
                const bf16x8v pa = __builtin_bit_cast(bf16x8v, pw);
                const bf16x4v a0 = va[2 * half + s2][0], a1 = va[2 * half + s2][1], c0 = vc[2 * half + s2][0], c1 = vc[2 * half + s2][1];
                const bf16x8v vf0 = (bf16x8v){a0[0], a0[1], a0[2], a0[3], a1[0], a1[1], a1[2], a1[3]};
                const bf16x8v vf1 = (bf16x8v){c0[0], c0[1], c0[2], c0[3], c1[0], c1[1], c1[2], c1[3]};
                o0 = __builtin_amdgcn_mfma_f32_32x32x16_bf16(pa, vf0, o0, 0, 0, 0);
                o1 = __builtin_amdgcn_mfma_f32_32x32x16_bf16(pa, vf1, o1, 0, 0, 0);
            }
        }
        mine = __all(R == 0.f);
        if (!mine && lane == 0) flagw[(kt + 2) % 3] = 1u;
    }
    bf16* op = A.y_b + (rowbase + 256 * u + 32 * wave) * 512 + h * 64 + r32;
#pragma unroll
    for (int r = 0; r < 16; ++r) { const int qq = (r & 3) + 8 * (r >> 2) + 4 * hh; op[(size_t)qq * 512] = f2bf(o0[r]); op[(size_t)qq * 512 + 32] = f2bf(o1[r]); }
}

__device__ __forceinline__ void wt_item(const float* __restrict__ src, int ldsrc, const float* __restrict__ scale, bf16* __restrict__ dst, int lddst, int koff, int N, int mode, LAS3 float* scr, int item, int lane) {
    const int nblk = N / 32, kb = item / nblk, nb = item % nblk, k0 = 64 * kb, n0 = 32 * nb;
    int sc0 = n0;
    if (mode == 1) { const int pn = n0 >> 8, j0 = n0 & 255; sc0 = (j0 < 128) ? (128 * pn + j0) : (DFF + 128 * pn + (j0 - 128)); }
    {
        const float* sp = src + (size_t)(k0 + (lane >> 5)) * ldsrc + sc0 + (lane & 31);
#pragma unroll
        for (int i0 = 0; i0 < 32; i0 += 8) { float v[8], sv[8];
#pragma unroll
            for (int i = 0; i < 8; ++i) { v[i] = __builtin_nontemporal_load(sp + (size_t)(2 * (i0 + i)) * ldsrc);       sv[i] = scale ? scale[k0 + 2 * (i0 + i) + (lane >> 5)] : 1.f; }
            asm volatile("" ::: "memory");
#pragma unroll
            for (int i = 0; i < 8; ++i) scr[(2 * (i0 + i) + (lane >> 5)) * 33 + (lane & 31)] = v[i] * sv[i]; }
    }
    asm volatile("s_waitcnt lgkmcnt(0)" ::: "memory");
    const int c = lane & 7;
#pragma unroll
    for (int j = 0; j < 4; ++j) { const int n = (lane >> 3) + 8 * j; const LAS3 float* s = scr + (8 * c) * 33 + n;
        pg8::u32x4 o; o.x = pg8::cvt_pk_bf16(s[0 * 33], s[1 * 33]); o.y = pg8::cvt_pk_bf16(s[2 * 33], s[3 * 33]); o.z = pg8::cvt_pk_bf16(s[4 * 33], s[5 * 33]); o.w = pg8::cvt_pk_bf16(s[6 * 33], s[7 * 33]);
        *(pg8::u32x4*)(dst + (size_t)(n0 + n) * lddst + koff + k0 + 8 * c) = o; }
    asm volatile("s_waitcnt lgkmcnt(0)" ::: "memory");
}
__device__ __forceinline__ void wt_job(const float* src, const float* scale, bf16* dst, int ldsrc, int lddst, int koff, int K, int N, int mode, LAS3 float* scr, int gw, int NGW, int lane, int rot) {
    const int ni = (K / 64) * (N / 32);
    int first = gw - (rot % NGW); if (first < 0) first += NGW;
    for (int it = first; it < ni; it += NGW) wt_item(src, ldsrc, scale, dst, lddst, koff, N, mode, scr, it, lane);
}
__device__ __forceinline__ void x_to_xb_rows(const float* __restrict__ x, bf16* __restrict__ xb, float* __restrict__ ssq, int rows, int gw, int NGW, int lane) {
    for (int row0 = gw; row0 < rows; row0 += 2 * NGW) {
        float4 v[2][4];
#pragma unroll
        for (int b = 0; b < 2; ++b) { const int row = (row0 + b * NGW < rows) ? row0 + b * NGW : row0;
#pragma unroll
            for (int q = 0; q < 4; ++q) { const f32x4v t_ = __builtin_nontemporal_load((const f32x4v*)(x + (size_t)row * D + q * 256 + lane * 4)); v[b][q] = make_float4(t_[0], t_[1], t_[2], t_[3]); } }
        asm volatile("" ::: "memory");
#pragma unroll
        for (int b = 0; b < 2; ++b) { const int row = row0 + b * NGW;
            if (row < rows) {
#pragma unroll
                for (int q = 0; q < 4; ++q) { const float4 w = v[b][q];
                    float s = (w.x * w.x + w.y * w.y) + (w.z * w.z + w.w * w.w);
                    s += shfl_xor_t(s, 1); s += shfl_xor_t(s, 2); s += shfl_xor_t(s, 4); s += shfl_xor_t(s, 8);
                    if ((lane & 15) == 0) ssq[(size_t)row * 16 + q * 4 + (lane >> 4)] = s;
                    pg8::u32x2 o; o.x = pg8::cvt_pk_bf16(w.x, w.y); o.y = pg8::cvt_pk_bf16(w.z, w.w);
                    *(pg8::u32x2*)(xb + (size_t)row * D + q * 256 + lane * 4) = o; } } }
    }
}
__device__ __forceinline__ void memk_norm_rows(bf16* __restrict__ kv, const float* __restrict__ kg, int gw, int NGW, int lane) {
    for (int it = gw; it < MEM_ROWS * 4; it += NGW) {
        bf16* p = kv + (size_t)(it >> 2) * 1024 + (it & 3) * 128 + lane * 2;
        const unsigned w = *(const unsigned*)p; const float a = __uint_as_float(w << 16), b = __uint_as_float(w & 0xffff0000u);
        const float ss = wave_sum(a * a + b * b), rs = rsqrtf(ss * (1.f / 128.f) + NORM_EPS);
        *(unsigned*)p = pg8::cvt_pk_bf16(a * rs * kg[lane * 2], b * rs * kg[lane * 2 + 1]);
    }
}
struct ShiftArgs { const bf16* proj_r; const float* mu; const float* k_k; bf16* r_s; bf16* k_s; bf16* v_s; bf16* lora_in; float* nrm; };
__device__ __forceinline__ float tanh_fast(float x) { const float e = __expf(-2.f * fabsf(x)); const float t = (1.f - e) * __builtin_amdgcn_rcpf(1.f + e); return x < 0.f ? -t : t; }
__device__ __forceinline__ void shift_rows(const ShiftArgs& A, int gw_, int NGW_) {
    const int lane = opaque_tid() & 63;
    f32x4v mu[7];
#pragma unroll
    for (int i = 0; i < 7; ++i) mu[i] = *(const f32x4v*)(A.mu + 4 * (lane + 64 * i));
    const f32x4v kk0 = *(const f32x4v*)(A.k_k + 4 * lane), kk1 = *(const f32x4v*)(A.k_k + 256 + 4 * lane);
    for (int row = gw_; row < M; row += NGW_) {
        const bool has_prev = (row % SEQ) != 0;
        const bf16* cur = A.proj_r + (size_t)row * RWKV_COLS + 4 * lane;
        u32x2v c[7], pv[7];
#pragma unroll
        for (int i = 0; i < 7; ++i) { c[i] = __builtin_nontemporal_load((const u32x2v*)(cur + 256 * i)); pv[i] = has_prev ? __builtin_nontemporal_load((const u32x2v*)(cur + 256 * i - RWKV_COLS)) : (u32x2v){0u, 0u}; }
        float ssq_[2]; f32x4v xr[2];
#pragma unroll
        for (int i = 0; i < 7; ++i) {
            f32x4v x;
            { const float c0 = __uint_as_float(c[i][0] << 16), c1 = __uint_as_float(c[i][0] & 0xffff0000u), c2 = __uint_as_float(c[i][1] << 16), c3 = __uint_as_float(c[i][1] & 0xffff0000u);
              const float p0 = __uint_as_float(pv[i][0] << 16), p1 = __uint_as_float(pv[i][0] & 0xffff0000u), p2 = __uint_as_float(pv[i][1] << 16), p3 = __uint_as_float(pv[i][1] & 0xffff0000u);
              x[0] = c0 + (p0 - c0) * mu[i][0]; x[1] = c1 + (p1 - c1) * mu[i][1]; x[2] = c2 + (p2 - c2) * mu[i][2]; x[3] = c3 + (p3 - c3) * mu[i][3]; }
            if (i == 2 || i == 3) { const f32x4v kk = (i == 2) ? kk0 : kk1; float q = 0.f;
#pragma unroll
                for (int e = 0; e < 4; ++e) { const float t = x[e] * kk[e]; q += t * t; }
                q += shfl_xor_t(q, 1); q += shfl_xor_t(q, 2); q += shfl_xor_t(q, 4); q += shfl_xor_t(q, 8); ssq_[i - 2] = q; }
            if (i == 6) {
                if (lane < 16) {
#pragma unroll
                    for (int e = 0; e < 4; ++e) x[e] = tanh_fast(x[e]);
                } else if (lane >= 32) {
#pragma unroll
                    for (int e = 0; e < 4; ++e) x[e] = sigmoidf_(x[e]);
                }
            }
            if (i < 2) xr[i] = x;
            else if (i < 4) {
                const f32x4v r_ = xr[i - 2]; u32x4v w4 = {pg8::cvt_pk_bf16(r_[0], x[0]), pg8::cvt_pk_bf16(r_[1], x[1]), pg8::cvt_pk_bf16(r_[2], x[2]), pg8::cvt_pk_bf16(r_[3], x[3])};
                *(u32x4v*)((unsigned*)A.r_s + (size_t)row * 512 + 256 * (i - 2) + 4 * lane) = w4;
            } else {
                u32x2v w; w[0] = pg8::cvt_pk_bf16(x[0], x[1]); w[1] = pg8::cvt_pk_bf16(x[2], x[3]);
                bf16* dst = (i < 6) ? A.v_s + (size_t)row * 512 + 256 * (i - 4) : A.lora_in + (size_t)row * 256;
                *(u32x2v*)(dst + 4 * lane) = w; }
        }
        if ((lane & 15) == 0) { A.nrm[(size_t)row * 8 + (lane >> 4)] = 1.f / fmaxf(sqrtf(ssq_[0]), 1e-12f); A.nrm[(size_t)row * 8 + 4 + (lane >> 4)] = 1.f / fmaxf(sqrtf(ssq_[1]), 1e-12f); }
    }
}
struct PostArgs { const bf16* y_raw; const bf16* v; const bf16* g; const float* bonus; const float* lnx_g; const float* lnx_b; bf16* y_a; };
__device__ __forceinline__ void unpack8(float (&o)[8], const u32x4v& w) {
#pragma unroll
    for (int j = 0; j < 4; ++j) { o[2 * j] = __uint_as_float(w[j] << 16); o[2 * j + 1] = __uint_as_float(w[j] & 0xffff0000u); } }
__device__ __forceinline__ float sum8lanes(float v) { v += shfl_xor_t(v, 1); v += shfl_xor_t(v, 2); v += shfl_xor_t(v, 4); return v; }
__device__ __forceinline__ void post_rows(const PostArgs& A, int gw_, int NGW_) {
    const int lane = opaque_tid() & 63, col = 8 * lane;
    float lg[8], lb[8];
#pragma unroll
    for (int e = 0; e < 8; ++e) { lg[e] = A.lnx_g[col + e]; lb[e] = A.lnx_b[col + e]; }
    for (int row = gw_; row < M; row += NGW_) {
        const size_t idx = (size_t)row * 512 + col;
        const u32x4v wy = __builtin_nontemporal_load((const u32x4v*)(A.y_raw + idx)), wv = __builtin_nontemporal_load((const u32x4v*)(A.v + idx)), wg = __builtin_nontemporal_load((const u32x4v*)(A.g + idx));
        const float bonus = A.bonus[(size_t)row * 8 + (lane >> 3)];
        float y[8], v[8], g[8];
        unpack8(y, wy); unpack8(v, wv); unpack8(g, wg);
        float s = 0.f;
#pragma unroll
        for (int e = 0; e < 8; ++e) s += y[e];
        const float mean = sum8lanes(s) * (1.f / 64.f);
        float q = 0.f;
#pragma unroll
        for (int e = 0; e < 8; ++e) { y[e] -= mean; q += y[e] * y[e]; }
        const float rstd = rsqrtf(sum8lanes(q) * (1.f / 64.f) + LNX_EPS);
        u32x4v w;
#pragma unroll
        for (int j = 0; j < 4; ++j) { const float o0 = (y[2 * j] * rstd * lg[2 * j] + lb[2 * j] + bonus * v[2 * j]) * g[2 * j], o1 = (y[2 * j + 1] * rstd * lg[2 * j + 1] + lb[2 * j + 1] + bonus * v[2 * j + 1]) * g[2 * j + 1];
            w[j] = pg8::cvt_pk_bf16(o0, o1); }
        *(u32x4v*)(A.y_a + idx) = w;
    }
}
struct MemArgs { const bf16* proj_sm; const bf16* kv; const float* qg; bf16* y_m; };

constexpr int MA_KSTR = 272, MA_VSTR = 520;
constexpr int MA_KOFF = 0, MA_VOFF = 256 * MA_KSTR, MA_LDS = MA_VOFF + 128 * MA_VSTR;
__device__ __forceinline__ void mem_unit(LAS3 unsigned char* lds, const MemArgs& A, int b, int h, int u) {
    const int tid = opaque_tid(), lane = tid & 63, wave = __builtin_amdgcn_readfirstlane(tid >> 6), r32 = lane & 31, hh = lane >> 5;
    {
        const bf16* kvb = A.kv + (size_t)(b * MEM_LEN) * 1024 + h * 128;
#pragma unroll
        for (int i = 0; i < 8; ++i) { const int c = tid + 512 * i, row = c >> 4, c16 = c & 15;
            const int combo = wave * 8 + i, vrow = 16 * (combo & 15) + (lane & 15), vc16 = 4 * (combo >> 4) + (lane >> 4);
            const u32x4v kw = *(const u32x4v*)(kvb + (size_t)row * 1024 + 8 * c16), vw = *(const u32x4v*)(kvb + (size_t)vrow * 1024 + 512 + 8 * vc16);
            *(LAS3 u32x4v*)(lds + MA_KOFF + row * MA_KSTR + 16 * c16) = kw;
#pragma unroll
            for (int j = 0; j < 8; ++j) { const unsigned wv = vw[j >> 1]; const unsigned short e = (j & 1) ? (unsigned short)(wv >> 16) : (unsigned short)(wv & 0xffffu);
                *(LAS3 unsigned short*)(lds + MA_VOFF + (8 * vc16 + j) * MA_VSTR + 2 * vrow) = e; } }
    }
    const size_t qrow = (size_t)b * SEQ + 256 * u + 32 * wave + r32;
    bf16x8v qf[8];
    {
        const bf16* qp = A.proj_sm + qrow * 2048 + 1536 + h * 128 + 8 * hh;
        u32x4v raw[8]; float ss = 0.f;
#pragma unroll
        for (int d0 = 0; d0 < 8; ++d0) { raw[d0] = *(const u32x4v*)(qp + 16 * d0);
#pragma unroll
            for (int j = 0; j < 4; ++j) { const float lo = __uint_as_float(raw[d0][j] << 16), hi = __uint_as_float(raw[d0][j] & 0xffff0000u); ss += lo * lo + hi * hi; } }
        { auto rr = __builtin_amdgcn_permlane32_swap(__float_as_uint(ss), __float_as_uint(ss), false, false); ss = __uint_as_float(rr[0]) + __uint_as_float(rr[1]); }
        const float sc = rsqrtf(ss * (1.f / 128.f) + NORM_EPS) * (0.08838834764831845f * 1.4426950408889634f);
#pragma unroll
        for (int d0 = 0; d0 < 8; ++d0) { const f32x4v g0 = *(const f32x4v*)(A.qg + 16 * d0 + 8 * hh), g1 = *(const f32x4v*)(A.qg + 16 * d0 + 8 * hh + 4);
            u32x4v w;
#pragma unroll
            for (int j = 0; j < 4; ++j) { const float lo = __uint_as_float(raw[d0][j] << 16), hi = __uint_as_float(raw[d0][j] & 0xffff0000u);
                const float gl = (j < 2) ? g0[2 * j] : g1[2 * j - 4], gh = (j < 2) ? g0[2 * j + 1] : g1[2 * j - 3]; w[j] = cvtpk_c(lo * sc * gl, hi * sc * gh); }
            qf[d0] = __builtin_bit_cast(bf16x8v, w); }
    }
    __syncthreads();
    f32x16v p[8];
#pragma unroll
    for (int t = 0; t < 8; ++t) {
#pragma unroll
        for (int i = 0; i < 16; ++i) p[t][i] = 0.f;
        asm volatile("" : "+v"(p[t]));
        const LAS3 unsigned char* kb = lds + MA_KOFF + (32 * t + r32) * MA_KSTR + 16 * hh;
#pragma unroll
        for (int d0 = 0; d0 < 8; ++d0) { const bf16x8v kf = *(const LAS3 bf16x8v*)(kb + 32 * d0); p[t] = __builtin_amdgcn_mfma_f32_32x32x16_bf16(kf, qf[d0], p[t], 0, 0, 0); }
    }
    float mx = -1e30f;
#pragma unroll
    for (int t = 0; t < 8; ++t)
#pragma unroll
        for (int i = 0; i < 16; ++i) mx = fmaxf(mx, p[t][i]);
    { auto rr = __builtin_amdgcn_permlane32_swap(__float_as_uint(mx), __float_as_uint(mx), false, false); mx = fmaxf(__uint_as_float(rr[0]), __uint_as_float(rr[1])); }
    float sm = 0.f;
#pragma unroll
    for (int t = 0; t < 8; ++t)
#pragma unroll
        for (int i = 0; i < 16; ++i) { const float e = __builtin_amdgcn_exp2f(p[t][i] - mx); p[t][i] = e; sm += e; }
    { auto rr = __builtin_amdgcn_permlane32_swap(__float_as_uint(sm), __float_as_uint(sm), false, false); sm = __uint_as_float(rr[0]) + __uint_as_float(rr[1]); }
    const float inv = 1.f / sm;
    f32x16v o[4];
#pragma unroll
    for (int db = 0; db < 4; ++db) {
#pragma unroll
        for (int i = 0; i < 16; ++i) o[db][i] = 0.f;
        asm volatile("" : "+v"(o[db])); }
    const LAS3 unsigned char* vb = lds + MA_VOFF + r32 * MA_VSTR + 8 * hh;
#pragma unroll
    for (int t = 0; t < 8; ++t)
#pragma unroll
        for (int s2 = 0; s2 < 2; ++s2) {
            u32x4v pw;
#pragma unroll
            for (int j = 0; j < 4; ++j) pw[j] = cvtpk_c(p[t][8 * s2 + 2 * j] * inv, p[t][8 * s2 + 2 * j + 1] * inv);
            const bf16x8v pa = __builtin_bit_cast(bf16x8v, pw);
            const int kvo = 2 * (32 * t + 16 * s2);
#pragma unroll
            for (int db = 0; db < 4; ++db) {
                const bf16x4v a0 = *(const LAS3 bf16x4v*)(vb + 32 * db * MA_VSTR + kvo), a1 = *(const LAS3 bf16x4v*)(vb + 32 * db * MA_VSTR + kvo + 16);
                const bf16x8v vf = (bf16x8v){a0[0], a0[1], a0[2], a0[3], a1[0], a1[1], a1[2], a1[3]};
                o[db] = __builtin_amdgcn_mfma_f32_32x32x16_bf16(pa, vf, o[db], 0, 0, 0);
            }
        }
    bf16* op = A.y_m + ((size_t)b * SEQ + 256 * u + 32 * wave) * 512 + h * 128 + r32;
#pragma unroll
    for (int r = 0; r < 16; ++r) { const int qq = (r & 3) + 8 * (r >> 2) + 4 * hh;
#pragma unroll
        for (int db = 0; db < 4; ++db) op[(size_t)qq * 512 + 32 * db] = f2bf(o[db][r]); }
}

__device__ __forceinline__ void ffn_fixup_chunks(const float* __restrict__ side, const float* __restrict__ cw, const float* __restrict__ cb, bf16* __restrict__ u, int vb, int G) {
    const int tidf = opaque_tid();
    for (int cid = vb; cid < M / 64; cid += G) {
        const bool first = ((cid * 64) % SEQ) == 0;
        for (int idx = tidf; idx < 2 * DFF; idx += 512) {
            const int rr = idx / DFF, ch = idx % DFF;
            float Gv = cb[ch], V = cb[DFF + ch];
#pragma unroll
            for (int i = 0; i < 3; ++i) {
                const int dt = 2 - i, q = rr - dt;
                float hg = 0.f, hv = 0.f;
                if (q >= 0) { const float* sp = side + (((size_t)cid * 4 + q) * 2) * DFF + ch; hg = sp[0]; hv = sp[DFF]; }
                else if (!first) { const float* sp = side + (((size_t)(cid - 1) * 4 + (4 + q)) * 2) * DFF + ch; hg = sp[0]; hv = sp[DFF]; }
                Gv += cw[i * DFF2 + ch] * hg; V += cw[i * DFF2 + DFF + ch] * hv;
            }
            u[(size_t)(cid * 64 + rr) * DFF + ch] = f2bf(Gv * sigmoidf_(Gv) * V);
        }
    }
}


#define XB_TMO      128
#define XB_XCNT(j)  (256  + 64 * (j))
#define XB_XSUB(j)  (1280 + 64 * (j))
#define XB_XGEN(j)  (2304 + 64 * (j))
#define XB_TOP      3328
#define XB_TOPGEN   3392
#define XCD_BAR_WORDS 3456
#define XB_SPIN_CAP (1u << 22)
__device__ __forceinline__ unsigned xb_ld(unsigned* p)              { return __hip_atomic_load(p, __ATOMIC_RELAXED, __HIP_MEMORY_SCOPE_AGENT); }
__device__ __forceinline__ unsigned xb_add(unsigned* p, unsigned v) { return __hip_atomic_fetch_add(p, v, __ATOMIC_RELAXED, __HIP_MEMORY_SCOPE_AGENT); }
__device__ __forceinline__ unsigned xb_xcc_id() { return (unsigned)__builtin_amdgcn_s_getreg((3 << 11) | 20) & 0xFu; }
#define XB_SPIN(cond, bar) do { unsigned _sp = 0; while (cond) { __builtin_amdgcn_s_sleep(1); \
    if ((++_sp & 255u) == 0u) { if (xb_ld(&(bar)[XB_TMO])) break; if (_sp > XB_SPIN_CAP) { atomicAdd(&(bar)[XB_TMO], 1u); break; } } } } while (0)
struct XcdBarrier { unsigned* bar; unsigned x; volatile LAS3 unsigned* st; };
__device__ __forceinline__ XcdBarrier xcd_barrier_post(unsigned* bar, volatile LAS3 unsigned* st) {
    XcdBarrier b; b.bar = bar; b.x = xb_xcc_id(); b.st = st;
    if (threadIdx.x == 0) (void)xb_add(&bar[XB_XCNT(b.x)], 1u);
    return b;
}
__device__ __forceinline__ void xcd_barrier_complete(unsigned* bar, unsigned x, unsigned& nloc, unsigned& nx) {
    const unsigned G = gridDim.x * gridDim.y * gridDim.z;
    unsigned sum, cnt, mine, sp = 0u;
    for (;;) {
        sum = 0u; cnt = 0u; mine = 0u;
#pragma unroll
        for (unsigned j = 0; j < 16; ++j) { const unsigned c = xb_ld(&bar[XB_XCNT(j)]); sum += c; cnt += (c > 0u) ? 1u : 0u; mine = (j == x) ? c : mine; }
        if (sum == G) break;
        __builtin_amdgcn_s_sleep(1);
        if ((++sp & 255u) == 0u) { if (xb_ld(&bar[XB_TMO])) break; if (sp > XB_SPIN_CAP) { atomicAdd(&bar[XB_TMO], 1u); break; } }
    }
    nloc = mine > 0u ? mine : 1u; nx = cnt > 0u ? cnt : 1u;
}
__device__ __forceinline__ void xcd_barrier(const XcdBarrier& b) {
    asm volatile("s_waitcnt vmcnt(0)" ::: "memory");
    __syncthreads();
    if (threadIdx.x == 0) {
        unsigned* bar = b.bar;
        __builtin_amdgcn_s_waitcnt(0);
        unsigned nloc = b.st[0], nx = b.st[1];
        if (nloc == 0u) { xcd_barrier_complete(bar, b.x, nloc, nx); b.st[0] = nloc; b.st[1] = nx; }
        const unsigned old = xb_add(&bar[XB_XSUB(b.x)], 1u);
        const unsigned gen = old / nloc;
        if (old + 1u == (gen + 1u) * nloc) {
            __builtin_amdgcn_fence(__ATOMIC_RELEASE, "agent");
            asm volatile("s_waitcnt vmcnt(0)" ::: "memory");
            const unsigned og = xb_add(&bar[XB_TOP], 1u);
            const unsigned target = (og / nx + 1u) * nx;
            if (og + 1u != target) XB_SPIN(xb_ld(&bar[XB_TOP]) < target, bar);
            __builtin_amdgcn_fence(__ATOMIC_ACQUIRE, "agent");
            asm volatile("s_waitcnt vmcnt(0)" ::: "memory");
            xb_add(&bar[XB_XGEN(b.x)], 1u);
            asm volatile("s_waitcnt vmcnt(0)" ::: "memory");
        } else {
            XB_SPIN(xb_ld(&bar[XB_XGEN(b.x)]) == gen, bar);
            asm volatile("buffer_inv sc0\n\ts_waitcnt vmcnt(0)" ::: "memory");
        }
    }
    __syncthreads();
}

constexpr int MEGA_LDS = 147456;
struct Params { const float* in[31]; float* out; unsigned char* wsp; int ph_lo, ph_hi; };
enum { PH_P0 = 0, PH_GEMMA, PH_SHIFT, PH_LORA, PH_VRES2, PH_SCAN, PH_SCAN2, PH_POST, PH_GEMMB, PH_ATTN, PH_GEMMC, PH_BRANCH, PH_WOUT, PH_UP, PH_FIX, PH_DOWN, PH_NCODES };
struct PhaseDesc { int code, layer; };
__device__ __constant__ const int kPhaseCode[30] = { PH_P0,
    PH_GEMMA, PH_SHIFT, PH_LORA, PH_SCAN, PH_SCAN2, PH_POST, PH_GEMMB, PH_ATTN, PH_GEMMC, PH_BRANCH, PH_WOUT, PH_UP, PH_FIX, PH_DOWN,
    PH_GEMMA, PH_SHIFT, PH_LORA, PH_VRES2, PH_SCAN, PH_SCAN2, PH_POST, PH_GEMMB, PH_ATTN, PH_GEMMC, PH_BRANCH, PH_WOUT, PH_UP, PH_FIX, PH_DOWN };
constexpr int N_PHASES = 30, L1_FIRST = 15;

#define WTJ(src, scale, dst, ldsrc, lddst, koff, K, N, mode) do { wt_job(src, scale, dst, ldsrc, lddst, koff, K, N, mode, (LAS3 float*)(lds + wave * 16384), vb * 8 + wave, G * 8, lane, rot_); rot_ += ((K) / 64) * ((N) / 32); } while (0)
#define WTJI(src, scale, dst, ldsrc, lddst, koff, K, N, mode) do { wt_job(src, scale, dst, ldsrc, lddst, koff, K, N, mode, (LAS3 float*)(lds + wave * 16384), (vb - 64) * 8 + wave, 192 * 8, lane, rot_); rot_ += ((K) / 64) * ((N) / 32); } while (0)
#define WTJX(b0, nb, src, scale, dst, ldsrc, lddst, koff, K, N, mode) do { wt_job(src, scale, dst, ldsrc, lddst, koff, K, N, mode, (LAS3 float*)(lds + wave * 16384), (vb - (b0)) * 8 + wave, (nb) * 8, lane, rot_); rot_ += ((K) / 64) * ((N) / 32); } while (0)
#define P_PROJ_R ((bf16*)(ws + RS(0)))
#define P_R_S ((bf16*)(ws + RS(4)))
#define P_BONUS ((float*)(ws + RS(3) + MiB))
#define P_K_S ((bf16*)(ws + RS(5)))
#define P_V_S ((l == 0) ? (bf16*)(ws + WS_VFIRST) : (bf16*)(ws + RS(6)))
#define P_LORA_IN ((bf16*)(ws + RS(3) + 8 * MiB))
#define P_LD ((unsigned short*)(ws + RS(0)))
#define P_A ((bf16*)(ws + RS(1)))
#define P_G ((bf16*)(ws + RS(2)))
#define P_T1 ((bf16*)(ws + RS(3)))
#define P_VP ((bf16*)(ws + RS(8)))
#define P_VUSE ((l == 0) ? (bf16*)(ws + WS_VFIRST) : (bf16*)(ws + RS(8)))
#define P_Y_RAW ((bf16*)(ws + RS(9)))
#define P_Y_A ((bf16*)(ws + RS(0)))
#define P_Y_B ((bf16*)(ws + RS(1)))
#define P_Y_M ((bf16*)(ws + RS(2)))
#define P_PROJ_SM ((bf16*)(ws + RS(3)))
#define P_GATES ((bf16*)(ws + RS(3)))
#define P_MERGED ((bf16*)xout)
#define P_XB2 ((bf16*)(ws + RS(0)))
#define P_U ((bf16*)(ws + RS(2)))
#define P_SIDE ((float*)(ws + RS(2) + 88 * MiB))
#define P_XIN ((l == 0) ? in[0] : (const float*)xout)
#define WinT ((bf16*)(ws + WS_WINT))
#define WupT ((bf16*)(ws + WS_WUPT))
#define WdnT ((bf16*)(ws + WS_WDNT))
#define WbrT ((bf16*)(ws + WS_WBRT))
#define WoutT ((bf16*)(ws + WS_WOUTT))
#define Wlora ((bf16*)(ws + WS_WLORA))
#define V1T ((bf16*)(ws + WS_V1T))
#define V2T ((bf16*)(ws + WS_V2T))
#define xbA ((bf16*)(ws + WS_XBA))
#define kvmem ((bf16*)(ws + WS_KVMEM))
#define ssq ((float*)(ws + WS_SSQ))
#define nrm ((float*)(ws + WS_NRM))
#define ssqm ((float*)(ws + WS_SSQM))
#define memb ((bf16*)(ws + RS(8)))
#define WkvT ((bf16*)(ws + RS(9)))
#define xout (P.out)
#define in (P.in + z0)
#define ws (P.wsp + z0)
#define gw (vb * 8 + wave)
#define lane (opaque_tid() & 63)
#define NGW (G * 8)
__global__ void __launch_bounds__(512, 2) mega(Params P) {
    extern __shared__ __attribute__((aligned(16))) unsigned char lds_dyn[];
    cooperative_groups::grid_group grid = cooperative_groups::this_grid();
    LAS3 unsigned char* lds = (LAS3 unsigned char*)lds_dyn;
    volatile LAS3 unsigned* bst = (volatile LAS3 unsigned*)(lds + MEGA_LDS - 16);
    if (threadIdx.x < 4) bst[threadIdx.x] = 0u;
    __syncthreads();
    (void)xcd_barrier_post((unsigned*)(P.wsp + WS_CTL), bst);
    for (int ph = P.ph_lo; ph < P.ph_hi; ++ph) {
        const int wave = __builtin_amdgcn_readfirstlane(opaque_tid() >> 6);
        int vb = blockIdx.x; asm volatile("" : "+s"(vb));
        int z0 = 0; asm volatile("" : "+s"(z0));
        constexpr int G = 256;
        const int code = kPhaseCode[ph], l = (ph >= L1_FIRST) ? 1 : 0;
#ifdef ONLY_PHASE
        if (code != ONLY_PHASE) continue;
#endif
        switch (code) {
#if !defined(ONLY_PHASE) || ONLY_PHASE == 0
        case PH_P0: {
            int rot_ = 0;
            WTJ(in[3], in[2], WinT, IN_COLS, D, 0, D, RWKV_COLS, 0);
            WTJ(in[6], nullptr, Wlora, 512, 256, 0, 64, 512, 0); WTJ(in[8], nullptr, Wlora + 512 * 256, 512, 256, 64, 64, 512, 0); WTJ(in[9], nullptr, Wlora + 1024 * 256, 512, 256, 128, 128, 512, 0);
            WTJ(in[21], in[20], WkvT, 1024, D, 0, D, 1024, 0); WTJ(in[21] + (size_t)D * 1024, in[20] + D, WkvT + (size_t)1024 * D, 1024, D, 0, D, 1024, 0);
            x_to_xb_rows(in[1], memb, ssqm, MEM_ROWS, gw, NGW, lane);
            x_to_xb_rows(in[0], xbA, ssq, M, gw, NGW, lane);
        } break;
#endif
#if !defined(ONLY_PHASE) || ONLY_PHASE == 1
        case PH_GEMMA: {
            pg8::gemm_phase<pg8::EpiRowScale, true, M, RWKV_COLS, D, D, D / 64>(lds, pg8::Gemm{xbA, xbA, xbA, WinT}, G, vb, pg8::EpiRowScale{P_PROJ_R, ssq, RWKV_COLS, 0});
            if (l == 1 && vb >= 192) {
                __syncthreads();
                int rot_ = 0;
                WTJX(192, 64, in[25] + (size_t)D * D, nullptr, WoutT, D, D, 0, D, D, 0);
            }
            if (l == 0) {
#pragma unroll 1
                for (int ll = 0; ll < 2; ++ll) { const int cc = (vb >= 192 + 32 * ll && vb < 224 + 32 * ll) ? vb - 192 - 32 * ll : -1;
                    pg8::gemm_phase<pg8::EpiRowScale, true, MEM_ROWS, 1024, D, D, D / 64>(lds, pg8::Gemm{memb, memb, memb, WkvT + (size_t)ll * 1024 * D}, 32, cc,
                                                           pg8::EpiRowScale{kvmem + (size_t)ll * MEM_ROWS * 1024, ssqm, 1024, 0}); }
            }
        } break;
#endif
#if !defined(ONLY_PHASE) || ONLY_PHASE == 2
        case PH_SHIFT: {
            shift_rows(ShiftArgs{P_PROJ_R, in[4] + l * RWKV_COLS, in[10] + l * 512, P_R_S, P_K_S, P_V_S, P_LORA_IN, nrm}, gw, NGW);
            if (l == 0) { memk_norm_rows(kvmem, in[23], gw, NGW, lane); memk_norm_rows(kvmem + (size_t)MEM_ROWS * 1024, in[23] + 128, gw, NGW, lane); }
        } break;
#endif
#if !defined(ONLY_PHASE) || ONLY_PHASE == 3
        case PH_LORA: {
            {
                const int cc = (l == 0) ? vb : ((vb < 128) ? vb : ((vb >= 192) ? vb - 64 : -1));
                pg8::gemm_phase<pg8::EpiLora, true, M, 1024, 256, 256, 4>(lds, pg8::Gemm{P_LORA_IN, P_LORA_IN, P_LORA_IN, Wlora}, G, cc, pg8::EpiLora{P_LD, in[5] + l * 512, in[7] + l * 512, 0}); }
            if (l == 1) {
                pg8::gemm_phase<pg8::EpiRowScale, true, M, 256, 512, 512, 8>(lds, pg8::Gemm{P_V_S, P_V_S, P_V_S, V1T}, G, (vb + 128) % G, pg8::EpiRowScale{P_T1, nullptr, 256, 0}); }
        } break;
#endif
#if !defined(ONLY_PHASE) || ONLY_PHASE == 4
        case PH_VRES2: {
            pg8::gemm_phase<pg8::EpiVres, true, M, 512, 256, 256, 4>(lds, pg8::Gemm{P_T1, P_T1, P_T1, V2T}, G, vb, pg8::EpiVres{P_V_S, ((bf16*)(ws + WS_VFIRST)), in[15], P_VP});
            pg8::gemm_phase<pg8::EpiLora, true, M, 1024, 256, 256, 4>(lds, pg8::Gemm{P_LORA_IN, P_LORA_IN, P_LORA_IN, Wlora}, G, (vb >= 128 && vb < 192) ? vb + 64 : -1, pg8::EpiLora{P_LD, in[5] + l * 512, in[7] + l * 512, 0});
        } break;
#endif
#if !defined(ONLY_PHASE) || ONLY_PHASE == 5
        case PH_SCAN: {
            cscan_produce(lds + wave * PS_BYTES, ScanArgs{P_R_S, P_K_S, P_VUSE, P_A, P_LD, nrm, in[10] + l * 512, in[11] + l * 512, P_Y_RAW, in[12] + l * 512, P_BONUS}, CsRec{(unsigned char*)xout, ws + RS(6), ws + RS(3)}, gw, NGW);
        } break;
#endif
#if !defined(ONLY_PHASE) || ONLY_PHASE == 15
        case PH_SCAN2: {
            if (vb < 64) cscan_consume(lds, ScanArgs{P_R_S, P_K_S, P_VUSE, P_A, P_LD, nrm, in[10] + l * 512, in[11] + l * 512, P_Y_RAW, in[12] + l * 512, P_BONUS}, CsRec{(unsigned char*)xout, ws + RS(6), ws + RS(3)}, vb);
            else {
                pg8::gemm_phase<pg8::EpiLora, true, M, 512, 256, 256, 4>(lds, pg8::Gemm{P_LORA_IN, P_LORA_IN, P_LORA_IN, Wlora + (size_t)1024 * 256}, 192, vb - 64, pg8::EpiLora{P_LD, in[5] + l * 512, in[7] + l * 512, 2});
                __syncthreads();
                int rot_ = 0;
                if (l == 0) { WTJI(in[24], nullptr, WbrT, D, 1536, 0, 512, D, 0); WTJI(in[24] + (size_t)512 * D, nullptr, WbrT, D, 1536, 512, 512, D, 0); WTJI(in[24] + (size_t)2 * 512 * D, nullptr, WbrT, D, 1536, 1024, 512, D, 0); }
                WTJI(in[27] + (size_t)l * D * DFF2, in[26] + l * D, WupT, DFF2, D, 0, D, DFF2, 1);
                if (l == 0) WTJI(in[25], nullptr, WoutT, D, D, 0, D, D, 0);
                if (l == 0) {
                    WTJI(in[3] + RWKV_COLS, in[2], WinT + (size_t)RWKV_COLS * D, IN_COLS, D, 0, D, IN_COLS - RWKV_COLS, 0);
                    WTJI(in[3] + (size_t)D * IN_COLS, in[2] + D, WinT, IN_COLS, D, 0, D, RWKV_COLS, 0);
                    WTJI(in[6] + 64 * 512, nullptr, Wlora, 512, 256, 0, 64, 512, 0); WTJI(in[8] + 64 * 512, nullptr, Wlora + 512 * 256, 512, 256, 64, 64, 512, 0);
                    WTJI(in[16], nullptr, V1T, 32, 512, 0, 512, 32, 0);
                    for (int idx = ((vb - 64) * 8 + wave) * 64 + lane; idx < 512 * 32; idx += 192 * 8 * 64) { const int n = idx >> 5, k = idx & 31; V2T[(size_t)n * 256 + k] = f2bf(in[17][(size_t)k * 512 + n]); }
                } else {
                    WTJI(in[3] + (size_t)D * IN_COLS + RWKV_COLS, in[2] + D, WinT + (size_t)RWKV_COLS * D, IN_COLS, D, 0, D, IN_COLS - RWKV_COLS, 0);
                }
            }
        } break;
#endif
#if !defined(ONLY_PHASE) || ONLY_PHASE == 6
        case PH_POST: {
            post_rows(PostArgs{P_Y_RAW, P_VUSE, P_G, P_BONUS, in[13] + l * 512, in[14] + l * 512, P_Y_A}, gw, NGW);
        } break;
#endif
#if !defined(ONLY_PHASE) || ONLY_PHASE == 7
        case PH_GEMMB: {
            pg8::gemm_phase<pg8::EpiRowScale, true, M, 2048, D, D, D / 64>(lds, pg8::Gemm{xbA, xbA, xbA, WinT + (size_t)RWKV_COLS * D}, G, vb, pg8::EpiRowScale{P_PROJ_SM, ssq, 2048, 0});
        } break;
#endif
#if !defined(ONLY_PHASE) || ONLY_PHASE == 8
        case PH_ATTN: {
            const SbArgs sa{P_PROJ_SM, in[18] + l * 64, in[19] + l * 64, P_Y_B};
            const int bh = vb >> 2, pr = vb & 3;
            sb_unit(lds, sa, bh, 7 - pr);
            __syncthreads();
            sb_unit(lds, sa, bh, pr);
            __syncthreads();
            { const int pair = vb >> 3; mem_unit(lds, MemArgs{P_PROJ_SM, kvmem + (size_t)l * MEM_ROWS * 1024, in[22] + l * 128, P_Y_M}, pair >> 2, pair & 3, vb & 7); }
        } break;
#endif
#if !defined(ONLY_PHASE) || ONLY_PHASE == 9
        case PH_GEMMC: {
            pg8::gemm_phase<pg8::EpiGatesFrag, true, M, 3072, D, D, D / 64>(lds, pg8::Gemm{xbA, xbA, xbA, WinT + (size_t)3840 * D}, G, vb, pg8::EpiGatesFrag{P_GATES, ssq});
        } break;
#endif
#if !defined(ONLY_PHASE) || ONLY_PHASE == 10
        case PH_BRANCH: {
            pg8::gemm_phase<pg8::EpiGated, true, M, D, 1536, 512, 8>(lds, pg8::Gemm{P_Y_A, P_Y_B, P_Y_M, WbrT}, G, vb, pg8::EpiGated{P_GATES, P_MERGED});
        } break;
#endif
#if !defined(ONLY_PHASE) || ONLY_PHASE == 11
        case PH_WOUT: {
            pg8::gemm_phase<pg8::EpiResidual<true, false>, true, M, D, D, D, D / 64>(lds, pg8::Gemm{P_MERGED, P_MERGED, P_MERGED, WoutT}, G, vb, pg8::EpiResidual<true, false>{nullptr, xbA, nullptr, P_XB2, ssq});
        } break;
#endif
#if !defined(ONLY_PHASE) || ONLY_PHASE == 12
        case PH_UP: {
            pg8::gemm_phase<pg8::EpiConv, true, M, DFF2, D, D, D / 64>(lds, pg8::Gemm{P_XB2, P_XB2, P_XB2, WupT}, G, vb, pg8::EpiConv{ssq, in[28] + (size_t)l * 3 * DFF2, in[29] + (size_t)l * DFF2, P_U, P_SIDE});
            if (vb >= 128) {
                __syncthreads();
                int rot_ = 0;
                WTJX(128, 128, in[30] + (size_t)l * DFF * D, nullptr, WdnT, D, DFF, 0, DFF, D, 0);
                if (l == 0) {
                    WTJX(128, 128, in[9] + 128 * 512, nullptr, Wlora + 1024 * 256, 512, 256, 128, 128, 512, 0);
                    WTJX(128, 128, in[24] + (size_t)3 * 512 * D, nullptr, WbrT, D, 1536, 0, 512, D, 0); WTJX(128, 128, in[24] + (size_t)4 * 512 * D, nullptr, WbrT, D, 1536, 512, 512, D, 0); WTJX(128, 128, in[24] + (size_t)5 * 512 * D, nullptr, WbrT, D, 1536, 1024, 512, D, 0); }
            }
        } break;
#endif
#if !defined(ONLY_PHASE) || ONLY_PHASE == 13
        case PH_FIX: {
            ffn_fixup_chunks(P_SIDE, in[28] + (size_t)l * 3 * DFF2, in[29] + (size_t)l * DFF2, P_U, vb, G);
        } break;
#endif
#if !defined(ONLY_PHASE) || ONLY_PHASE == 14
        case PH_DOWN: {
            if (l == 0) pg8::gemm_phase<pg8::EpiResidual<true, false>, true, M, D, DFF, DFF, DFF / 64>(lds, pg8::Gemm{P_U, P_U, P_U, WdnT}, G, vb, pg8::EpiResidual<true, false>{nullptr, P_XB2, nullptr, xbA, ssq});
            else        pg8::gemm_phase<pg8::EpiResidual<true, true>, true, M, D, DFF, DFF, DFF / 64>(lds, pg8::Gemm{P_U, P_U, P_U, WdnT}, G, vb, pg8::EpiResidual<true, true>{nullptr, P_XB2, xout, xbA, ssq});
        } break;
#endif
        default: break;
        }
        if (ph + 1 < P.ph_hi) { if (P.ph_hi > N_PHASES) grid.sync(); else { XcdBarrier xb_; xb_.bar = (unsigned*)(ws + WS_CTL); xb_.x = xb_xcc_id(); xb_.st = (volatile LAS3 unsigned*)(lds + MEGA_LDS - 16); xcd_barrier(xb_); } }
    }
}

#undef lane
#undef WinT
#undef WupT
#undef WdnT
#undef WbrT
#undef WoutT
#undef Wlora
#undef V1T
#undef V2T
#undef xbA
#undef kvmem
#undef ssq
#undef nrm
#undef ssqm
#undef memb
#undef WkvT
#undef xout
#undef in
#undef ws
#undef gw
#undef NGW
#ifndef MK_SPLIT
#define MK_SPLIT 0
#endif
extern "C" void kernel_launch(void* const* d_in, const int* in_sizes, int n_in, void* d_out, int out_size, void* d_ws, size_t ws_size, hipStream_t stream) {
    static int grid_blocks = 0;
    if (!grid_blocks) {
        if (n_in != 31 || ws_size < 256 * MiB) { fprintf(stderr, "kernel_launch: unexpected n_in %d / ws %zu\n", n_in, ws_size); grid_blocks = -1; return; }
        int dev = 0, cus = 0, per_cu = 0;
        (void)hipGetDevice(&dev); (void)hipDeviceGetAttribute(&cus, hipDeviceAttributeMultiprocessorCount, dev);
        (void)hipFuncSetAttribute((const void*)mega, hipFuncAttributeMaxDynamicSharedMemorySize, MEGA_LDS);
        (void)hipOccupancyMaxActiveBlocksPerMultiprocessor(&per_cu, (const void*)mega, 512, MEGA_LDS);
        grid_blocks = (per_cu >= 1 && cus >= 256) ? 256 : -1;
        if (grid_blocks != 256) fprintf(stderr, "kernel_launch: %d CUs, %d blocks/CU: this kernel needs a 256-CU device; nothing launched\n", cus, per_cu);
    }
    if (grid_blocks < 0) return;
    unsigned char* ws = (unsigned char*)d_ws;
    (void)hipMemsetAsync(ws + WS_WLORA, 0, 3 * MiB / 4 + MiB / 2 + 65536, stream);
    Params p{};
    for (int i = 0; i < 31; ++i) p.in[i] = (const float*)d_in[i];
    p.out = (float*)d_out; p.wsp = ws;
#if MK_SPLIT
    for (int ph = 0; ph < N_PHASES; ++ph) { p.ph_lo = ph; p.ph_hi = ph + 1; void* args[] = {(void*)&p};
        hipError_t e = hipLaunchCooperativeKernel((const void*)mega, dim3(grid_blocks), dim3(512), args, MEGA_LDS, stream);
        if (e != hipSuccess) { fprintf(stderr, "cooperative launch failed: %s\n", hipGetErrorString(e)); return; } }
#else
    p.ph_lo = 0; p.ph_hi = N_PHASES; void* args[] = {(void*)&p};
    hipError_t e = hipLaunchCooperativeKernel((const void*)mega, dim3(grid_blocks), dim3(512), args, MEGA_LDS, stream);
    if (e != hipSuccess) fprintf(stderr, "cooperative launch failed: %s (grid %d)\n", hipGetErrorString(e), grid_blocks);
#endif
}
```
